# Optimizing an MI355X kernel written in HIP

```python
import math
import jax, jax.numpy as jnp
from jax import lax
import numpy as np

D_MODEL = 4096
BATCH = 4
SEQ = 4096
DEPTH = 1

N_META = 16
Q_BLOCK = 128
D_FF = 11008
EPS = 1e-6

DIFF_HEADS = 8
DIFF_HEAD_DIM = 128
DIFF_V_DIM = 2 * DIFF_HEAD_DIM
DIFF_QK_WIDTH = DIFF_HEADS * 2 * DIFF_HEAD_DIM
DIFF_WIDTH = DIFF_HEADS * DIFF_V_DIM

MLA_HEADS = 16
Q_LORA = 1024
KV_LORA = 512
NOPE_D = 128
ROPE_D = 64
MLA_QK_D = NOPE_D + ROPE_D
MLA_V_D = 128
MLA_WIDTH = MLA_HEADS * MLA_V_D
ROPE_THETA = 10000.0

IN_SIZES = (DIFF_QK_WIDTH, DIFF_QK_WIDTH, DIFF_WIDTH, Q_LORA, KV_LORA, ROPE_D)
IN_WIDTH = sum(IN_SIZES)
IN_SPLITS = tuple(int(v) for v in np.cumsum(IN_SIZES)[:-1])

kernel_name = "hybrid_diffattn_mla_macaron_encoder"


def alibi_slopes(n):
    return np.array([2.0 ** (-8.0 * (h + 1) / n) for h in range(n)], dtype=np.float32)


def rms_norm(x, g):
    xf = x.astype(jnp.float32)
    y = xf * lax.rsqrt(jnp.mean(xf * xf, axis=-1, keepdims=True) + EPS)
    return (y * g.astype(jnp.float32)).astype(x.dtype)


def swiglu(h, w_gate, w_up, w_down):
    return (jax.nn.silu(h @ w_gate) * (h @ w_up)) @ w_down


def apply_rope(x, cos, sin):
    half = ROPE_D // 2
    x1, x2 = x[..., :half], x[..., half:]
    cos = cos.astype(x.dtype)
    sin = sin.astype(x.dtype)
    return jnp.concatenate([x1 * cos - x2 * sin, x1 * sin + x2 * cos], axis=-1)


def setup_inputs(seed: int = 0) -> dict:
    key = jax.random.key(seed)
    ks = iter(jax.random.split(key, 40))
    f32 = jnp.float32

    def w(shape, fan_in):
        return jax.random.normal(next(ks), shape, f32) * (fan_in ** -0.5)

    def gain(shape):
        return 1.0 + 0.02 * jax.random.normal(next(ks), shape, f32)

    L = DEPTH
    return {
        "x": jax.random.normal(next(ks), (BATCH, SEQ, D_MODEL), f32),
        "meta_tokens": jax.random.normal(next(ks), (N_META, D_MODEL), f32),
        "ffn1_norm": gain((L, D_MODEL)),
        "ffn1_w_gate": w((L, D_MODEL, D_FF), D_MODEL),
        "ffn1_w_up": w((L, D_MODEL, D_FF), D_MODEL),
        "ffn1_w_down": w((L, D_FF, D_MODEL), D_FF),
        "mix_norm": gain((L, D_MODEL)),
        "w_in": w((L, D_MODEL, IN_WIDTH), D_MODEL),
        "diff_lambda_q1": 0.1 * jax.random.normal(next(ks), (L, DIFF_HEAD_DIM), f32),
        "diff_lambda_k1": 0.1 * jax.random.normal(next(ks), (L, DIFF_HEAD_DIM), f32),
        "diff_lambda_q2": 0.1 * jax.random.normal(next(ks), (L, DIFF_HEAD_DIM), f32),
        "diff_lambda_k2": 0.1 * jax.random.normal(next(ks), (L, DIFF_HEAD_DIM), f32),
        "diff_subln": gain((L, DIFF_V_DIM)),
        "mla_q_norm": gain((L, Q_LORA)),
        "mla_w_uq": w((L, Q_LORA, MLA_HEADS * MLA_QK_D), Q_LORA),
        "mla_kv_norm": gain((L, KV_LORA)),
        "mla_w_ukv": w((L, KV_LORA, MLA_HEADS * (NOPE_D + MLA_V_D)), KV_LORA),
        "w_gate": w((L, D_MODEL, 2 * D_MODEL), D_MODEL),
        "b_gate": 0.02 * jax.random.normal(next(ks), (L, 2 * D_MODEL), f32),
        "w_branch_diff": w((L, DIFF_WIDTH, D_MODEL), DIFF_WIDTH),
        "w_branch_mla": w((L, MLA_WIDTH, D_MODEL), MLA_WIDTH),
        "w_out": w((L, D_MODEL, D_MODEL), D_MODEL),
        "ffn2_norm": gain((L, D_MODEL)),
        "ffn2_w_gate": w((L, D_MODEL, D_FF), D_MODEL),
        "ffn2_w_up": w((L, D_MODEL, D_FF), D_MODEL),
        "ffn2_w_down": w((L, D_FF, D_MODEL), D_FF),
        "final_norm": gain((D_MODEL,)),
    }


def mixing_sublayer(h, w_in, lq1, lk1, lq2, lk2, subln, q_norm, w_uq, kv_norm, w_ukv,
                    lam_init):
    B, T, _ = h.shape
    S = T - N_META
    proj = h @ w_in
    dq, dk, dv, cq, ckv, k_rope = jnp.split(proj, IN_SPLITS, axis=-1)
    dq = dq.reshape(B, T, DIFF_HEADS, 2, DIFF_HEAD_DIM)
    dk = dk.reshape(B, T, DIFF_HEADS, 2, DIFF_HEAD_DIM)
    dv = dv.reshape(B, T, DIFF_HEADS, DIFF_V_DIM)

    lam = (jnp.exp(jnp.sum(lq1.astype(jnp.float32) * lk1.astype(jnp.float32)))
           - jnp.exp(jnp.sum(lq2.astype(jnp.float32) * lk2.astype(jnp.float32)))
           + lam_init)

    pos = jnp.arange(T)
    inv_freq = 1.0 / (ROPE_THETA ** (jnp.arange(0, ROPE_D, 2, dtype=jnp.float32) / ROPE_D))
    ang = pos.astype(jnp.float32)[:, None] * inv_freq[None, :]
    cos, sin = jnp.cos(ang), jnp.sin(ang)
    q = (rms_norm(cq, q_norm) @ w_uq).reshape(B, T, MLA_HEADS, MLA_QK_D)
    q_nope, q_pe = q[..., :NOPE_D], q[..., NOPE_D:]
    q_pe = apply_rope(q_pe, cos[:, None, :], sin[:, None, :])
    mq = jnp.concatenate([q_nope, q_pe], axis=-1)
    kv = (rms_norm(ckv, kv_norm) @ w_ukv).reshape(B, T, MLA_HEADS, NOPE_D + MLA_V_D)
    k_nope, mv = kv[..., :NOPE_D], kv[..., NOPE_D:]
    k_pe = apply_rope(k_rope, cos, sin)
    mk = jnp.concatenate(
        [k_nope, jnp.broadcast_to(k_pe[:, :, None, :], (B, T, MLA_HEADS, ROPE_D))], axis=-1)

    slopes = jnp.asarray(alibi_slopes(DIFF_HEADS))
    kpos = pos
    diff_scale = DIFF_HEAD_DIM ** -0.5
    mla_scale = MLA_QK_D ** -0.5
    out_scale = 1.0 - lam_init

    def attend_block(start, qn):
        qpos = start + jnp.arange(qn)
        both_real = (qpos[:, None] >= N_META) & (kpos[None, :] >= N_META)
        dist = jnp.abs(qpos[:, None] - kpos[None, :]).astype(jnp.float32)
        alibi = -slopes[:, None, None] * jnp.where(both_real, dist, 0.0)[None]

        qd = lax.dynamic_slice_in_dim(dq, start, qn, axis=1)
        s = jnp.einsum('bqhcd,bkhcd->bhcqk', qd, dk).astype(jnp.float32) * diff_scale
        p = jax.nn.softmax(s + alibi[None, :, None], axis=-1)
        a = p[:, :, 0] - lam * p[:, :, 1]
        od = jnp.einsum('bhqk,bkhe->bqhe', a.astype(dv.dtype), dv)
        od = rms_norm(od, subln) * out_scale

        qm = lax.dynamic_slice_in_dim(mq, start, qn, axis=1)
        s2 = jnp.einsum('bqhd,bkhd->bhqk', qm, mk).astype(jnp.float32) * mla_scale
        p2 = jax.nn.softmax(s2, axis=-1)
        om = jnp.einsum('bhqk,bkhe->bqhe', p2.astype(mv.dtype), mv)
        return od.reshape(B, qn, DIFF_WIDTH), om.reshape(B, qn, MLA_WIDTH)

    od_meta, om_meta = attend_block(0, N_META)
    n_blk = S // Q_BLOCK
    od_blk, om_blk = lax.map(lambda i: attend_block(N_META + i * Q_BLOCK, Q_BLOCK),
                             jnp.arange(n_blk))
    od_real = jnp.moveaxis(od_blk, 0, 1).reshape(B, S, DIFF_WIDTH)
    om_real = jnp.moveaxis(om_blk, 0, 1).reshape(B, S, MLA_WIDTH)
    return (jnp.concatenate([od_meta, od_real], axis=1),
            jnp.concatenate([om_meta, om_real], axis=1))


def reference(x, meta_tokens, ffn1_norm, ffn1_w_gate, ffn1_w_up, ffn1_w_down, mix_norm, w_in,
              diff_lambda_q1, diff_lambda_k1, diff_lambda_q2, diff_lambda_k2, diff_subln,
              mla_q_norm, mla_w_uq, mla_kv_norm, mla_w_ukv, w_gate, b_gate,
              w_branch_diff, w_branch_mla, w_out, ffn2_norm, ffn2_w_gate, ffn2_w_up,
              ffn2_w_down, final_norm):
    B = x.shape[0]
    meta = jnp.broadcast_to(meta_tokens[None].astype(x.dtype), (B, N_META, x.shape[-1]))
    h_stream = jnp.concatenate([meta, x], axis=1)

    for l in range(DEPTH):
        lam_init = 0.8 - 0.6 * math.exp(-0.3 * l)
        h_stream = h_stream + 0.5 * swiglu(rms_norm(h_stream, ffn1_norm[l]),
                                           ffn1_w_gate[l], ffn1_w_up[l], ffn1_w_down[l])
        h = rms_norm(h_stream, mix_norm[l])
        o_diff, o_mla = mixing_sublayer(
            h, w_in[l], diff_lambda_q1[l], diff_lambda_k1[l], diff_lambda_q2[l],
            diff_lambda_k2[l], diff_subln[l], mla_q_norm[l], mla_w_uq[l], mla_kv_norm[l],
            mla_w_ukv[l], lam_init)
        gates = jax.nn.sigmoid(h @ w_gate[l] + b_gate[l])
        g_diff, g_mla = jnp.split(gates, 2, axis=-1)
        merged = g_diff * (o_diff @ w_branch_diff[l]) + g_mla * (o_mla @ w_branch_mla[l])
        h_stream = h_stream + merged @ w_out[l]
        h_stream = h_stream + 0.5 * swiglu(rms_norm(h_stream, ffn2_norm[l]),
                                           ffn2_w_gate[l], ffn2_w_up[l], ffn2_w_down[l])

    return rms_norm(h_stream, final_norm)[:, N_META:]
```

```cpp
#include <hip/hip_runtime.h>
#include <cstdio>
#include <cstdint>

constexpr int DM = 4096, BATCH = 4, SEQ = 4096, NMETA = 16, DFF = 11008;
constexpr int MR = BATCH * SEQ;
constexpr int MP = MR + 256;
constexpr int INW = 7744, INWP = 7936;
constexpr int PC_DQ = 0, PC_DK = 2048, PC_DV = 4096, PC_CQ = 6144, PC_CKV = 7168, PC_KR = 7680;
constexpr float EPS = 1e-6f;

namespace pg8 {
#define PG8_LAS __attribute__((address_space(3)))
typedef unsigned short bf16_t;
typedef short bf16x8 __attribute__((ext_vector_type(8)));
typedef float f32x4 __attribute__((ext_vector_type(4)));
typedef unsigned u32x4 __attribute__((ext_vector_type(4)));
constexpr int BM = 256, BK = 64, HALF = 128, HTB = HALF * BK * 2  , STAGE_BYTES = 8 * HTB, NXCD = 8, WGM = 8;

__host__ __device__ __forceinline__ int lds_byte(int r, int c) { const int st = (r >> 4) * 2 + (c >> 5), rr = r & 15, cc = c & 31, ob = rr * 64 + cc * 2; return st * 1024 + (ob ^ (((ob >> 9) & 1) << 5)); }
__host__ __device__ __forceinline__ void stage_rc(int b, int& R, int& C) { const int st = b / 1024, sb = b % 1024, swz = sb ^ (((sb >> 9) & 1) << 5); R = (st >> 1) * 16 + swz / 64; C = (st & 1) * 32 + (swz % 64) / 2; }
__host__ __device__ __forceinline__ int perm32(int rho) { const int n = rho >> 4, i = rho & 15; return 8 * (i >> 2) + 4 * n + (i & 3); }

struct Unit { int pm, pn; };
struct Gemm { const bf16_t* A; const bf16_t* Bt; int M, N, K, lda, ldb; };

struct StaticOrder {
    int nM, nN, nwg, G, c;
    __host__ __device__ void init(int M, int N, int G_, int c_) { nM = M / BM; nN = N / BM; nwg = nM * nN; G = G_; c = c_; }
    __host__ __device__ bool next(int i, Unit& u) const {
        const long L = (long)i * G + c; if (L >= nwg) return false;
        int wgid = (int)L; { const int q = nwg / NXCD, r = nwg % NXCD, xcd = wgid % NXCD, off = wgid / NXCD; wgid = (xcd < r ? xcd * (q + 1) : r * (q + 1) + (xcd - r) * q) + off; }
        const int nig = WGM * nN, gid = wgid / nig, fm = gid * WGM, gsz = (nM - fm) < WGM ? (nM - fm) : WGM;
        u.pm = fm + ((wgid % nig) % gsz); u.pn = (wgid % nig) / gsz; return true;
    }
    __device__ __forceinline__ void a_ready(const Unit&) const {}
    __device__ __forceinline__ void done(const Unit&) const {}
};

__device__ __forceinline__ unsigned cvt_pk_bf16(float lo, float hi) { unsigned r; asm volatile("v_cvt_pk_bf16_f32 %0, %1, %2" : "=v"(r) : "v"(lo), "v"(hi)); return r; }
__device__ __forceinline__ u32x4 pack8(const f32x4& a, const f32x4& b) { u32x4 w; w.x = cvt_pk_bf16(a[0], a[1]); w.y = cvt_pk_bf16(a[2], a[3]); w.z = cvt_pk_bf16(b[0], b[1]); w.w = cvt_pk_bf16(b[2], b[3]); return w; }
__device__ __forceinline__ void unpack8(const u32x4& w, f32x4& a, f32x4& b) {
    a[0] = __uint_as_float(w.x << 16); a[1] = __uint_as_float(w.x & 0xffff0000u); a[2] = __uint_as_float(w.y << 16); a[3] = __uint_as_float(w.y & 0xffff0000u);
    b[0] = __uint_as_float(w.z << 16); b[1] = __uint_as_float(w.z & 0xffff0000u); b[2] = __uint_as_float(w.w << 16); b[3] = __uint_as_float(w.w & 0xffff0000u); }
__device__ __forceinline__ float sigmoidf_fast(float x) { return __builtin_amdgcn_rcpf(1.0f + __builtin_amdgcn_exp2f(-1.4426950408889634f * x)); }

struct EpiSwiglu {
    static constexpr bool PERM = true, AFTER_DRAIN = false;
    bf16_t* H; int ldh;
    __device__ __forceinline__ void operator()(const f32x4 (&acc)[2][2][4][2], const Unit& u, int wr, int wc, int fr, int fq) const {
        const int row0 = u.pm * BM + wr * 64 + fr, col0 = u.pn * HALF + wc * 32 + 8 * fq;
#pragma unroll
        for (int ai = 0; ai < 2; ++ai)
#pragma unroll
            for (int m = 0; m < 4; ++m) {
                f32x4 h[2];
#pragma unroll
                for (int n = 0; n < 2; ++n) { const f32x4 g = acc[ai][0][m][n], up = acc[ai][1][m][n];
#pragma unroll
                    for (int j = 0; j < 4; ++j) h[n][j] = g[j] * sigmoidf_fast(g[j]) * up[j]; }
                *(u32x4*)(H + (size_t)(row0 + ai * HALF + m * 16) * ldh + col0) = pack8(h[0], h[1]);
            }
    }
};
struct EpiResid {
    static constexpr bool PERM = false, AFTER_DRAIN = false;
    const float* res_real; float* out_real; const float* res_meta; float* out_meta; float alpha;
    __device__ __forceinline__ void operator()(const f32x4 (&acc)[2][2][4][2], const Unit& u, int wr, int wc, int fr, int fq) const {
        const bool meta = u.pm >= MR / BM;
        const float* rb = meta ? res_meta : res_real + (size_t)u.pm * BM * DM; float* ob = meta ? out_meta : out_real + (size_t)u.pm * BM * DM;
        const int col0 = u.pn * BM + wc * 32 + 4 * fq;
#pragma unroll
        for (int ai = 0; ai < 2; ++ai)
#pragma unroll
            for (int m = 0; m < 4; ++m) { const size_t off = (size_t)(ai * HALF + wr * 64 + m * 16 + fr) * DM + col0;
#pragma unroll
                for (int bj = 0; bj < 2; ++bj)
#pragma unroll
                    for (int n = 0; n < 2; ++n) { const f32x4 r = *(const f32x4*)(rb + off + bj * HALF + n * 16); *(f32x4*)(ob + off + bj * HALF + n * 16) = r + alpha * acc[ai][bj][m][n]; }
                if (m & 1) asm volatile("" ::: "memory"); }
    }
};
enum { MB_PLAIN = 0, MB_WIN = 1, MB_QUP = 2, MB_GATE = 3, MB_BR1 = 4, MB_BR2 = 5 };
__device__ __forceinline__ void rope8(f32x4& v0, f32x4& v1, const float* cs) {
    const f32x4 c01 = *(const f32x4*)cs, c23 = *(const f32x4*)(cs + 4);
    const f32x4 a = v0, b = v1;
    v0[0] = a[0] * c01[0] - a[1] * c01[1]; v0[1] = a[0] * c01[1] + a[1] * c01[0]; v0[2] = a[2] * c01[2] - a[3] * c01[3]; v0[3] = a[2] * c01[3] + a[3] * c01[2];
    v1[0] = b[0] * c23[0] - b[1] * c23[1]; v1[1] = b[0] * c23[1] + b[1] * c23[0]; v1[2] = b[2] * c23[2] - b[3] * c23[3]; v1[3] = b[2] * c23[3] + b[3] * c23[2];
}
template <int MODE> struct EpiB {
    static constexpr bool PERM = true, AFTER_DRAIN = false;
    bf16_t* O; int ldc; const float* bias; const bf16_t* G; const bf16_t* T1; const float* rope;
    __device__ __forceinline__ void operator()(const f32x4 (&acc)[2][2][4][2], const Unit& u, int wr, int wc, int fr, int fq) const {
        const int row0 = u.pm * BM + wr * 64 + fr, colt = u.pn * BM + wc * 32 + 8 * fq;
#pragma unroll
        for (int ai = 0; ai < 2; ++ai)
#pragma unroll
            for (int m = 0; m < 4; ++m) { const int row = row0 + ai * HALF + m * 16;
                const int pos = row < MR ? NMETA + (row & (SEQ - 1)) : (row - MR);
#pragma unroll
                for (int bj = 0; bj < 2; ++bj) { const int col0 = colt + bj * HALF; f32x4 v0 = acc[ai][bj][m][0], v1 = acc[ai][bj][m][1];
                    if (MODE == MB_WIN) { if (col0 >= PC_KR && col0 < INW) rope8(v0, v1, rope + ((size_t)pos * 32 + ((col0 - PC_KR) >> 1)) * 2); }
                    if (MODE == MB_QUP) { const int d0 = col0 % 192; if (d0 >= 128) rope8(v0, v1, rope + ((size_t)pos * 32 + ((d0 - 128) >> 1)) * 2); }
                    if (MODE == MB_GATE) { const f32x4 b0 = *(const f32x4*)(bias + col0), b1 = *(const f32x4*)(bias + col0 + 4);
#pragma unroll
                        for (int j = 0; j < 4; ++j) { v0[j] = sigmoidf_fast(v0[j] + b0[j]); v1[j] = sigmoidf_fast(v1[j] + b1[j]); } }
                    if (MODE == MB_BR1) { f32x4 g0, g1; unpack8(*(const u32x4*)(G + (size_t)row * (2 * DM) + col0), g0, g1); v0 = v0 * g0; v1 = v1 * g1; }
                    if (MODE == MB_BR2) { f32x4 g0, g1, t0, t1; unpack8(*(const u32x4*)(G + (size_t)row * (2 * DM) + DM + col0), g0, g1); unpack8(*(const u32x4*)(T1 + (size_t)row * DM + col0), t0, t1);
                        v0 = t0 + v0 * g0; v1 = t1 + v1 * g1; }
                    *(u32x4*)(O + (size_t)row * ldc + col0) = pack8(v0, v1); } }
    }
};

template <class Epi, class Sched, bool ALIGN_EPI = false, bool SP2 = false>
__device__ __forceinline__ void gemm_phase(PG8_LAS unsigned char* lds, const Gemm g, const Sched& S, const Epi& E) {
    const int tid = threadIdx.x, wid = __builtin_amdgcn_readfirstlane(tid >> 6), lane = tid & 63, wr = wid >> 2, wc = wid & 3, fr = lane & 15, fq = lane >> 4;
    const int K = g.K, nt = K / BK;
    unsigned voffA[2], voffB[2];
#pragma unroll
    for (int i = 0; i < 2; ++i) { int R, C; stage_rc(tid * 16 + i * 8192, R, C); const int Rb = Epi::PERM ? ((R & ~31) + perm32(R & 31)) : R;
        voffA[i] = (unsigned)(R * g.lda + C) * 2u; voffB[i] = (unsigned)(Rb * g.ldb + C) * 2u; }
    const size_t kstep = (size_t)(BK * 2);
    const size_t hstepA = (size_t)HALF * g.lda * 2, hstepB = (size_t)HALF * g.ldb * 2;
    const size_t tstepA = 2 * hstepA, tstepB = 2 * hstepB;
    const unsigned ldsw = (unsigned)wid * 1024u;
    const int aoff = lds_byte(wr * 64 + fr, fq * 8), boff = lds_byte(wc * 32 + fr, fq * 8);
#define PG8_SA(b, h) (((b) * 2 + (h)) * HTB)
#define PG8_SB(b, h) ((4 + (b) * 2 + (h)) * HTB)
#define PG8_STAGE(bufoff, gbase, voff) do { _Pragma("unroll") for (int _i = 0; _i < 2; ++_i) \
        __builtin_amdgcn_global_load_lds((const unsigned*)((const char*)(gbase) + (voff)[_i]), (PG8_LAS unsigned*)(lds + (bufoff) + ldsw + _i * 8192), 16, 0, 0); } while (0)
#define PG8_LDA(dst, b, h) do { _Pragma("unroll") for (int m = 0; m < 4; ++m) _Pragma("unroll") for (int k = 0; k < 2; ++k) dst[m][k] = *(const PG8_LAS bf16x8*)(lds + PG8_SA(b, h) + aoff + m * 2048 + k * 1024); } while (0)
#define PG8_LDB(dst, b, h) do { _Pragma("unroll") for (int n = 0; n < 2; ++n) _Pragma("unroll") for (int k = 0; k < 2; ++k) dst[n][k] = *(const PG8_LAS bf16x8*)(lds + PG8_SB(b, h) + boff + n * 2048 + k * 1024); } while (0)
#define PG8_MMA(ai, bj, At, Bt) do { __builtin_amdgcn_s_setprio(1); _Pragma("unroll") for (int m = 0; m < 4; ++m) _Pragma("unroll") for (int n = 0; n < 2; ++n) _Pragma("unroll") for (int k = 0; k < 2; ++k) \
        acc[ai][bj][m][n] = __builtin_amdgcn_mfma_f32_16x16x32_bf16(Bt[n][k], At[m][k], acc[ai][bj][m][n], 0, 0, 0); __builtin_amdgcn_s_setprio(0); } while (0)
#define PG8_WAIT_V(n) asm volatile("s_waitcnt vmcnt(" #n ")" ::: "memory")
#define PG8_WAIT_L(n) asm volatile("s_waitcnt lgkmcnt(" #n ")" ::: "memory")
#define PG8_BAR __builtin_amdgcn_s_barrier()
#define PG8_SCHED __builtin_amdgcn_sched_barrier(0)
    Unit cur, nxt; int ui = 0;
    if (!S.next(0, cur)) return;
    f32x4 acc[2][2][4][2];
#pragma unroll
    for (int a = 0; a < 2; ++a)
#pragma unroll
        for (int b = 0; b < 2; ++b)
#pragma unroll
            for (int m = 0; m < 4; ++m)
#pragma unroll
                for (int n = 0; n < 2; ++n) acc[a][b][m][n] = (f32x4){0.f, 0.f, 0.f, 0.f};
    bf16x8 At[4][2], B0[2][2], B1[2][2];
    const char* cA = (const char*)g.A + (size_t)cur.pm * tstepA; const char* cB = (const char*)g.Bt + (size_t)cur.pn * tstepB;
    S.a_ready(cur);
    if constexpr (SP2) {
        PG8_STAGE(PG8_SB(0, 0), cB, voffB); PG8_STAGE(PG8_SB(0, 1), cB + hstepB, voffB); PG8_STAGE(PG8_SA(0, 0), cA, voffA); PG8_STAGE(PG8_SA(0, 1), cA + hstepA, voffA);
        if (wr == 1) PG8_BAR;
        PG8_WAIT_V(2); PG8_BAR;
        PG8_STAGE(PG8_SB(1, 0), cB + kstep, voffB); PG8_STAGE(PG8_SA(1, 0), cA + kstep, voffA); PG8_STAGE(PG8_SB(1, 1), cB + hstepB + kstep, voffB);
        PG8_WAIT_V(6); PG8_BAR;
    } else {
        PG8_STAGE(PG8_SB(0, 0), cB, voffB); PG8_STAGE(PG8_SA(0, 0), cA, voffA); PG8_STAGE(PG8_SB(0, 1), cB + hstepB, voffB); PG8_STAGE(PG8_SA(0, 1), cA + hstepA, voffA);
        if (wr == 1) PG8_BAR;
        PG8_WAIT_V(4); PG8_BAR;
        PG8_STAGE(PG8_SB(1, 0), cB + kstep, voffB); PG8_STAGE(PG8_SA(1, 0), cA + kstep, voffA); PG8_STAGE(PG8_SB(1, 1), cB + hstepB + kstep, voffB);
        PG8_WAIT_V(6); PG8_BAR;
    }
    for (;;) {
        const bool has_next = S.next(ui + 1, nxt);
        const char* nA = has_next ? (const char*)g.A + (size_t)nxt.pm * tstepA : cA; const char* nB = has_next ? (const char*)g.Bt + (size_t)nxt.pn * tstepB : cB;
        for (int t = 0; t < nt; t += 2) {
            const bool last = (t == nt - 2);
            const char* a1 = cA + (size_t)(t + 1) * kstep;
            const char* a2 = last ? nA : cA + (size_t)(t + 2) * kstep; const char* b2 = last ? nB : cB + (size_t)(t + 2) * kstep;
            const char* a3 = a2 + kstep; const char* b3 = b2 + kstep;
            if (last && has_next) S.a_ready(nxt);
            if constexpr (SP2) {
            PG8_LDB(B0, 0, 0); PG8_LDB(B1, 0, 1); PG8_SCHED; PG8_LDA(At, 0, 0); PG8_STAGE(PG8_SA(1, 1), a1 + hstepA, voffA);
            PG8_WAIT_V(8); PG8_WAIT_L(0); PG8_BAR; PG8_MMA(0, 0, At, B0); PG8_MMA(0, 1, At, B1); PG8_BAR; PG8_SCHED;
            PG8_LDA(At, 0, 1); PG8_STAGE(PG8_SB(0, 0), b2, voffB); PG8_STAGE(PG8_SB(0, 1), b2 + hstepB, voffB); PG8_STAGE(PG8_SA(0, 0), a2, voffA);
            PG8_WAIT_V(8); PG8_WAIT_L(0); PG8_BAR; PG8_MMA(1, 0, At, B0); PG8_MMA(1, 1, At, B1); PG8_BAR; PG8_SCHED;
            PG8_LDB(B0, 1, 0); PG8_LDB(B1, 1, 1); PG8_SCHED; PG8_LDA(At, 1, 0); PG8_STAGE(PG8_SA(0, 1), a2 + hstepA, voffA);
            PG8_WAIT_V(8); PG8_WAIT_L(0); PG8_BAR; PG8_MMA(0, 0, At, B0); PG8_MMA(0, 1, At, B1); PG8_BAR; PG8_SCHED;
            PG8_LDA(At, 1, 1); PG8_STAGE(PG8_SB(1, 0), b3, voffB); PG8_STAGE(PG8_SB(1, 1), b3 + hstepB, voffB); PG8_STAGE(PG8_SA(1, 0), a3, voffA);
            PG8_WAIT_V(8); PG8_WAIT_L(0); PG8_BAR; PG8_MMA(1, 0, At, B0); PG8_MMA(1, 1, At, B1); PG8_BAR; PG8_SCHED;
            } else {
            PG8_LDB(B0, 0, 0); PG8_SCHED; PG8_LDA(At, 0, 0); PG8_STAGE(PG8_SA(1, 1), a1 + hstepA, voffA);
            PG8_WAIT_L(8); PG8_BAR; PG8_WAIT_L(0); PG8_MMA(0, 0, At, B0); PG8_BAR; PG8_SCHED;
            PG8_LDB(B1, 0, 1); PG8_STAGE(PG8_SB(0, 0), b2, voffB);
            PG8_BAR; PG8_WAIT_L(0); PG8_MMA(0, 1, At, B1); PG8_BAR;
            PG8_LDA(At, 0, 1); PG8_STAGE(PG8_SA(0, 0), a2, voffA);
            PG8_BAR; PG8_WAIT_L(0); PG8_MMA(1, 0, At, B0); PG8_BAR; PG8_SCHED;
            PG8_STAGE(PG8_SB(0, 1), b2 + hstepB, voffB);
            PG8_WAIT_V(6); PG8_BAR; PG8_MMA(1, 1, At, B1); PG8_BAR;
            PG8_LDB(B0, 1, 0); PG8_SCHED; PG8_LDA(At, 1, 0); PG8_STAGE(PG8_SA(0, 1), a2 + hstepA, voffA);
            PG8_WAIT_L(8); PG8_BAR; PG8_WAIT_L(0); PG8_MMA(0, 0, At, B0); PG8_BAR; PG8_SCHED;
            PG8_LDB(B1, 1, 1); PG8_STAGE(PG8_SB(1, 0), b3, voffB);
            PG8_BAR; PG8_WAIT_L(0); PG8_MMA(0, 1, At, B1); PG8_BAR;
            PG8_LDA(At, 1, 1); PG8_STAGE(PG8_SA(1, 0), a3, voffA);
            PG8_BAR; PG8_WAIT_L(0); PG8_MMA(1, 0, At, B0); PG8_BAR; PG8_SCHED;
            PG8_STAGE(PG8_SB(1, 1), b3 + hstepB, voffB);
            PG8_WAIT_V(6); PG8_BAR; PG8_MMA(1, 1, At, B1); PG8_BAR;
            }
        }
        if constexpr (ALIGN_EPI) { if (wr == 0) PG8_BAR; }
        if constexpr (!Epi::AFTER_DRAIN) { E(acc, cur, wr, wc, fr, fq); S.done(cur); }
        if (!has_next) break;
#pragma unroll
        for (int a = 0; a < 2; ++a)
#pragma unroll
            for (int b = 0; b < 2; ++b)
#pragma unroll
                for (int m = 0; m < 4; ++m)
#pragma unroll
                    for (int n = 0; n < 2; ++n) acc[a][b][m][n] = (f32x4){0.f, 0.f, 0.f, 0.f};
        cur = nxt; cA = nA; cB = nB; ++ui;
        if constexpr (ALIGN_EPI) { if (wr == 1) PG8_BAR; }
    }
    PG8_WAIT_V(0);
    if constexpr (!ALIGN_EPI) { if (wr == 0) PG8_BAR; }
    PG8_BAR;
    if constexpr (Epi::AFTER_DRAIN) { E.fused(acc, cur, wr, wc, fr, fq, lds, wid, lane); S.done(cur); }
#undef PG8_SA
#undef PG8_SB
#undef PG8_STAGE
#undef PG8_LDA
#undef PG8_LDB
#undef PG8_MMA
#undef PG8_WAIT_V
#undef PG8_WAIT_L
#undef PG8_BAR
#undef PG8_SCHED
}
}

namespace att {
typedef unsigned short bf16;
using bf16x8 = __attribute__((ext_vector_type(8))) short;
using s16x4  = __attribute__((ext_vector_type(4))) short;
using f32x16 = __attribute__((ext_vector_type(16))) float;
using u32x4  = __attribute__((ext_vector_type(4))) unsigned;
constexpr int NW = 8, QBLK = 32, KVBLK = 64, NT = SEQ / KVBLK + 1;
constexpr float THR = 8.f;
constexpr int SHM_V = KVBLK * 128 * 2;
template <int DQK> constexpr int shm_k() { return KVBLK * DQK * 2; }
template <int DQK> constexpr int nqreg() { return DQK == 192 ? 6 : 8; }
template <int DQK> constexpr int shm_total() { return 2 * SHM_V + 2 * shm_k<DQK>() + NW * 64 * 4 + NW * 1024 * (DQK / 16 - nqreg<DQK>()); }
#define ATT_SBAR() __builtin_amdgcn_sched_barrier(0)
__device__ __forceinline__ int crow(int r, int hi) { return (r & 3) + 8 * (r >> 2) + 4 * hi; }
__device__ __forceinline__ unsigned cvtpk(float lo, float hi) { unsigned r; asm volatile("v_cvt_pk_bf16_f32 %0, %1, %2" : "=v"(r) : "v"(lo), "v"(hi)); return r; }
template <int DQK> __device__ __forceinline__ int kswz(int row, int colB) {
    if constexpr (DQK == 128) return row * 256 + (colB ^ ((row & 7) << 4));
    else return row * 384 + (colB ^ (((row >> 1) & 7) << 4));
}
template <int DQK> __device__ __forceinline__ void partialSM(f32x16& p0, f32x16& p1, float& m_reg, float& mn, float& alpha) {
    constexpr float SCALE = DQK == 128 ? 0.08838834764831845f : 0.07216878364870322f;
    constexpr float C = SCALE * 1.4426950408889634f;
    float pmax = p0[0];
#pragma unroll
    for (int r = 1; r < 16; ++r) pmax = fmaxf(pmax, p0[r]);
#pragma unroll
    for (int r = 0; r < 16; ++r) pmax = fmaxf(pmax, p1[r]);
    { auto rr = __builtin_amdgcn_permlane32_swap(__float_as_uint(pmax), __float_as_uint(pmax), false, false);
      pmax = fmaxf(__uint_as_float(rr[0]), __uint_as_float(rr[1])); }
    if (__builtin_expect(__all(pmax - m_reg <= THR / SCALE), 1)) { mn = m_reg; alpha = 1.f; }
    else { mn = fmaxf(m_reg, pmax); alpha = __builtin_amdgcn_exp2f((m_reg - mn) * C); m_reg = mn; }
    const float mnC = -mn * C;
#pragma unroll
    for (int r = 0; r < 16; ++r) p0[r] = fmaf(p0[r], C, mnC);
#pragma unroll
    for (int r = 0; r < 16; ++r) p1[r] = fmaf(p1[r], C, mnC);
#pragma unroll
    for (int r = 0; r < 16; ++r) p0[r] = __builtin_amdgcn_exp2f(p0[r]);
}
__device__ __forceinline__ void finishSM(f32x16& p0, f32x16& p1, float alpha, float& l_reg, bf16x8& pa0, bf16x8& pa1, bf16x8& pa2, bf16x8& pa3) {
#pragma unroll
    for (int r = 0; r < 16; ++r) p1[r] = __builtin_amdgcn_exp2f(p1[r]);
    float ps = 0;
#pragma unroll
    for (int r = 0; r < 16; ++r) ps += p0[r];
#pragma unroll
    for (int r = 0; r < 16; ++r) ps += p1[r];
    { auto rr = __builtin_amdgcn_permlane32_swap(__float_as_uint(ps), __float_as_uint(ps), false, false);
      ps = __uint_as_float(rr[0]) + __uint_as_float(rr[1]); }
    l_reg = l_reg * alpha + ps;
#define ATT_PK4(P, BASE, OUT) do { unsigned a0 = cvtpk(P[BASE + 0], P[BASE + 1]), a1 = cvtpk(P[BASE + 2], P[BASE + 3]);   \
    unsigned b0 = cvtpk(P[BASE + 4], P[BASE + 5]), b1 = cvtpk(P[BASE + 6], P[BASE + 7]);                              \
    auto r0 = __builtin_amdgcn_permlane32_swap(a0, b0, false, false); auto r1 = __builtin_amdgcn_permlane32_swap(a1, b1, false, false); \
    u32x4 w = {r0[0], r1[0], r0[1], r1[1]}; OUT = *reinterpret_cast<bf16x8*>(&w); } while (0)
    ATT_PK4(p0, 0, pa0); ATT_PK4(p0, 8, pa1); ATT_PK4(p1, 0, pa2); ATT_PK4(p1, 8, pa3);
#undef ATT_PK4
}
template <int DQK> __device__ __forceinline__ void qkt(f32x16& p0, f32x16& p1, const char* Ks, const bf16x8* qr, const char* qp, int r32, int hi) {
#pragma unroll
    for (int d0 = 0; d0 < DQK / 16; ++d0) { const int cb = (d0 * 16 + hi * 8) * 2;
        const bf16x8 b0 = *reinterpret_cast<const bf16x8*>(Ks + kswz<DQK>(r32, cb));
        const bf16x8 b1 = *reinterpret_cast<const bf16x8*>(Ks + kswz<DQK>(32 + r32, cb));
        bf16x8 qv; if (d0 < nqreg<DQK>()) qv = qr[d0]; else qv = *reinterpret_cast<const bf16x8*>(qp + (d0 - nqreg<DQK>()) * 1024);
        p0 = __builtin_amdgcn_mfma_f32_32x32x16_bf16(b0, qv, p0, 0, 0, 0);
        p1 = __builtin_amdgcn_mfma_f32_32x32x16_bf16(b1, qv, p1, 0, 0, 0); }
}
__device__ __forceinline__ int v_st(int k, int c) { const int kk = (k & ~0xC) | ((k & 4) << 1) | ((k & 8) >> 1); return ((kk >> 3) * 4 + (c >> 5)) * 512 + ((kk & 7) * 32 + (c & 31)) * 2; }
__device__ __forceinline__ int v_rd_base(int lane) { return ((lane & 3) << 3) | (((lane >> 2) & 3) << 6) | (((lane >> 4) & 1) << 5) | (((lane >> 5) & 1) << 8); }
constexpr int v_rd_off(int d0, int ks, int half) { return d0 * 512 + ks * 4096 + half * 2048; }
template <int OFF> __device__ __forceinline__ s16x4 tr_read(int vb) { s16x4 r; asm volatile("ds_read_b64_tr_b16 %0, %1 offset:%2" : "=&v"(r) : "v"(vb), "i"(OFF) : "memory"); return r; }
template <int D0> __device__ __forceinline__ void pv_one(f32x16& od, int vb, bf16x8 pa0, bf16x8 pa1, bf16x8 pa2, bf16x8 pa3) {
    const s16x4 l0 = tr_read<v_rd_off(D0, 0, 0)>(vb), h0 = tr_read<v_rd_off(D0, 0, 1)>(vb), l1 = tr_read<v_rd_off(D0, 1, 0)>(vb), h1 = tr_read<v_rd_off(D0, 1, 1)>(vb);
    const s16x4 l2 = tr_read<v_rd_off(D0, 2, 0)>(vb), h2 = tr_read<v_rd_off(D0, 2, 1)>(vb), l3 = tr_read<v_rd_off(D0, 3, 0)>(vb), h3 = tr_read<v_rd_off(D0, 3, 1)>(vb);
    asm volatile("s_waitcnt lgkmcnt(0)" ::: "memory"); ATT_SBAR();
#define ATT_PK(L, H) (bf16x8){L[0], L[1], L[2], L[3], H[0], H[1], H[2], H[3]}
    od = __builtin_amdgcn_mfma_f32_32x32x16_bf16(pa0, ATT_PK(l0, h0), od, 0, 0, 0);
    od = __builtin_amdgcn_mfma_f32_32x32x16_bf16(pa1, ATT_PK(l1, h1), od, 0, 0, 0);
    od = __builtin_amdgcn_mfma_f32_32x32x16_bf16(pa2, ATT_PK(l2, h2), od, 0, 0, 0);
    od = __builtin_amdgcn_mfma_f32_32x32x16_bf16(pa3, ATT_PK(l3, h3), od, 0, 0, 0);
#undef ATT_PK
}
__device__ __forceinline__ void pv_d0(f32x16* o, int vb, bf16x8 pa0, bf16x8 pa1, bf16x8 pa2, bf16x8 pa3) {
    pv_one<0>(o[0], vb, pa0, pa1, pa2, pa3); pv_one<1>(o[1], vb, pa0, pa1, pa2, pa3); pv_one<2>(o[2], vb, pa0, pa1, pa2, pa3); pv_one<3>(o[3], vb, pa0, pa1, pa2, pa3);
}
template <bool ALIBI> __device__ __forceinline__ void init_real(f32x16& p0, f32x16& p1, float dq, float nslope) {
    if constexpr (ALIBI) {
#pragma unroll
        for (int r = 0; r < 16; ++r) { const float cr = (float)((r & 3) + 8 * (r >> 2)); p0[r] = nslope * fabsf(dq - cr); p1[r] = nslope * fabsf(dq - (cr + 32.f)); }
    } else { p0 = f32x16{}; p1 = f32x16{}; }
}
__device__ __forceinline__ void init_meta(f32x16& p0, f32x16& p1) {
#pragma unroll
    for (int r = 0; r < 16; ++r) { p0[r] = (r < 8) ? 0.f : -1e30f; p1[r] = -1e30f; }
}

template <int DQK, bool ALIBI, int SDEPTH>
__device__ __forceinline__ void attn_unit(const bf16* __restrict__ Qb, const int ldq,
                                          const bf16* __restrict__ K0, const int ldk0, const bf16* __restrict__ K1, const int ldk1,
                                          const bf16* __restrict__ Vg, const int ldv, bf16* __restrict__ Ob, const int ldo,
                                          const int kbase, const int q0, const float nslope, char* lds) {
    constexpr int SHM_K = shm_k<DQK>(), ND0 = DQK / 16, NLD = (DQK == 192) ? 5 : 4;
    const int tid = threadIdx.x, wid = tid >> 6, lane = tid & 63, r32 = lane & 31, hi = lane >> 5;
    char* V_lds = lds; char* K_lds = lds + 2 * SHM_V;
    float* ws = (float*)(lds + 2 * SHM_V + 2 * SHM_K) + wid * 64; float* li_l = ws; float* al_l = ws + 32;
    constexpr int NQR = nqreg<DQK>();
    float m_reg = -1e30f, l_reg = 0; f32x16 o[4] = {}; bf16x8 qr[NQR];
    const bf16* Qw = Qb + (long)(wid * QBLK + r32) * ldq + hi * 8;
    char* const qp = lds + 2 * SHM_V + 2 * SHM_K + NW * 64 * 4 + wid * (1024 * (ND0 - NQR)) + hi * 512 + r32 * 16;
#pragma unroll
    for (int d0 = 0; d0 < NQR; ++d0) qr[d0] = *reinterpret_cast<const bf16x8*>(Qw + d0 * 16);
#pragma unroll
    for (int d0 = NQR; d0 < ND0; ++d0) *reinterpret_cast<bf16x8*>(qp + (d0 - NQR) * 1024) = *reinterpret_cast<const bf16x8*>(Qw + d0 * 16);
    const int sr = tid >> 4, sc = (tid & 15) * 8, vst0 = v_st(sr, sc), vst1 = v_st(32 + sr, sc);
    const int kr2 = tid >> 3, sc2 = (tid & 7) * 8;
    const int vb0 = (int)(uintptr_t)V_lds + v_rd_base(lane);
    struct { bf16x8 vs0, vs1, ks0, ks1, ks2; } sr_[SDEPTH];
    const float qs = (float)(q0 + wid * QBLK + r32 - 4 * hi);
#define ATT_SLOAD(i, t) do { const int t_ = (t); const long g0 = t_ == 0 ? (long)(MR + (sr & 15)) : (long)(kbase + (t_ - 1) * KVBLK + sr); const long g1 = t_ == 0 ? g0 : g0 + 32; \
        sr_[i].vs0 = *reinterpret_cast<const bf16x8*>(Vg + g0 * ldv + sc); sr_[i].vs1 = *reinterpret_cast<const bf16x8*>(Vg + g1 * ldv + sc); \
        sr_[i].ks0 = *reinterpret_cast<const bf16x8*>(K0 + g0 * ldk0 + sc); sr_[i].ks1 = *reinterpret_cast<const bf16x8*>(K0 + g1 * ldk0 + sc); \
        if constexpr (DQK == 192) { const long g2 = t_ == 0 ? (long)(MR + (kr2 & 15)) : (long)(kbase + (t_ - 1) * KVBLK + kr2); sr_[i].ks2 = *reinterpret_cast<const bf16x8*>(K1 + g2 * ldk1 + sc2); } } while (0)
#define ATT_SWRITE(b, i) do { *(bf16x8*)(V_lds + (b) * SHM_V + vst0) = sr_[i].vs0; *(bf16x8*)(V_lds + (b) * SHM_V + vst1) = sr_[i].vs1; \
        *(bf16x8*)(K_lds + (b) * SHM_K + kswz<DQK>(sr, sc * 2)) = sr_[i].ks0; *(bf16x8*)(K_lds + (b) * SHM_K + kswz<DQK>(32 + sr, sc * 2)) = sr_[i].ks1; \
        if constexpr (DQK == 192) *(bf16x8*)(K_lds + (b) * SHM_K + kswz<DQK>(kr2, (128 + sc2) * 2)) = sr_[i].ks2; } while (0)
#define ATT_SWAIT() do { if constexpr (SDEPTH == 2) { if constexpr (NLD == 5) asm volatile("s_waitcnt vmcnt(5)" ::: "memory"); else asm volatile("s_waitcnt vmcnt(4)" ::: "memory"); } \
        else asm volatile("s_waitcnt vmcnt(0)" ::: "memory"); } while (0)
#define ATT_RESC(a) do { if (__any((a) < 1.f)) { if (hi == 0) al_l[r32] = (a); asm volatile("s_waitcnt lgkmcnt(0)" ::: "memory"); \
        _Pragma("unroll") for (int d = 0; d < 4; ++d) _Pragma("unroll") for (int r = 0; r < 16; ++r) o[d][r] *= al_l[crow(r, hi)]; } } while (0)
    f32x16 pA0, pA1, pB0, pB1; float mnA, mnB, alA, alB; bf16x8 pa0, pa1, pa2, pa3;
    constexpr int SE = 0, SO = SDEPTH - 1;
    ATT_SLOAD(SE, 0); asm volatile("s_waitcnt vmcnt(0)" ::: "memory"); ATT_SWRITE(0, SE); __syncthreads();
    init_meta(pA0, pA1); qkt<DQK>(pA0, pA1, K_lds, qr, qp, r32, hi); partialSM<DQK>(pA0, pA1, m_reg, mnA, alA);
    ATT_SLOAD(SO, 1); if constexpr (SDEPTH == 2) ATT_SLOAD(SE, 2);
    ATT_SWAIT(); ATT_SWRITE(1, SO); __syncthreads();
    for (int j = 1; j + 1 < NT; j += 2) {
        ATT_SBAR(); init_real<ALIBI>(pB0, pB1, qs - (float)((j - 1) * KVBLK), nslope); qkt<DQK>(pB0, pB1, K_lds + SHM_K, qr, qp, r32, hi);
        finishSM(pA0, pA1, alA, l_reg, pa0, pa1, pa2, pa3); ATT_SBAR();
        { const int tn = j + SDEPTH; ATT_SLOAD(SO, tn < NT ? tn : NT - 1); } ATT_SBAR();
        pv_d0(o, vb0, pa0, pa1, pa2, pa3); partialSM<DQK>(pB0, pB1, m_reg, mnB, alB);
        __syncthreads(); ATT_SWAIT(); ATT_SWRITE(0, SE);
        ATT_RESC(alB); __syncthreads();
        ATT_SBAR(); init_real<ALIBI>(pA0, pA1, qs - (float)(j * KVBLK), nslope); qkt<DQK>(pA0, pA1, K_lds, qr, qp, r32, hi);
        finishSM(pB0, pB1, alB, l_reg, pa0, pa1, pa2, pa3); ATT_SBAR();
        { const int tn = j + 1 + SDEPTH; ATT_SLOAD(SE, tn < NT ? tn : NT - 1); } ATT_SBAR();
        pv_d0(o, vb0 + SHM_V, pa0, pa1, pa2, pa3); partialSM<DQK>(pA0, pA1, m_reg, mnA, alA);
        __syncthreads(); ATT_SWAIT(); ATT_SWRITE(1, SO);
        ATT_RESC(alA); __syncthreads();
    }
    finishSM(pA0, pA1, alA, l_reg, pa0, pa1, pa2, pa3); ATT_SBAR();
    pv_d0(o, vb0, pa0, pa1, pa2, pa3);
    asm volatile("s_waitcnt vmcnt(0)" ::: "memory");
    if (hi == 0) li_l[r32] = l_reg; asm volatile("s_waitcnt lgkmcnt(0)" ::: "memory");
    float rli[16];
#pragma unroll
    for (int r = 0; r < 16; ++r) rli[r] = __builtin_amdgcn_rcpf(li_l[crow(r, hi)]);
    bf16* Ow = Ob + (long)(wid * QBLK) * ldo;
#pragma unroll
    for (int r = 0; r < 16; ++r) { const int orow = crow(r, hi);
#pragma unroll
        for (int d0 = 0; d0 < 4; d0 += 1) { const unsigned w = cvtpk(o[d0][r] * rli[r], 0.f); Ow[(long)orow * ldo + d0 * 32 + r32] = (bf16)(w & 0xffffu); } }
    __syncthreads();
#undef ATT_SLOAD
#undef ATT_SWRITE
#undef ATT_SWAIT
#undef ATT_RESC
}
#undef ATT_SBAR
}

constexpr int NWAVES = 8;
constexpr int NPH = 16;
#ifndef MK_N_LAUNCHES
#define MK_N_LAUNCHES 1
#endif
constexpr int N_LAUNCHES = MK_N_LAUNCHES;
#ifndef MLA_SDEPTH
#define MLA_SDEPTH 1
#endif

constexpr size_t MiB = 1u << 20;
constexpr size_t WS_CTL = 0, CTL_ZERO_BYTES = 1 * MiB;
constexpr size_t WS_ROPE = 1 * MiB;
constexpr size_t WS_MX0 = 4 * MiB, WS_MX1 = 8 * MiB;
constexpr size_t WS_W1GU = 16 * MiB, WS_W1D = 188 * MiB, WS_W2GU = 274 * MiB, WS_W2D = 446 * MiB;
constexpr size_t WS_WIN = 532 * MiB, WS_WG = 594 * MiB, WS_WUQ = 658 * MiB, WS_WUKV = 664 * MiB, WS_WBD = 668 * MiB, WS_WBM = 684 * MiB, WS_WO = 700 * MiB;
constexpr size_t WS_XN = 732 * MiB;
constexpr size_t WS_H = 862 * MiB;
constexpr size_t WS_P = 862 * MiB;
constexpr size_t WS_CQN = 1114 * MiB, WS_CKVN = 1147 * MiB;
constexpr size_t WS_QM = 1164 * MiB;
constexpr size_t WS_KV = 1262 * MiB;
constexpr size_t WS_ORAW = 1392 * MiB;
constexpr size_t WS_OM = 1520 * MiB, WS_OD = 1584 * MiB;
constexpr size_t WS_GATES = 862 * MiB;
constexpr size_t WS_T1 = 1164 * MiB;
constexpr size_t WS_MERGED = 1292 * MiB;
constexpr size_t WS_END = 1648 * MiB;
static_assert(WS_W1GU + (size_t)2 * DFF * DM * 2 <= WS_W1D && WS_W1D + (size_t)DM * DFF * 2 <= WS_W2GU && WS_W2GU + (size_t)2 * DFF * DM * 2 <= WS_W2D && WS_W2D + (size_t)DM * DFF * 2 <= WS_WIN, "ws map 1");
static_assert(WS_WIN + (size_t)INWP * DM * 2 <= WS_WG && WS_WG + (size_t)2 * DM * DM * 2 <= WS_WUQ && WS_WUQ + (size_t)3072 * 1024 * 2 <= WS_WUKV && WS_WUKV + (size_t)4096 * 512 * 2 <= WS_WBD, "ws map 2");
static_assert(WS_WBD + (size_t)DM * 2048 * 2 <= WS_WBM && WS_WBM + (size_t)DM * 2048 * 2 <= WS_WO && WS_WO + (size_t)DM * DM * 2 <= WS_XN && WS_XN + (size_t)MP * DM * 2 <= WS_H, "ws map 3");
static_assert(WS_H + (size_t)MP * DFF * 2 <= WS_END && WS_P + (size_t)MP * INWP * 2 <= WS_CQN && WS_CQN + (size_t)MP * 1024 * 2 <= WS_CKVN && WS_CKVN + (size_t)MP * 512 * 2 <= WS_QM, "ws map 4");
static_assert(WS_QM + (size_t)MP * 3072 * 2 <= WS_KV && WS_KV + (size_t)MP * 4096 * 2 <= WS_ORAW && WS_ORAW + (size_t)MR * 4096 * 2 <= WS_OM && WS_OM + (size_t)MR * 2048 * 2 <= WS_OD && WS_OD + (size_t)MR * 2048 * 2 <= WS_END, "ws map 5");
static_assert(WS_GATES + (size_t)MR * 2 * DM * 2 <= WS_QM && WS_T1 + (size_t)MR * DM * 2 <= WS_MERGED && WS_MERGED + (size_t)MR * DM * 2 <= WS_OM, "ws map 6");
static_assert(WS_ROPE + (size_t)(SEQ + NMETA) * 32 * 8 <= WS_MX0 && WS_MX0 + (size_t)256 * DM * 4 <= WS_MX1 && WS_MX1 + (size_t)256 * DM * 4 <= WS_W1GU, "ws map 7");
constexpr int CW_BAR = 4096;

constexpr int RING_OFF = 0, RING_BYTES = 155648;
constexpr int LDSCTL_OFF = RING_BYTES, MISC_OFF = LDSCTL_OFF + 320;
constexpr int LDS_BYTES = 156672;
static_assert(att::shm_total<128>() <= RING_BYTES && att::shm_total<192>() <= RING_BYTES && pg8::STAGE_BYTES <= RING_BYTES && LDS_BYTES <= 163840, "LDS map");
static_assert(MISC_OFF + 128 <= LDS_BYTES, "LDS map");

#define GAS __attribute__((address_space(1)))
#define LAS __attribute__((address_space(3)))
typedef unsigned short bf16;
typedef unsigned v4u __attribute__((ext_vector_type(4)));
typedef unsigned v2u __attribute__((ext_vector_type(2)));
typedef float f32x4 __attribute__((ext_vector_type(4)));
typedef GAS unsigned gu32;
#define RLX_AGENT __ATOMIC_RELAXED, __HIP_MEMORY_SCOPE_AGENT
#define LDS_WAIT() asm volatile("s_waitcnt lgkmcnt(0)" ::: "memory")
#define VM_WAIT() asm volatile("s_waitcnt vmcnt(0)" ::: "memory")
__device__ __forceinline__ unsigned f2bf(float f) { unsigned u = __builtin_bit_cast(unsigned, f); return (u + 0x7fffu + ((u >> 16) & 1u)) >> 16; }
__device__ __forceinline__ unsigned pk2(float lo, float hi) { return f2bf(lo) | (f2bf(hi) << 16); }
__device__ __forceinline__ float bflo(unsigned w) { return __uint_as_float(w << 16); }
__device__ __forceinline__ float bfhi(unsigned w) { return __uint_as_float(w & 0xffff0000u); }
__device__ __forceinline__ float wave_sum(float v) {
#pragma unroll
    for (int o = 1; o < 64; o <<= 1) v += __shfl_xor(v, o);
    return v;
}

#define XB_TMO      128
#define XB_XCNT(j)  (256  + 64 * (j))
#define XB_XSUB(j)  (1280 + 64 * (j))
#define XB_XGEN(j)  (2304 + 64 * (j))
#define XB_TOP      3328
#define XB_TOPGEN   3392
#define XCD_BAR_WORDS 3456
#define XB_SPIN_CAP (1u << 18)

__device__ __forceinline__ unsigned xb_ld(unsigned* p)              { return __hip_atomic_load(p, __ATOMIC_RELAXED, __HIP_MEMORY_SCOPE_AGENT); }
__device__ __forceinline__ unsigned xb_add(unsigned* p, unsigned v) { return __hip_atomic_fetch_add(p, v, __ATOMIC_RELAXED, __HIP_MEMORY_SCOPE_AGENT); }
__device__ __forceinline__ unsigned xb_xcc_id() { return (unsigned)__builtin_amdgcn_s_getreg((3 << 11) | 20) & 0xFu; }
#define XB_SPIN(cond, bar) do { unsigned _sp = 0; while (cond) { __builtin_amdgcn_s_sleep(1); \
    if ((++_sp & 255u) == 0u) { if (xb_ld(&(bar)[XB_TMO])) break; if (_sp > XB_SPIN_CAP) { atomicAdd(&(bar)[XB_TMO], 1u); break; } } } } while (0)

struct XcdBarrier {
    unsigned* bar; unsigned x;
    volatile LAS unsigned* st;
};

__device__ __forceinline__ XcdBarrier xcd_barrier_post(unsigned* bar, volatile LAS unsigned* st) {
    XcdBarrier b; b.bar = bar; b.x = xb_xcc_id(); b.st = st;
    if (threadIdx.x == 0) (void)xb_add(&bar[XB_XCNT(b.x)], 1u);
    return b;
}
__device__ __forceinline__ void xcd_barrier_complete(unsigned* bar, unsigned x, unsigned& nloc, unsigned& nx) {
    const unsigned G = gridDim.x * gridDim.y * gridDim.z;
    unsigned sum, cnt, mine, sp = 0u;
    for (;;) {
        sum = 0u; cnt = 0u; mine = 0u;
#pragma unroll
        for (unsigned j = 0; j < 16; ++j) { const unsigned c = xb_ld(&bar[XB_XCNT(j)]); sum += c; cnt += (c > 0u) ? 1u : 0u; mine = (j == x) ? c : mine; }
        if (sum == G) break;
        __builtin_amdgcn_s_sleep(1);
        if ((++sp & 255u) == 0u) { if (xb_ld(&bar[XB_TMO])) break; if (sp > XB_SPIN_CAP) { atomicAdd(&bar[XB_TMO], 1u); break; } }
    }
    nloc = mine > 0u ? mine : 1u; nx = cnt > 0u ? cnt : 1u;
}

__device__ __forceinline__ void xcd_barrier(const XcdBarrier& b) {
    asm volatile("s_waitcnt vmcnt(0)" ::: "memory");
    __syncthreads();
    if (threadIdx.x == 0) {
        unsigned* bar = b.bar;
        __builtin_amdgcn_s_waitcnt(0);
        unsigned nloc = b.st[0], nx = b.st[1];
        if (nloc == 0u) { xcd_barrier_complete(bar, b.x, nloc, nx); b.st[0] = nloc; b.st[1] = nx; }
        const unsigned old = xb_add(&bar[XB_XSUB(b.x)], 1u);
        const unsigned gen = old / nloc;
        if (old + 1u == (gen + 1u) * nloc) {
            __builtin_amdgcn_fence(__ATOMIC_RELEASE, "agent");
            asm volatile("s_waitcnt vmcnt(0)" ::: "memory");
            const unsigned og = xb_add(&bar[XB_TOP], 1u);
            const unsigned tg = og / nx;
            if (og + 1u == (tg + 1u) * nx) xb_add(&bar[XB_TOPGEN], 1u);
            else XB_SPIN(xb_ld(&bar[XB_TOPGEN]) == tg, bar);
            __builtin_amdgcn_fence(__ATOMIC_ACQUIRE, "agent");
            xb_add(&bar[XB_XGEN(b.x)], 1u);
            asm volatile("s_waitcnt vmcnt(0)" ::: "memory");
        } else {
            XB_SPIN(xb_ld(&bar[XB_XGEN(b.x)]) == gen, bar);
            __builtin_amdgcn_fence(__ATOMIC_ACQUIRE, "agent");
            asm volatile("s_waitcnt vmcnt(0)" ::: "memory");
        }
    }
    __syncthreads();
}

template <int MAP> __device__ __forceinline__ int map_row(int n) {
    if (MAP == 1) return 256 * (n >> 7) + (n & 127);
    if (MAP == 2) return 256 * (n >> 7) + 128 + (n & 127);
    if (MAP == 3) { if (n < PC_KR) return n; const int j = n - PC_KR; return PC_KR + (j < 32 ? 2 * j : 2 * (j - 32) + 1); }
    if (MAP == 4) { const int h = n / 192, d = n % 192; if (d < 128) return n; const int j = d - 128; return h * 192 + 128 + (j < 32 ? 2 * j : 2 * (j - 32) + 1); }
    return n;
}
template <int MAP> __device__ __forceinline__ void p0_transpose_item(const float* W, int K, int N, bf16* WT, LAS float* scr, int item, int lane) {
    const int nblk = N / 32, kb = item / nblk, nb = item % nblk, k0 = 64 * kb, n0 = 32 * nb;
#pragma unroll 8
    for (int i = 0; i < 32; ++i) { const int kk = 2 * i + (lane >> 5); scr[kk * 33 + (lane & 31)] = W[(size_t)(k0 + kk) * N + n0 + (lane & 31)]; }
    LDS_WAIT(); asm volatile("" ::: "memory");
    const int c = lane & 7;
#pragma unroll
    for (int j = 0; j < 4; ++j) { const int n = (lane >> 3) + 8 * j; const LAS float* s = scr + (8 * c) * 33 + n;
        v4u o; o.x = pk2(s[0 * 33], s[1 * 33]); o.y = pk2(s[2 * 33], s[3 * 33]); o.z = pk2(s[4 * 33], s[5 * 33]); o.w = pk2(s[6 * 33], s[7 * 33]);
        *(GAS v4u*)(WT + (size_t)map_row<MAP>(n0 + n) * K + k0 + 8 * c) = o; }
    LDS_WAIT(); asm volatile("" ::: "memory");
}
__device__ __forceinline__ void rms_row_to_bf16(const float* xrow, const float* g, bf16* orow, int lane) {
    const GAS f32x4* xr = (const GAS f32x4*)xrow + lane; const GAS f32x4* gr = (const GAS f32x4*)g + lane;
    f32x4 v[16]; float s = 0.f;
#pragma unroll
    for (int j = 0; j < 16; ++j) { v[j] = xr[64 * j]; s += (v[j].x * v[j].x + v[j].y * v[j].y) + (v[j].z * v[j].z + v[j].w * v[j].w); }
    const float rstd = 1.f / sqrtf(wave_sum(s) * (1.f / DM) + EPS);
    GAS v2u* o8 = (GAS v2u*)orow + lane;
#pragma unroll
    for (int j = 0; j < 16; ++j) { const f32x4 gg = gr[64 * j]; v2u w; w.x = pk2(v[j].x * rstd * gg.x, v[j].y * rstd * gg.y); w.y = pk2(v[j].z * rstd * gg.z, v[j].w * rstd * gg.w); o8[64 * j] = w; }
}
__device__ __forceinline__ void zero_row_bf16(bf16* orow, int nelem, int lane) {
    GAS v4u* o = (GAS v4u*)orow + lane;
    for (int j = 0; j < nelem / 512; ++j) o[64 * j] = (v4u){0u, 0u, 0u, 0u};
}
__device__ __forceinline__ void rms_row_inplace(float* xrow, const float* g, int lane) {
    GAS f32x4* xr = (GAS f32x4*)xrow + lane; const GAS f32x4* gr = (const GAS f32x4*)g + lane;
    f32x4 v[16]; float s = 0.f;
#pragma unroll
    for (int j = 0; j < 16; ++j) { v[j] = xr[64 * j]; s += (v[j].x * v[j].x + v[j].y * v[j].y) + (v[j].z * v[j].z + v[j].w * v[j].w); }
    const float rstd = 1.f / sqrtf(wave_sum(s) * (1.f / DM) + EPS);
#pragma unroll
    for (int j = 0; j < 16; ++j) { const f32x4 gg = gr[64 * j]; xr[64 * j] = v[j] * rstd * gg; }
}

struct Args { const float* in[27]; float* out; unsigned char* ws; int ph_lo, ph_hi; };
static_assert(sizeof(Args) == 27 * 8 + 8 + 8 + 8, "Args has no padding");
enum { I_X = 0, I_META, I_N1, I_W1G, I_W1U, I_W1D, I_NMIX, I_WIN, I_LQ1, I_LK1, I_LQ2, I_LK2, I_SUBLN, I_QNORM, I_WUQ, I_KVNORM, I_WUKV, I_WG, I_BG, I_WBD, I_WBM, I_WO, I_N2, I_W2G, I_W2U, I_W2D, I_NF };

__global__ void __launch_bounds__(NWAVES * 64, 2) fwd(Args  ) {
    extern __shared__ __attribute__((aligned(16))) unsigned char lds[];
    LAS unsigned char* const L = (LAS unsigned char*)lds;
    volatile LAS unsigned* const MISC = (volatile LAS unsigned*)(L + MISC_OFF);
    const int tid = threadIdx.x, lane = tid & 63, wave = __builtin_amdgcn_readfirstlane(tid >> 6);
    const int G = gridDim.x; const int bx = blockIdx.x; const int vcu = (G % 8 == 0) ? (bx % 8) * (G / 8) + bx / 8 : bx;
typedef const __attribute__((address_space(4))) Args* CArgsP;
#define KARGS() ({ CArgsP p_ = (CArgsP)__builtin_amdgcn_kernarg_segment_ptr(); asm volatile("" : "+s"(p_)); p_; })
    int lo, hi; { CArgsP A0 = KARGS(); lo = A0->ph_lo; hi = A0->ph_hi; }
    gu32* const ctl = (gu32*)(KARGS()->ws + WS_CTL);
    for (int u = tid; u < (LDS_BYTES - LDSCTL_OFF) / 4; u += NWAVES * 64) ((LAS unsigned*)(L + LDSCTL_OFF))[u] = 0u;
    __syncthreads();
    const XcdBarrier bar = xcd_barrier_post((unsigned*)(ctl + CW_BAR) + lo * XCD_BAR_WORDS, MISC + 8);
#define GRID_BAR() xcd_barrier(bar)
#ifndef PH_MASK
#define PH_MASK 0xFFFF
#endif
#define IN(k) ((((PH_MASK) >> (k)) & 1) && lo <= (k) && (k) < hi)
#define BOTH(k) (IN(k) && IN((k) + 1))
    const int gw = vcu * NWAVES + wave, NGW = G * NWAVES;
#define PHASE_PTRS() CArgsP const A = KARGS(); unsigned char* const ws = A->ws; float* const out = A->out; (void)out; \
    bf16* const XN = (bf16*)(ws + WS_XN); bf16* const HB = (bf16*)(ws + WS_H); bf16* const PB = (bf16*)(ws + WS_P); (void)XN; (void)HB; (void)PB; \
    bf16* const CQN = (bf16*)(ws + WS_CQN); bf16* const CKVN = (bf16*)(ws + WS_CKVN); bf16* const QM = (bf16*)(ws + WS_QM); bf16* const KV = (bf16*)(ws + WS_KV); (void)CQN; (void)CKVN; (void)QM; (void)KV; \
    bf16* const ORAW = (bf16*)(ws + WS_ORAW); bf16* const OM = (bf16*)(ws + WS_OM); bf16* const OD = (bf16*)(ws + WS_OD); (void)ORAW; (void)OM; (void)OD; \
    bf16* const GATES = (bf16*)(ws + WS_GATES); bf16* const T1 = (bf16*)(ws + WS_T1); bf16* const MERGED = (bf16*)(ws + WS_MERGED); (void)GATES; (void)T1; (void)MERGED; \
    float* const MX0 = (float*)(ws + WS_MX0); float* const MX1 = (float*)(ws + WS_MX1); float* const ROPE = (float*)(ws + WS_ROPE); (void)MX0; (void)MX1; (void)ROPE
    typedef pg8::bf16_t pbf;
#define GEMM_PHASE(EPI_T, Aptr, Btptr, Mr, Nr, Kr, LDA, LDB, EPI) do { pg8::Gemm g_{(const pbf*)(Aptr), (const pbf*)(Btptr), (Mr), (Nr), (Kr), (LDA), (LDB)}; \
        pg8::StaticOrder S_; S_.init((Mr), (Nr), G, bx); pg8::gemm_phase<EPI_T, pg8::StaticOrder, true, true>(L + RING_OFF, g_, S_, EPI); } while (0)

    if (IN(0)) { PHASE_PTRS();
        LAS float* scr = (LAS float*)(L + RING_OFF + wave * 16384);
        constexpr int IT_FG = (DM / 64) * (DFF / 32), IT_FD = (DFF / 64) * (DM / 32), IT_WIN = (DM / 64) * (INW / 32), IT_WG = (DM / 64) * (2 * DM / 32),
                      IT_UQ = (1024 / 64) * (3072 / 32), IT_UKV = (512 / 64) * (4096 / 32), IT_BR = (2048 / 64) * (DM / 32), IT_WO = (DM / 64) * (DM / 32);
        constexpr int NITEMS = 4 * IT_FG + 2 * IT_FD + IT_WIN + IT_WG + IT_UQ + IT_UKV + 2 * IT_BR + IT_WO;
        for (int it = gw; it < NITEMS; it += NGW) {
            int r = it;
            if (r < IT_FG) { p0_transpose_item<1>(A->in[I_W1G], DM, DFF, (bf16*)(ws + WS_W1GU), scr, r, lane); continue; } r -= IT_FG;
            if (r < IT_FG) { p0_transpose_item<2>(A->in[I_W1U], DM, DFF, (bf16*)(ws + WS_W1GU), scr, r, lane); continue; } r -= IT_FG;
            if (r < IT_FD) { p0_transpose_item<0>(A->in[I_W1D], DFF, DM, (bf16*)(ws + WS_W1D), scr, r, lane); continue; } r -= IT_FD;
            if (r < IT_WIN) { p0_transpose_item<3>(A->in[I_WIN], DM, INW, (bf16*)(ws + WS_WIN), scr, r, lane); continue; } r -= IT_WIN;
            if (r < IT_WG) { p0_transpose_item<0>(A->in[I_WG], DM, 2 * DM, (bf16*)(ws + WS_WG), scr, r, lane); continue; } r -= IT_WG;
            if (r < IT_UQ) { p0_transpose_item<4>(A->in[I_WUQ], 1024, 3072, (bf16*)(ws + WS_WUQ), scr, r, lane); continue; } r -= IT_UQ;
            if (r < IT_UKV) { p0_transpose_item<0>(A->in[I_WUKV], 512, 4096, (bf16*)(ws + WS_WUKV), scr, r, lane); continue; } r -= IT_UKV;
            if (r < IT_BR) { p0_transpose_item<0>(A->in[I_WBD], 2048, DM, (bf16*)(ws + WS_WBD), scr, r, lane); continue; } r -= IT_BR;
            if (r < IT_BR) { p0_transpose_item<0>(A->in[I_WBM], 2048, DM, (bf16*)(ws + WS_WBM), scr, r, lane); continue; } r -= IT_BR;
            if (r < IT_WO) { p0_transpose_item<0>(A->in[I_WO], DM, DM, (bf16*)(ws + WS_WO), scr, r, lane); continue; } r -= IT_WO;
            if (r < IT_FG) { p0_transpose_item<1>(A->in[I_W2G], DM, DFF, (bf16*)(ws + WS_W2GU), scr, r, lane); continue; } r -= IT_FG;
            if (r < IT_FG) { p0_transpose_item<2>(A->in[I_W2U], DM, DFF, (bf16*)(ws + WS_W2GU), scr, r, lane); continue; } r -= IT_FG;
            p0_transpose_item<0>(A->in[I_W2D], DFF, DM, (bf16*)(ws + WS_W2D), scr, r, lane);
        }
        for (int m = gw; m < INWP - INW; m += NGW) zero_row_bf16((bf16*)(ws + WS_WIN) + (size_t)(INW + m) * DM, DM, lane);
        for (int m = gw; m < MP; m += NGW) {
            if (m < MR) rms_row_to_bf16(A->in[I_X] + (size_t)m * DM, A->in[I_N1], XN + (size_t)m * DM, lane);
            else if (m < MR + NMETA) rms_row_to_bf16(A->in[I_META] + (size_t)(m - MR) * DM, A->in[I_N1], XN + (size_t)m * DM, lane);
            else zero_row_bf16(XN + (size_t)m * DM, DM, lane);
        }
        for (int m = gw; m < 256; m += NGW) {
            GAS f32x4* o = (GAS f32x4*)(MX0 + (size_t)m * DM) + lane;
            for (int j = 0; j < 16; ++j) o[64 * j] = (m < NMETA) ? ((const GAS f32x4*)(A->in[I_META] + (size_t)m * DM) + lane)[64 * j] : (f32x4){0.f, 0.f, 0.f, 0.f};
        }
        {
            static constexpr double INVF[32] = {1.0, 0.7498942093324559, 0.5623413251903491, 0.4216965034285822, 0.31622776601683794, 0.23713737056616552, 0.1778279410038923, 0.1333521432163324,
                0.1, 0.07498942093324558, 0.05623413251903491, 0.042169650342858224, 0.03162277660168379, 0.023713737056616554, 0.01778279410038923, 0.01333521432163324,
                0.01, 0.007498942093324558, 0.005623413251903491, 0.004216965034285823, 0.0031622776601683794, 0.0023713737056616554, 0.0017782794100389228, 0.001333521432163324,
                0.001, 0.0007498942093324559, 0.0005623413251903491, 0.00042169650342858224, 0.00031622776601683794, 0.00023713737056616554, 0.00017782794100389227, 0.0001333521432163324};
            for (int idx = (vcu * NWAVES + wave) * 64 + lane; idx < (SEQ + NMETA) * 32; idx += NGW * 64) {
                const int pos = idx >> 5, i = idx & 31; double rev = (double)pos * INVF[i] * 0.15915494309189535; rev -= __builtin_floor(rev);
                const float fr = (float)rev; ROPE[2 * idx] = __builtin_amdgcn_cosf(fr); ROPE[2 * idx + 1] = __builtin_amdgcn_sinf(fr);
            }
        }
        if (BOTH(0)) GRID_BAR();
    }

    if (IN(1)) { PHASE_PTRS(); pg8::EpiSwiglu E{(pbf*)HB, DFF}; GEMM_PHASE(pg8::EpiSwiglu, XN, ws + WS_W1GU, MP, 2 * DFF, DM, DM, DM, E); if (BOTH(1)) GRID_BAR(); }
    if (IN(2)) { PHASE_PTRS(); pg8::EpiResid E{A->in[I_X], out, MX0, MX1, 0.5f}; GEMM_PHASE(pg8::EpiResid, HB, ws + WS_W1D, MP, DM, DFF, DFF, DFF, E); if (BOTH(2)) GRID_BAR(); }
    if (IN(3)) { PHASE_PTRS();
        for (int m = gw; m < MP; m += NGW) {
            if (m < MR) rms_row_to_bf16(out + (size_t)m * DM, A->in[I_NMIX], XN + (size_t)m * DM, lane);
            else if (m < MR + NMETA) rms_row_to_bf16(MX1 + (size_t)(m - MR) * DM, A->in[I_NMIX], XN + (size_t)m * DM, lane);
            else zero_row_bf16(XN + (size_t)m * DM, DM, lane);
        }
        if (BOTH(3)) GRID_BAR();
    }
    if (IN(4)) { PHASE_PTRS(); pg8::EpiB<pg8::MB_WIN> E{(pbf*)PB, INWP, nullptr, nullptr, nullptr, ROPE}; GEMM_PHASE(pg8::EpiB<pg8::MB_WIN>, XN, ws + WS_WIN, MP, INWP, DM, DM, DM, E); if (BOTH(4)) GRID_BAR(); }
    if (IN(5)) { PHASE_PTRS();
        for (int m = gw; m < MP; m += NGW) {
            const bf16* prow = PB + (size_t)m * INWP;
            {   const v4u a = *(const GAS v4u*)(prow + PC_CQ + 8 * lane), b = *(const GAS v4u*)(prow + PC_CQ + 512 + 8 * lane);
                float x[16] = {bflo(a.x), bfhi(a.x), bflo(a.y), bfhi(a.y), bflo(a.z), bfhi(a.z), bflo(a.w), bfhi(a.w), bflo(b.x), bfhi(b.x), bflo(b.y), bfhi(b.y), bflo(b.z), bfhi(b.z), bflo(b.w), bfhi(b.w)};
                float s = 0.f;
#pragma unroll
                for (int j = 0; j < 16; ++j) s += x[j] * x[j];
                const float rstd = 1.f / sqrtf(wave_sum(s) * (1.f / 1024.f) + EPS);
                const float* g = A->in[I_QNORM];
#pragma unroll
                for (int hseg = 0; hseg < 2; ++hseg) { const f32x4 g0 = *(const GAS f32x4*)(g + hseg * 512 + 8 * lane), g1 = *(const GAS f32x4*)(g + hseg * 512 + 8 * lane + 4); const float* xx = x + 8 * hseg;
                    v4u o; o.x = pk2(xx[0] * rstd * g0.x, xx[1] * rstd * g0.y); o.y = pk2(xx[2] * rstd * g0.z, xx[3] * rstd * g0.w); o.z = pk2(xx[4] * rstd * g1.x, xx[5] * rstd * g1.y); o.w = pk2(xx[6] * rstd * g1.z, xx[7] * rstd * g1.w);
                    *(GAS v4u*)(CQN + (size_t)m * 1024 + hseg * 512 + 8 * lane) = o; } }
            {   const v4u a = *(const GAS v4u*)(prow + PC_CKV + 8 * lane);
                float x[8] = {bflo(a.x), bfhi(a.x), bflo(a.y), bfhi(a.y), bflo(a.z), bfhi(a.z), bflo(a.w), bfhi(a.w)};
                float s = 0.f;
#pragma unroll
                for (int j = 0; j < 8; ++j) s += x[j] * x[j];
                const float rstd = 1.f / sqrtf(wave_sum(s) * (1.f / 512.f) + EPS);
                const float* g = A->in[I_KVNORM];
                const f32x4 g0 = *(const GAS f32x4*)(g + 8 * lane), g1 = *(const GAS f32x4*)(g + 8 * lane + 4);
                v4u o; o.x = pk2(x[0] * rstd * g0.x, x[1] * rstd * g0.y); o.y = pk2(x[2] * rstd * g0.z, x[3] * rstd * g0.w); o.z = pk2(x[4] * rstd * g1.x, x[5] * rstd * g1.y); o.w = pk2(x[6] * rstd * g1.z, x[7] * rstd * g1.w);
                *(GAS v4u*)(CKVN + (size_t)m * 512 + 8 * lane) = o; }
        }
        if (BOTH(5)) GRID_BAR();
    }
    if (IN(6)) { PHASE_PTRS();
        { pg8::EpiB<pg8::MB_QUP> E{(pbf*)QM, 3072, nullptr, nullptr, nullptr, ROPE}; GEMM_PHASE(pg8::EpiB<pg8::MB_QUP>, CQN, ws + WS_WUQ, MP, 3072, 1024, 1024, 1024, E); }
        { pg8::EpiB<pg8::MB_PLAIN> E{(pbf*)KV, 4096, nullptr, nullptr, nullptr, nullptr}; GEMM_PHASE(pg8::EpiB<pg8::MB_PLAIN>, CKVN, ws + WS_WUKV, MP, 4096, 512, 512, 512, E); }
        if (BOTH(6)) GRID_BAR();
    }
    if (IN(7)) { PHASE_PTRS();
        char* const al = (char*)lds + RING_OFF;
#ifndef ATT_NO_DIFF
        for (int Lu = vcu; Lu < 2048; Lu += G) {
            const int i = Lu >> 8, x = (Lu >> 5) & 7, j = Lu & 31, bh = 4 * x + (i >> 1), b = bh >> 3, h = bh & 7, c = i & 1, vh = j >> 4, qb = j & 15;
            const size_t qrow = (size_t)b * SEQ + (size_t)qb * 256;
            const float nslope = -__builtin_amdgcn_exp2f(-(float)(h + 1)) * 11.313708498984761f;
            att::attn_unit<128, true, 2>(PB + qrow * INWP + PC_DQ + h * 256 + c * 128, INWP, PB + PC_DK + h * 256 + c * 128, INWP, nullptr, 0, PB + PC_DV + h * 256 + vh * 128, INWP,
                                         ORAW + qrow * 4096 + c * 2048 + h * 256 + vh * 128, 4096, b * SEQ, qb * 256, nslope, al);
        }
#endif
#ifndef ATT_NO_MLA
        for (int Lu = vcu; Lu < 1024; Lu += G) {
            const int i = Lu >> 8, x = (Lu >> 5) & 7, j = Lu & 31, bh = 8 * x + 2 * i + (j >> 4), b = bh >> 4, h = bh & 15, qb = j & 15;
            const size_t qrow = (size_t)b * SEQ + (size_t)qb * 256;
            att::attn_unit<192, false, MLA_SDEPTH>(QM + qrow * 3072 + h * 192, 3072, KV + h * 256, 4096, PB + PC_KR, INWP, KV + h * 256 + 128, 4096,
                                                   OM + qrow * 2048 + h * 128, 2048, b * SEQ, qb * 256, 0.f, al);
        }
#endif
        if (BOTH(7)) GRID_BAR();
    }
    if (IN(8)) { PHASE_PTRS();
        float lam;
        {   const float* q1 = A->in[I_LQ1]; const float* k1 = A->in[I_LK1]; const float* q2 = A->in[I_LQ2]; const float* k2 = A->in[I_LK2];
            const float s1 = wave_sum(q1[lane] * k1[lane] + q1[lane + 64] * k1[lane + 64]), s2 = wave_sum(q2[lane] * k2[lane] + q2[lane + 64] * k2[lane + 64]);
            lam = __builtin_amdgcn_exp2f(s1 * 1.4426950408889634f) - __builtin_amdgcn_exp2f(s2 * 1.4426950408889634f) + 0.2f; }
        const f32x4 sg = *(const GAS f32x4*)(A->in[I_SUBLN] + 4 * lane);
        for (int m = gw; m < MR; m += NGW) {
            const bf16* o1 = ORAW + (size_t)m * 4096; const bf16* o2 = o1 + 2048;
#pragma unroll 2
            for (int h = 0; h < 8; ++h) {
                const v2u a = *(const GAS v2u*)(o1 + h * 256 + 4 * lane), b = *(const GAS v2u*)(o2 + h * 256 + 4 * lane);
                const float f0 = bflo(a.x) - lam * bflo(b.x), f1 = bfhi(a.x) - lam * bfhi(b.x), f2 = bflo(a.y) - lam * bflo(b.y), f3 = bfhi(a.y) - lam * bfhi(b.y);
                const float rstd = 1.f / sqrtf(wave_sum((f0 * f0 + f1 * f1) + (f2 * f2 + f3 * f3)) * (1.f / 256.f) + EPS);
                v2u o; o.x = pk2(f0 * rstd * sg.x * 0.8f, f1 * rstd * sg.y * 0.8f); o.y = pk2(f2 * rstd * sg.z * 0.8f, f3 * rstd * sg.w * 0.8f);
                *(GAS v2u*)(OD + (size_t)m * 2048 + h * 256 + 4 * lane) = o;
            }
        }
        { pg8::EpiB<pg8::MB_GATE> E{(pbf*)GATES, 2 * DM, A->in[I_BG], nullptr, nullptr, nullptr}; GEMM_PHASE(pg8::EpiB<pg8::MB_GATE>, XN, ws + WS_WG, MR, 2 * DM, DM, DM, DM, E); }
        if (BOTH(8)) GRID_BAR();
    }
    if (IN(9)) { PHASE_PTRS(); pg8::EpiB<pg8::MB_BR1> E{(pbf*)T1, DM, nullptr, (const pbf*)GATES, nullptr, nullptr}; GEMM_PHASE(pg8::EpiB<pg8::MB_BR1>, OD, ws + WS_WBD, MR, DM, 2048, 2048, 2048, E); if (BOTH(9)) GRID_BAR(); }
    if (IN(10)) { PHASE_PTRS(); pg8::EpiB<pg8::MB_BR2> E{(pbf*)MERGED, DM, nullptr, (const pbf*)GATES, (const pbf*)T1, nullptr}; GEMM_PHASE(pg8::EpiB<pg8::MB_BR2>, OM, ws + WS_WBM, MR, DM, 2048, 2048, 2048, E); if (BOTH(10)) GRID_BAR(); }
    if (IN(11)) { PHASE_PTRS(); pg8::EpiResid E{out, out, MX1, MX1, 1.0f}; GEMM_PHASE(pg8::EpiResid, MERGED, ws + WS_WO, MR, DM, DM, DM, DM, E); if (BOTH(11)) GRID_BAR(); }
    if (IN(12)) { PHASE_PTRS(); for (int m = gw; m < MR; m += NGW) rms_row_to_bf16(out + (size_t)m * DM, A->in[I_N2], XN + (size_t)m * DM, lane); if (BOTH(12)) GRID_BAR(); }
    if (IN(13)) { PHASE_PTRS(); pg8::EpiSwiglu E{(pbf*)HB, DFF}; GEMM_PHASE(pg8::EpiSwiglu, XN, ws + WS_W2GU, MR, 2 * DFF, DM, DM, DM, E); if (BOTH(13)) GRID_BAR(); }
    if (IN(14)) { PHASE_PTRS(); pg8::EpiResid E{out, out, MX1, MX1, 0.5f}; GEMM_PHASE(pg8::EpiResid, HB, ws + WS_W2D, MR, DM, DFF, DFF, DFF, E); if (BOTH(14)) GRID_BAR(); }
    if (IN(15)) { PHASE_PTRS(); for (int m = gw; m < MR; m += NGW) rms_row_inplace(out + (size_t)m * DM, A->in[I_NF], lane); }
#undef IN
#undef BOTH
#undef GRID_BAR
#undef GEMM_PHASE
}

extern "C" void kernel_launch(void* const* d_in, const int* in_sizes, int n_in, void* d_out, int out_size, void* d_ws, size_t ws_size, hipStream_t stream) {
    static int grid = 0;
    if (grid == 0) {
        if (n_in != 27 || in_sizes[0] != MR * DM || out_size != MR * DM || ws_size < WS_END) {
            fprintf(stderr, "kernel_launch: built for 27 inputs, x/out of %d floats, >= %zu bytes of workspace; got n_in %d, in0 %d, out %d, ws %zu; nothing launched\n", MR * DM, (size_t)WS_END, n_in, n_in > 0 ? in_sizes[0] : -1, out_size, ws_size);
            grid = -1; return; }
        int dev = 0, cus = 0, per_cu = 0;
        if (hipGetDevice(&dev) != hipSuccess || hipDeviceGetAttribute(&cus, hipDeviceAttributeMultiprocessorCount, dev) != hipSuccess) { fprintf(stderr, "kernel_launch: device query failed\n"); grid = -1; return; }
        if (hipFuncSetAttribute((const void*)fwd, hipFuncAttributeMaxDynamicSharedMemorySize, LDS_BYTES) != hipSuccess) { fprintf(stderr, "kernel_launch: hipFuncSetAttribute failed\n"); grid = -1; return; }
        if (hipOccupancyMaxActiveBlocksPerMultiprocessor(&per_cu, (const void*)fwd, NWAVES * 64, LDS_BYTES) != hipSuccess || per_cu < 1)
            fprintf(stderr, "kernel_launch: note: occupancy query reports %d workgroups per CU\n", per_cu);
        (void)hipGetLastError();
        grid = cus;
    }
    if (grid < 0) return;
    if (hipMemsetAsync((char*)d_ws + WS_CTL, 0, CTL_ZERO_BYTES, stream) != hipSuccess) { fprintf(stderr, "kernel_launch: memset failed\n"); return; }
    Args a{};
    for (int i = 0; i < 27; ++i) a.in[i] = (const float*)d_in[i];
    a.out = (float*)d_out; a.ws = (unsigned char*)d_ws;
    for (int li = 0; li < N_LAUNCHES; ++li) {
        a.ph_lo = (N_LAUNCHES == 1) ? 0 : li * NPH / N_LAUNCHES; a.ph_hi = (N_LAUNCHES == 1) ? NPH : (li + 1) * NPH / N_LAUNCHES;
        hipLaunchKernelGGL(fwd, dim3(grid), dim3(NWAVES * 64), LDS_BYTES, stream, a);
        const hipError_t le = hipPeekAtLastError();
        if (le != hipSuccess) { fprintf(stderr, "kernel_launch: launch %d failed: %s\n", li, hipGetErrorName(le)); break; }
    }
}
```

```cpp
#include <hip/hip_runtime.h>
#include <cstdio>
#include <cstdint>

constexpr int DM = 4096, BATCH = 4, SEQ = 4096, NMETA = 16, DFF = 11008;
constexpr int MR = BATCH * SEQ;
constexpr int MP = MR + 256;
constexpr int INW = 7744, INWP = 7936;
constexpr int PC_DQ = 0, PC_DK = 2048, PC_DV = 4096, PC_CQ = 6144, PC_CKV = 7168, PC_KR = 7680;
constexpr float EPS = 1e-6f;

namespace pg8 {
#define PG8_LAS __attribute__((address_space(3)))
typedef unsigned short bf16_t;
typedef short bf16x8 __attribute__((ext_vector_type(8)));
typedef float f32x4 __attribute__((ext_vector_type(4)));
typedef unsigned u32x4 __attribute__((ext_vector_type(4)));
constexpr int BM = 256, BK = 64, HALF = 128, HTB = HALF * BK * 2  , STAGE_BYTES = 8 * HTB, NXCD = 8, WGM = 8;

__host__ __device__ __forceinline__ int lds_byte(int r, int c) { const int st = (r >> 4) * 2 + (c >> 5), rr = r & 15, cc = c & 31, ob = rr * 64 + cc * 2; return st * 1024 + (ob ^ (((ob >> 9) & 1) << 5)); }
__host__ __device__ __forceinline__ void stage_rc(int b, int& R, int& C) { const int st = b / 1024, sb = b % 1024, swz = sb ^ (((sb >> 9) & 1) << 5); R = (st >> 1) * 16 + swz / 64; C = (st & 1) * 32 + (swz % 64) / 2; }
__host__ __device__ __forceinline__ int perm32(int rho) { const int n = rho >> 4, i = rho & 15; return 8 * (i >> 2) + 4 * n + (i & 3); }

struct Unit { int pm, pn, kt0, nkt, sp; };
struct Gemm { const bf16_t* A; const bf16_t* Bt; int M, N, K, lda, ldb; };

struct StaticOrder {
    int nM, nN, nwg, G, c, nkt, nsplit;
    __host__ __device__ void init(int M, int N, int K, int G_, int c_, int nsplit_ = 0) { nM = M / BM; nN = N / BM; nwg = nM * nN; G = G_; c = c_; nkt = K / BK; nsplit = nsplit_; }
    __host__ __device__ bool next(int i, Unit& u) const {
        const long L = (long)i * G + c;
        if (L >= nwg) { const int e = (int)(L - nwg); if (e >= nsplit * nN) return false;
            const int s = e / nN, trips = nkt / 2, qd = trips / nsplit, rm = trips % nsplit;
            u.pm = nM; u.pn = e % nN; u.kt0 = 2 * (s * qd + (s < rm ? s : rm)); u.nkt = 2 * (qd + (s < rm ? 1 : 0)); u.sp = s; return true; }
        int wgid = (int)L; { const int q = nwg / NXCD, r = nwg % NXCD, xcd = wgid % NXCD, off = wgid / NXCD; wgid = (xcd < r ? xcd * (q + 1) : r * (q + 1) + (xcd - r) * q) + off; }
        const int nig = WGM * nN, gid = wgid / nig, fm = gid * WGM, gsz = (nM - fm) < WGM ? (nM - fm) : WGM;
        u.pm = fm + ((wgid % nig) % gsz); u.pn = (wgid % nig) / gsz; u.kt0 = 0; u.nkt = nkt; u.sp = 0; return true;
    }
    __device__ __forceinline__ void a_ready(const Unit&) const {}
    __device__ __forceinline__ void done(const Unit&) const {}
};

__device__ __forceinline__ unsigned cvt_pk_bf16(float lo, float hi) { unsigned r; asm volatile("v_cvt_pk_bf16_f32 %0, %1, %2" : "=v"(r) : "v"(lo), "v"(hi)); return r; }
__device__ __forceinline__ u32x4 pack8(const f32x4& a, const f32x4& b) { u32x4 w; w.x = cvt_pk_bf16(a[0], a[1]); w.y = cvt_pk_bf16(a[2], a[3]); w.z = cvt_pk_bf16(b[0], b[1]); w.w = cvt_pk_bf16(b[2], b[3]); return w; }
__device__ __forceinline__ void unpack8(const u32x4& w, f32x4& a, f32x4& b) {
    a[0] = __uint_as_float(w.x << 16); a[1] = __uint_as_float(w.x & 0xffff0000u); a[2] = __uint_as_float(w.y << 16); a[3] = __uint_as_float(w.y & 0xffff0000u);
    b[0] = __uint_as_float(w.z << 16); b[1] = __uint_as_float(w.z & 0xffff0000u); b[2] = __uint_as_float(w.w << 16); b[3] = __uint_as_float(w.w & 0xffff0000u); }
__device__ __forceinline__ float row_rstd(const float* ssq, int row) { return 1.0f / sqrtf(ssq[row] * (1.0f / DM) + EPS); }
__device__ __forceinline__ float sigmoidf_fast(float x) { return __builtin_amdgcn_rcpf(1.0f + __builtin_amdgcn_exp2f(-1.4426950408889634f * x)); }

struct EpiSwiglu {
    static constexpr bool PERM = true, AFTER_DRAIN = false;
    bf16_t* H; int ldh; const float* ssq;
    __device__ __forceinline__ void operator()(const f32x4 (&acc)[2][2][4][2], const Unit& u, int wr, int wc, int fr, int fq) const {
        const int row0 = u.pm * BM + wr * 64 + fr, col0 = u.pn * HALF + wc * 32 + 8 * fq;
#pragma unroll
        for (int ai = 0; ai < 2; ++ai)
#pragma unroll
            for (int m = 0; m < 4; ++m) {
                const float rs = ssq ? row_rstd(ssq, row0 + ai * HALF + m * 16) : 1.f;
                f32x4 h[2];
#pragma unroll
                for (int n = 0; n < 2; ++n) { const f32x4 g = acc[ai][0][m][n] * rs, up = acc[ai][1][m][n] * rs;
#pragma unroll
                    for (int j = 0; j < 4; ++j) h[n][j] = g[j] * sigmoidf_fast(g[j]) * up[j]; }
                *(u32x4*)(H + (size_t)(row0 + ai * HALF + m * 16) * ldh + col0) = pack8(h[0], h[1]);
            }
    }
};
struct EpiResid {
    static constexpr bool PERM = false, AFTER_DRAIN = false;
    const float* res; float* out; float* slab; bf16_t* xn; float* part; float alpha;
    __device__ __forceinline__ void operator()(const f32x4 (&acc)[2][2][4][2], const Unit& u, int wr, int wc, int fr, int fq) const {
        const int col0 = u.pn * BM + wc * 32 + 4 * fq;
        if (u.pm >= MR / BM) {
            if (wr == 0) { float* ob = slab + ((size_t)u.sp * NMETA + fr) * DM + col0;
#pragma unroll
                for (int bj = 0; bj < 2; ++bj)
#pragma unroll
                    for (int n = 0; n < 2; ++n) *(f32x4*)(ob + bj * HALF + n * 16) = alpha * acc[0][bj][0][n]; }
            return; }
        const float* rb = res + (size_t)u.pm * BM * DM; float* ob = out + (size_t)u.pm * BM * DM;
#pragma unroll
        for (int ai = 0; ai < 2; ++ai)
#pragma unroll
            for (int m = 0; m < 4; ++m) { const int rowt = ai * HALF + wr * 64 + m * 16 + fr; const size_t off = (size_t)rowt * DM + col0; float q = 0.f;
#pragma unroll
                for (int bj = 0; bj < 2; ++bj)
#pragma unroll
                    for (int n = 0; n < 2; ++n) { const f32x4 r = *(const f32x4*)(rb + off + bj * HALF + n * 16); const f32x4 v = r + alpha * acc[ai][bj][m][n]; *(f32x4*)(ob + off + bj * HALF + n * 16) = v;
                        q += (v[0] * v[0] + v[1] * v[1]) + (v[2] * v[2] + v[3] * v[3]);
                        if (xn) { typedef unsigned u32x2 __attribute__((ext_vector_type(2))); u32x2 w; w.x = cvt_pk_bf16(v[0], v[1]); w.y = cvt_pk_bf16(v[2], v[3]); *(u32x2*)(xn + (size_t)u.pm * BM * DM + off + bj * HALF + n * 16) = w; } }
                if (part) { q += __shfl_xor(q, 16); q += __shfl_xor(q, 32); if (fq == 0) part[(size_t)(u.pm * BM + rowt) * 64 + u.pn * 4 + wc] = q; }
                if (m & 1) asm volatile("" ::: "memory"); }
    }
};
enum { MB_PLAIN = 0, MB_WIN = 1, MB_QUP = 2, MB_GATE = 3, MB_BR1 = 4, MB_BR2 = 5 };
__device__ __forceinline__ void rope8(f32x4& v0, f32x4& v1, const float* cs) {
    const f32x4 c01 = *(const f32x4*)cs, c23 = *(const f32x4*)(cs + 4);
    const f32x4 a = v0, b = v1;
    v0[0] = a[0] * c01[0] - a[1] * c01[1]; v0[1] = a[0] * c01[1] + a[1] * c01[0]; v0[2] = a[2] * c01[2] - a[3] * c01[3]; v0[3] = a[2] * c01[3] + a[3] * c01[2];
    v1[0] = b[0] * c23[0] - b[1] * c23[1]; v1[1] = b[0] * c23[1] + b[1] * c23[0]; v1[2] = b[2] * c23[2] - b[3] * c23[3]; v1[3] = b[2] * c23[3] + b[3] * c23[2];
}
template <int MODE> struct EpiB {
    static constexpr bool PERM = true, AFTER_DRAIN = false;
    bf16_t* O; int ldc; const float* bias; const bf16_t* G; const bf16_t* T1; const float* rope; const float* ssq;
    __device__ __forceinline__ void operator()(const f32x4 (&acc)[2][2][4][2], const Unit& u, int wr, int wc, int fr, int fq) const {
        const int row0 = u.pm * BM + wr * 64 + fr, colt = u.pn * BM + wc * 32 + 8 * fq;
#pragma unroll
        for (int ai = 0; ai < 2; ++ai)
#pragma unroll
            for (int m = 0; m < 4; ++m) { const int row = row0 + ai * HALF + m * 16;
                const int pos = row < MR ? NMETA + (row & (SEQ - 1)) : (row - MR);
                const float rs = ssq ? row_rstd(ssq, row) : 1.f;
#pragma unroll
                for (int bj = 0; bj < 2; ++bj) { const int col0 = colt + bj * HALF; f32x4 v0 = acc[ai][bj][m][0] * rs, v1 = acc[ai][bj][m][1] * rs;
                    if (MODE == MB_WIN) { if (col0 >= PC_KR && col0 < INW) rope8(v0, v1, rope + ((size_t)pos * 32 + ((col0 - PC_KR) >> 1)) * 2); }
                    if (MODE == MB_QUP) { const int d0 = col0 % 192; if (d0 >= 128) rope8(v0, v1, rope + ((size_t)pos * 32 + ((d0 - 128) >> 1)) * 2); }
                    if (MODE == MB_GATE) { const f32x4 b0 = *(const f32x4*)(bias + col0), b1 = *(const f32x4*)(bias + col0 + 4);
#pragma unroll
                        for (int j = 0; j < 4; ++j) { v0[j] = sigmoidf_fast(v0[j] + b0[j]); v1[j] = sigmoidf_fast(v1[j] + b1[j]); } }
                    if (MODE == MB_BR1) { f32x4 g0, g1; unpack8(*(const u32x4*)(G + (size_t)row * (2 * DM) + col0), g0, g1); v0 = v0 * g0; v1 = v1 * g1; }
                    if (MODE == MB_BR2) { f32x4 g0, g1, t0, t1; unpack8(*(const u32x4*)(G + (size_t)row * (2 * DM) + DM + col0), g0, g1); unpack8(*(const u32x4*)(T1 + (size_t)row * DM + col0), t0, t1);
                        v0 = t0 + v0 * g0; v1 = t1 + v1 * g1; }
                    *(u32x4*)(O + (size_t)row * ldc + col0) = pack8(v0, v1); } }
    }
};

template <class Epi, class Sched, bool ALIGN_EPI = false, bool SP2 = false>
__device__ __forceinline__ void gemm_phase(PG8_LAS unsigned char* lds, const Gemm g, const Sched& S, const Epi& E) {
    const int tid = threadIdx.x, wid = __builtin_amdgcn_readfirstlane(tid >> 6), lane = tid & 63, wr = wid >> 2, wc = wid & 3, fr = lane & 15, fq = lane >> 4;

    unsigned voffA[2], voffB[2];
#pragma unroll
    for (int i = 0; i < 2; ++i) { int R, C; stage_rc(tid * 16 + i * 8192, R, C); const int Rb = Epi::PERM ? ((R & ~31) + perm32(R & 31)) : R;
        voffA[i] = (unsigned)(R * g.lda + C) * 2u; voffB[i] = (unsigned)(Rb * g.ldb + C) * 2u; }
    const size_t kstep = (size_t)(BK * 2);
    const size_t hstepA = (size_t)HALF * g.lda * 2, hstepB = (size_t)HALF * g.ldb * 2;
    const size_t tstepA = 2 * hstepA, tstepB = 2 * hstepB;
    const unsigned ldsw = (unsigned)wid * 1024u;
    const int aoff = lds_byte(wr * 64 + fr, fq * 8), boff = lds_byte(wc * 32 + fr, fq * 8);
#define PG8_SA(b, h) (((b) * 2 + (h)) * HTB)
#define PG8_SB(b, h) ((4 + (b) * 2 + (h)) * HTB)
#define PG8_STAGE(bufoff, gbase, voff) do { _Pragma("unroll") for (int _i = 0; _i < 2; ++_i) \
        __builtin_amdgcn_global_load_lds((const unsigned*)((const char*)(gbase) + (voff)[_i]), (PG8_LAS unsigned*)(lds + (bufoff) + ldsw + _i * 8192), 16, 0, 0); } while (0)
#define PG8_LDA(dst, b, h) do { _Pragma("unroll") for (int m = 0; m < 4; ++m) _Pragma("unroll") for (int k = 0; k < 2; ++k) dst[m][k] = *(const PG8_LAS bf16x8*)(lds + PG8_SA(b, h) + aoff + m * 2048 + k * 1024); } while (0)
#define PG8_LDB(dst, b, h) do { _Pragma("unroll") for (int n = 0; n < 2; ++n) _Pragma("unroll") for (int k = 0; k < 2; ++k) dst[n][k] = *(const PG8_LAS bf16x8*)(lds + PG8_SB(b, h) + boff + n * 2048 + k * 1024); } while (0)
#define PG8_MMA(ai, bj, At, Bt) do { __builtin_amdgcn_s_setprio(1); _Pragma("unroll") for (int m = 0; m < 4; ++m) _Pragma("unroll") for (int n = 0; n < 2; ++n) _Pragma("unroll") for (int k = 0; k < 2; ++k) \
        acc[ai][bj][m][n] = __builtin_amdgcn_mfma_f32_16x16x32_bf16(Bt[n][k], At[m][k], acc[ai][bj][m][n], 0, 0, 0); __builtin_amdgcn_s_setprio(0); } while (0)
#define PG8_WAIT_V(n) asm volatile("s_waitcnt vmcnt(" #n ")" ::: "memory")
#define PG8_WAIT_L(n) asm volatile("s_waitcnt lgkmcnt(" #n ")" ::: "memory")
#define PG8_BAR __builtin_amdgcn_s_barrier()
#define PG8_SCHED __builtin_amdgcn_sched_barrier(0)
    Unit cur, nxt; int ui = 0;
    if (!S.next(0, cur)) return;
    f32x4 acc[2][2][4][2];
#pragma unroll
    for (int a = 0; a < 2; ++a)
#pragma unroll
        for (int b = 0; b < 2; ++b)
#pragma unroll
            for (int m = 0; m < 4; ++m)
#pragma unroll
                for (int n = 0; n < 2; ++n) acc[a][b][m][n] = (f32x4){0.f, 0.f, 0.f, 0.f};
    bf16x8 At[4][2], B0[2][2], B1[2][2];
    const char* cA = (const char*)g.A + (size_t)cur.pm * tstepA + (size_t)cur.kt0 * kstep; const char* cB = (const char*)g.Bt + (size_t)cur.pn * tstepB + (size_t)cur.kt0 * kstep;
    S.a_ready(cur);
    if constexpr (SP2) {
        PG8_STAGE(PG8_SB(0, 0), cB, voffB); PG8_STAGE(PG8_SB(0, 1), cB + hstepB, voffB); PG8_STAGE(PG8_SA(0, 0), cA, voffA); PG8_STAGE(PG8_SA(0, 1), cA + hstepA, voffA);
        if (wr == 1) PG8_BAR;
        PG8_WAIT_V(2); PG8_BAR;
        PG8_STAGE(PG8_SB(1, 0), cB + kstep, voffB); PG8_STAGE(PG8_SA(1, 0), cA + kstep, voffA); PG8_STAGE(PG8_SB(1, 1), cB + hstepB + kstep, voffB);
        PG8_WAIT_V(6); PG8_BAR;
    } else {
        PG8_STAGE(PG8_SB(0, 0), cB, voffB); PG8_STAGE(PG8_SA(0, 0), cA, voffA); PG8_STAGE(PG8_SB(0, 1), cB + hstepB, voffB); PG8_STAGE(PG8_SA(0, 1), cA + hstepA, voffA);
        if (wr == 1) PG8_BAR;
        PG8_WAIT_V(4); PG8_BAR;
        PG8_STAGE(PG8_SB(1, 0), cB + kstep, voffB); PG8_STAGE(PG8_SA(1, 0), cA + kstep, voffA); PG8_STAGE(PG8_SB(1, 1), cB + hstepB + kstep, voffB);
        PG8_WAIT_V(6); PG8_BAR;
    }
    for (;;) {
        const bool has_next = S.next(ui + 1, nxt);
        const char* nA = has_next ? (const char*)g.A + (size_t)nxt.pm * tstepA + (size_t)nxt.kt0 * kstep : cA; const char* nB = has_next ? (const char*)g.Bt + (size_t)nxt.pn * tstepB + (size_t)nxt.kt0 * kstep : cB;
        const int nt = cur.nkt;
        for (int t = 0; t < nt; t += 2) {
            const bool last = (t == nt - 2);
            const char* a1 = cA + (size_t)(t + 1) * kstep;
            const char* a2 = last ? nA : cA + (size_t)(t + 2) * kstep; const char* b2 = last ? nB : cB + (size_t)(t + 2) * kstep;
            const char* a3 = a2 + kstep; const char* b3 = b2 + kstep;
            if (last && has_next) S.a_ready(nxt);
            if constexpr (SP2) {
            PG8_LDB(B0, 0, 0); PG8_LDB(B1, 0, 1); PG8_SCHED; PG8_LDA(At, 0, 0); PG8_STAGE(PG8_SA(1, 1), a1 + hstepA, voffA);
            PG8_WAIT_V(8); PG8_WAIT_L(0); PG8_BAR; PG8_MMA(0, 0, At, B0); PG8_MMA(0, 1, At, B1); PG8_BAR; PG8_SCHED;
            PG8_LDA(At, 0, 1); PG8_STAGE(PG8_SB(0, 0), b2, voffB); PG8_STAGE(PG8_SB(0, 1), b2 + hstepB, voffB); PG8_STAGE(PG8_SA(0, 0), a2, voffA);
            PG8_WAIT_V(8); PG8_WAIT_L(0); PG8_BAR; PG8_MMA(1, 0, At, B0); PG8_MMA(1, 1, At, B1); PG8_BAR; PG8_SCHED;
            PG8_LDB(B0, 1, 0); PG8_LDB(B1, 1, 1); PG8_SCHED; PG8_LDA(At, 1, 0); PG8_STAGE(PG8_SA(0, 1), a2 + hstepA, voffA);
            PG8_WAIT_V(8); PG8_WAIT_L(0); PG8_BAR; PG8_MMA(0, 0, At, B0); PG8_MMA(0, 1, At, B1); PG8_BAR; PG8_SCHED;
            PG8_LDA(At, 1, 1); PG8_STAGE(PG8_SB(1, 0), b3, voffB); PG8_STAGE(PG8_SB(1, 1), b3 + hstepB, voffB); PG8_STAGE(PG8_SA(1, 0), a3, voffA);
            PG8_WAIT_V(8); PG8_WAIT_L(0); PG8_BAR; PG8_MMA(1, 0, At, B0); PG8_MMA(1, 1, At, B1); PG8_BAR; PG8_SCHED;
            } else {
            PG8_LDB(B0, 0, 0); PG8_SCHED; PG8_LDA(At, 0, 0); PG8_STAGE(PG8_SA(1, 1), a1 + hstepA, voffA);
            PG8_WAIT_L(8); PG8_BAR; PG8_WAIT_L(0); PG8_MMA(0, 0, At, B0); PG8_BAR; PG8_SCHED;
            PG8_LDB(B1, 0, 1); PG8_STAGE(PG8_SB(0, 0), b2, voffB);
            PG8_BAR; PG8_WAIT_L(0); PG8_MMA(0, 1, At, B1); PG8_BAR;
            PG8_LDA(At, 0, 1); PG8_STAGE(PG8_SA(0, 0), a2, voffA);
            PG8_BAR; PG8_WAIT_L(0); PG8_MMA(1, 0, At, B0); PG8_BAR; PG8_SCHED;
            PG8_STAGE(PG8_SB(0, 1), b2 + hstepB, voffB);
            PG8_WAIT_V(6); PG8_BAR; PG8_MMA(1, 1, At, B1); PG8_BAR;
            PG8_LDB(B0, 1, 0); PG8_SCHED; PG8_LDA(At, 1, 0); PG8_STAGE(PG8_SA(0, 1), a2 + hstepA, voffA);
            PG8_WAIT_L(8); PG8_BAR; PG8_WAIT_L(0); PG8_MMA(0, 0, At, B0); PG8_BAR; PG8_SCHED;
            PG8_LDB(B1, 1, 1); PG8_STAGE(PG8_SB(1, 0), b3, voffB);
            PG8_BAR; PG8_WAIT_L(0); PG8_MMA(0, 1, At, B1); PG8_BAR;
            PG8_LDA(At, 1, 1); PG8_STAGE(PG8_SA(1, 0), a3, voffA);
            PG8_BAR; PG8_WAIT_L(0); PG8_MMA(1, 0, At, B0); PG8_BAR; PG8_SCHED;
            PG8_STAGE(PG8_SB(1, 1), b3 + hstepB, voffB);
            PG8_WAIT_V(6); PG8_BAR; PG8_MMA(1, 1, At, B1); PG8_BAR;
            }
        }
        if constexpr (ALIGN_EPI) { if (wr == 0) PG8_BAR; }
        if constexpr (!Epi::AFTER_DRAIN) { E(acc, cur, wr, wc, fr, fq); S.done(cur); }
        if (!has_next) break;
#pragma unroll
        for (int a = 0; a < 2; ++a)
#pragma unroll
            for (int b = 0; b < 2; ++b)
#pragma unroll
                for (int m = 0; m < 4; ++m)
#pragma unroll
                    for (int n = 0; n < 2; ++n) acc[a][b][m][n] = (f32x4){0.f, 0.f, 0.f, 0.f};
        cur = nxt; cA = nA; cB = nB; ++ui;
        if constexpr (ALIGN_EPI) { if (wr == 1) PG8_BAR; }
    }
    PG8_WAIT_V(0);
    if constexpr (!ALIGN_EPI) { if (wr == 0) PG8_BAR; }
    PG8_BAR;
    if constexpr (Epi::AFTER_DRAIN) { E.fused(acc, cur, wr, wc, fr, fq, lds, wid, lane); S.done(cur); }
#undef PG8_SA
#undef PG8_SB
#undef PG8_STAGE
#undef PG8_LDA
#undef PG8_LDB
#undef PG8_MMA
#undef PG8_WAIT_V
#undef PG8_WAIT_L
#undef PG8_BAR
#undef PG8_SCHED
}
}

namespace att {
typedef unsigned short bf16;
using bf16x8 = __attribute__((ext_vector_type(8))) short;
using s16x4  = __attribute__((ext_vector_type(4))) short;
using f32x16 = __attribute__((ext_vector_type(16))) float;
using u32x4  = __attribute__((ext_vector_type(4))) unsigned;
constexpr int NW = 8, QBLK = 32, KVBLK = 64, NT = SEQ / KVBLK + 1;
constexpr float THR = 8.f;
constexpr int SHM_V = KVBLK * 128 * 2;
template <int DQK> constexpr int shm_k() { return KVBLK * DQK * 2; }
template <int DQK> constexpr int nqreg() { return DQK == 192 ? 6 : 8; }
template <int DQK> constexpr int shm_total() { return 2 * SHM_V + 2 * shm_k<DQK>() + NW * 64 * 4 + NW * 1024 * (DQK / 16 - nqreg<DQK>()); }
#define ATT_SBAR() __builtin_amdgcn_sched_barrier(0)
__device__ __forceinline__ int crow(int r, int hi) { return (r & 3) + 8 * (r >> 2) + 4 * hi; }
__device__ __forceinline__ unsigned cvtpk(float lo, float hi) { unsigned r; asm volatile("v_cvt_pk_bf16_f32 %0, %1, %2" : "=v"(r) : "v"(lo), "v"(hi)); return r; }
template <int DQK> __device__ __forceinline__ int kswz(int row, int colB) {
    if constexpr (DQK == 128) return row * 256 + (colB ^ ((row & 7) << 4));
    else return row * 384 + (colB ^ (((row >> 1) & 7) << 4));
}
template <int DQK> __device__ __forceinline__ void partialSM(f32x16& p0, f32x16& p1, float& m_reg, float& mn, float& alpha) {
    constexpr float SCALE = DQK == 128 ? 0.08838834764831845f : 0.07216878364870322f;
    constexpr float C = SCALE * 1.4426950408889634f;
    float pmax = p0[0];
#pragma unroll
    for (int r = 1; r < 16; ++r) pmax = fmaxf(pmax, p0[r]);
#pragma unroll
    for (int r = 0; r < 16; ++r) pmax = fmaxf(pmax, p1[r]);
    { auto rr = __builtin_amdgcn_permlane32_swap(__float_as_uint(pmax), __float_as_uint(pmax), false, false);
      pmax = fmaxf(__uint_as_float(rr[0]), __uint_as_float(rr[1])); }
    if (__builtin_expect(__all(pmax - m_reg <= THR / SCALE), 1)) { mn = m_reg; alpha = 1.f; }
    else { mn = fmaxf(m_reg, pmax); alpha = __builtin_amdgcn_exp2f((m_reg - mn) * C); m_reg = mn; }
    const float mnC = -mn * C;
#pragma unroll
    for (int r = 0; r < 16; ++r) p0[r] = fmaf(p0[r], C, mnC);
#pragma unroll
    for (int r = 0; r < 16; ++r) p1[r] = fmaf(p1[r], C, mnC);
#pragma unroll
    for (int r = 0; r < 16; ++r) p0[r] = __builtin_amdgcn_exp2f(p0[r]);
}
__device__ __forceinline__ void finishSM(f32x16& p0, f32x16& p1, float alpha, float& l_reg, bf16x8& pa0, bf16x8& pa1, bf16x8& pa2, bf16x8& pa3) {
#pragma unroll
    for (int r = 0; r < 16; ++r) p1[r] = __builtin_amdgcn_exp2f(p1[r]);
    float ps = 0;
#pragma unroll
    for (int r = 0; r < 16; ++r) ps += p0[r];
#pragma unroll
    for (int r = 0; r < 16; ++r) ps += p1[r];
    { auto rr = __builtin_amdgcn_permlane32_swap(__float_as_uint(ps), __float_as_uint(ps), false, false);
      ps = __uint_as_float(rr[0]) + __uint_as_float(rr[1]); }
    l_reg = l_reg * alpha + ps;
#define ATT_PK4(P, BASE, OUT) do { unsigned a0 = cvtpk(P[BASE + 0], P[BASE + 1]), a1 = cvtpk(P[BASE + 2], P[BASE + 3]);   \
    unsigned b0 = cvtpk(P[BASE + 4], P[BASE + 5]), b1 = cvtpk(P[BASE + 6], P[BASE + 7]);                              \
    auto r0 = __builtin_amdgcn_permlane32_swap(a0, b0, false, false); auto r1 = __builtin_amdgcn_permlane32_swap(a1, b1, false, false); \
    u32x4 w = {r0[0], r1[0], r0[1], r1[1]}; OUT = *reinterpret_cast<bf16x8*>(&w); } while (0)
    ATT_PK4(p0, 0, pa0); ATT_PK4(p0, 8, pa1); ATT_PK4(p1, 0, pa2); ATT_PK4(p1, 8, pa3);
#undef ATT_PK4
}
template <int DQK> __device__ __forceinline__ void qkt(f32x16& p0, f32x16& p1, const char* Ks, const bf16x8* qr, const char* qp, int r32, int hi) {
#pragma unroll
    for (int d0 = 0; d0 < DQK / 16; ++d0) { const int cb = (d0 * 16 + hi * 8) * 2;
        const bf16x8 b0 = *reinterpret_cast<const bf16x8*>(Ks + kswz<DQK>(r32, cb));
        const bf16x8 b1 = *reinterpret_cast<const bf16x8*>(Ks + kswz<DQK>(32 + r32, cb));
        bf16x8 qv; if (d0 < nqreg<DQK>()) qv = qr[d0]; else qv = *reinterpret_cast<const bf16x8*>(qp + (d0 - nqreg<DQK>()) * 1024);
        p0 = __builtin_amdgcn_mfma_f32_32x32x16_bf16(b0, qv, p0, 0, 0, 0);
        p1 = __builtin_amdgcn_mfma_f32_32x32x16_bf16(b1, qv, p1, 0, 0, 0); }
}
__device__ __forceinline__ int v_st(int k, int c) { const int kk = (k & ~0xC) | ((k & 4) << 1) | ((k & 8) >> 1); return ((kk >> 3) * 4 + (c >> 5)) * 512 + ((kk & 7) * 32 + (c & 31)) * 2; }
__device__ __forceinline__ int v_rd_base(int lane) { return ((lane & 3) << 3) | (((lane >> 2) & 3) << 6) | (((lane >> 4) & 1) << 5) | (((lane >> 5) & 1) << 8); }
constexpr int v_rd_off(int d0, int ks, int half) { return d0 * 512 + ks * 4096 + half * 2048; }
template <int OFF> __device__ __forceinline__ s16x4 tr_read(int vb) { s16x4 r; asm volatile("ds_read_b64_tr_b16 %0, %1 offset:%2" : "=&v"(r) : "v"(vb), "i"(OFF) : "memory"); return r; }
template <int D0> __device__ __forceinline__ void pv_one(f32x16& od, int vb, bf16x8 pa0, bf16x8 pa1, bf16x8 pa2, bf16x8 pa3) {
    const s16x4 l0 = tr_read<v_rd_off(D0, 0, 0)>(vb), h0 = tr_read<v_rd_off(D0, 0, 1)>(vb), l1 = tr_read<v_rd_off(D0, 1, 0)>(vb), h1 = tr_read<v_rd_off(D0, 1, 1)>(vb);
    const s16x4 l2 = tr_read<v_rd_off(D0, 2, 0)>(vb), h2 = tr_read<v_rd_off(D0, 2, 1)>(vb), l3 = tr_read<v_rd_off(D0, 3, 0)>(vb), h3 = tr_read<v_rd_off(D0, 3, 1)>(vb);
    asm volatile("s_waitcnt lgkmcnt(0)" ::: "memory"); ATT_SBAR();
#define ATT_PK(L, H) (bf16x8){L[0], L[1], L[2], L[3], H[0], H[1], H[2], H[3]}
    od = __builtin_amdgcn_mfma_f32_32x32x16_bf16(pa0, ATT_PK(l0, h0), od, 0, 0, 0);
    od = __builtin_amdgcn_mfma_f32_32x32x16_bf16(pa1, ATT_PK(l1, h1), od, 0, 0, 0);
    od = __builtin_amdgcn_mfma_f32_32x32x16_bf16(pa2, ATT_PK(l2, h2), od, 0, 0, 0);
    od = __builtin_amdgcn_mfma_f32_32x32x16_bf16(pa3, ATT_PK(l3, h3), od, 0, 0, 0);
#undef ATT_PK
}
__device__ __forceinline__ void pv_d0(f32x16* o, int vb, bf16x8 pa0, bf16x8 pa1, bf16x8 pa2, bf16x8 pa3) {
    pv_one<0>(o[0], vb, pa0, pa1, pa2, pa3); pv_one<1>(o[1], vb, pa0, pa1, pa2, pa3); pv_one<2>(o[2], vb, pa0, pa1, pa2, pa3); pv_one<3>(o[3], vb, pa0, pa1, pa2, pa3);
}
template <bool ALIBI> __device__ __forceinline__ void init_real(f32x16& p0, f32x16& p1, float dq, float nslope) {
    if constexpr (ALIBI) {
#pragma unroll
        for (int r = 0; r < 16; ++r) { const float cr = (float)((r & 3) + 8 * (r >> 2)); p0[r] = nslope * fabsf(dq - cr); p1[r] = nslope * fabsf(dq - (cr + 32.f)); }
    } else { p0 = f32x16{}; p1 = f32x16{}; }
}
__device__ __forceinline__ void init_meta(f32x16& p0, f32x16& p1) {
#pragma unroll
    for (int r = 0; r < 16; ++r) { p0[r] = (r < 8) ? 0.f : -1e30f; p1[r] = -1e30f; }
}

template <int DQK, bool ALIBI, int SDEPTH>
__device__ __forceinline__ void attn_unit(const bf16* __restrict__ Qb, const int ldq,
                                          const bf16* __restrict__ K0, const int ldk0, const bf16* __restrict__ K1, const int ldk1,
                                          const bf16* __restrict__ Vg, const int ldv, bf16* __restrict__ Ob, const int ldo,
                                          const int kbase, const int q0, const float nslope, char* lds) {
    constexpr int SHM_K = shm_k<DQK>(), ND0 = DQK / 16, NLD = (DQK == 192) ? 5 : 4;
    const int tid = threadIdx.x, wid = tid >> 6, lane = tid & 63, r32 = lane & 31, hi = lane >> 5;
    char* V_lds = lds; char* K_lds = lds + 2 * SHM_V;
    float* ws = (float*)(lds + 2 * SHM_V + 2 * SHM_K) + wid * 64; float* li_l = ws; float* al_l = ws + 32;
    constexpr int NQR = nqreg<DQK>();
    float m_reg = -1e30f, l_reg = 0; f32x16 o[4] = {}; bf16x8 qr[NQR];
    const bf16* Qw = Qb + (long)(wid * QBLK + r32) * ldq + hi * 8;
    char* const qp = lds + 2 * SHM_V + 2 * SHM_K + NW * 64 * 4 + wid * (1024 * (ND0 - NQR)) + hi * 512 + r32 * 16;
#pragma unroll
    for (int d0 = 0; d0 < NQR; ++d0) qr[d0] = *reinterpret_cast<const bf16x8*>(Qw + d0 * 16);
#pragma unroll
    for (int d0 = NQR; d0 < ND0; ++d0) *reinterpret_cast<bf16x8*>(qp + (d0 - NQR) * 1024) = *reinterpret_cast<const bf16x8*>(Qw + d0 * 16);
    const int sr = tid >> 4, sc = (tid & 15) * 8, vst0 = v_st(sr, sc), vst1 = v_st(32 + sr, sc);
    const int kr2 = tid >> 3, sc2 = (tid & 7) * 8;
    const int vb0 = (int)(uintptr_t)V_lds + v_rd_base(lane);
    struct { bf16x8 vs0, vs1, ks0, ks1, ks2; } sr_[SDEPTH];
    const float qs = (float)(q0 + wid * QBLK + r32 - 4 * hi);
#define ATT_SLOAD(i, t) do { const int t_ = (t); const long g0 = t_ == 0 ? (long)(MR + (sr & 15)) : (long)(kbase + (t_ - 1) * KVBLK + sr); const long g1 = t_ == 0 ? g0 : g0 + 32; \
        sr_[i].vs0 = *reinterpret_cast<const bf16x8*>(Vg + g0 * ldv + sc); sr_[i].vs1 = *reinterpret_cast<const bf16x8*>(Vg + g1 * ldv + sc); \
        sr_[i].ks0 = *reinterpret_cast<const bf16x8*>(K0 + g0 * ldk0 + sc); sr_[i].ks1 = *reinterpret_cast<const bf16x8*>(K0 + g1 * ldk0 + sc); \
        if constexpr (DQK == 192) { const long g2 = t_ == 0 ? (long)(MR + (kr2 & 15)) : (long)(kbase + (t_ - 1) * KVBLK + kr2); sr_[i].ks2 = *reinterpret_cast<const bf16x8*>(K1 + g2 * ldk1 + sc2); } } while (0)
#define ATT_SWRITE(b, i) do { *(bf16x8*)(V_lds + (b) * SHM_V + vst0) = sr_[i].vs0; *(bf16x8*)(V_lds + (b) * SHM_V + vst1) = sr_[i].vs1; \
        *(bf16x8*)(K_lds + (b) * SHM_K + kswz<DQK>(sr, sc * 2)) = sr_[i].ks0; *(bf16x8*)(K_lds + (b) * SHM_K + kswz<DQK>(32 + sr, sc * 2)) = sr_[i].ks1; \
        if constexpr (DQK == 192) *(bf16x8*)(K_lds + (b) * SHM_K + kswz<DQK>(kr2, (128 + sc2) * 2)) = sr_[i].ks2; } while (0)
#define ATT_SWAIT() do { if constexpr (SDEPTH == 2) { if constexpr (NLD == 5) asm volatile("s_waitcnt vmcnt(5)" ::: "memory"); else asm volatile("s_waitcnt vmcnt(4)" ::: "memory"); } \
        else asm volatile("s_waitcnt vmcnt(0)" ::: "memory"); } while (0)
#define ATT_RESC(a) do { if (__any((a) < 1.f)) { if (hi == 0) al_l[r32] = (a); asm volatile("s_waitcnt lgkmcnt(0)" ::: "memory"); \
        _Pragma("unroll") for (int d = 0; d < 4; ++d) _Pragma("unroll") for (int r = 0; r < 16; ++r) o[d][r] *= al_l[crow(r, hi)]; } } while (0)
    f32x16 pA0, pA1, pB0, pB1; float mnA, mnB, alA, alB; bf16x8 pa0, pa1, pa2, pa3;
    constexpr int SE = 0, SO = SDEPTH - 1;
    ATT_SLOAD(SE, 0); asm volatile("s_waitcnt vmcnt(0)" ::: "memory"); ATT_SWRITE(0, SE); __syncthreads();
    init_meta(pA0, pA1); qkt<DQK>(pA0, pA1, K_lds, qr, qp, r32, hi); partialSM<DQK>(pA0, pA1, m_reg, mnA, alA);
    ATT_SLOAD(SO, 1); if constexpr (SDEPTH == 2) ATT_SLOAD(SE, 2);
    ATT_SWAIT(); ATT_SWRITE(1, SO); __syncthreads();
    for (int j = 1; j + 1 < NT; j += 2) {
        ATT_SBAR(); init_real<ALIBI>(pB0, pB1, qs - (float)((j - 1) * KVBLK), nslope); qkt<DQK>(pB0, pB1, K_lds + SHM_K, qr, qp, r32, hi);
        finishSM(pA0, pA1, alA, l_reg, pa0, pa1, pa2, pa3); ATT_SBAR();
        { const int tn = j + SDEPTH; ATT_SLOAD(SO, tn < NT ? tn : NT - 1); } ATT_SBAR();
        pv_d0(o, vb0, pa0, pa1, pa2, pa3); partialSM<DQK>(pB0, pB1, m_reg, mnB, alB);
        __syncthreads(); ATT_SWAIT(); ATT_SWRITE(0, SE);
        ATT_RESC(alB); __syncthreads();
        ATT_SBAR(); init_real<ALIBI>(pA0, pA1, qs - (float)(j * KVBLK), nslope); qkt<DQK>(pA0, pA1, K_lds, qr, qp, r32, hi);
        finishSM(pB0, pB1, alB, l_reg, pa0, pa1, pa2, pa3); ATT_SBAR();
        { const int tn = j + 1 + SDEPTH; ATT_SLOAD(SE, tn < NT ? tn : NT - 1); } ATT_SBAR();
        pv_d0(o, vb0 + SHM_V, pa0, pa1, pa2, pa3); partialSM<DQK>(pA0, pA1, m_reg, mnA, alA);
        __syncthreads(); ATT_SWAIT(); ATT_SWRITE(1, SO);
        ATT_RESC(alA); __syncthreads();
    }
    finishSM(pA0, pA1, alA, l_reg, pa0, pa1, pa2, pa3); ATT_SBAR();
    pv_d0(o, vb0, pa0, pa1, pa2, pa3);
    asm volatile("s_waitcnt vmcnt(0)" ::: "memory");
    if (hi == 0) li_l[r32] = l_reg; asm volatile("s_waitcnt lgkmcnt(0)" ::: "memory");
    float rli[16];
#pragma unroll
    for (int r = 0; r < 16; ++r) rli[r] = __builtin_amdgcn_rcpf(li_l[crow(r, hi)]);
    bf16* Ow = Ob + (long)(wid * QBLK) * ldo;
#pragma unroll
    for (int r = 0; r < 16; ++r) { const int orow = crow(r, hi);
#pragma unroll
        for (int d0 = 0; d0 < 4; d0 += 1) { const unsigned w = cvtpk(o[d0][r] * rli[r], 0.f); Ow[(long)orow * ldo + d0 * 32 + r32] = (bf16)(w & 0xffffu); } }
    __syncthreads();
#undef ATT_SLOAD
#undef ATT_SWRITE
#undef ATT_SWAIT
#undef ATT_RESC
}
#undef ATT_SBAR
}

constexpr int NWAVES = 8;
constexpr int NPH = 16;
#ifndef MK_N_LAUNCHES
#define MK_N_LAUNCHES 1
#endif
constexpr int N_LAUNCHES = MK_N_LAUNCHES;
#ifndef MLA_SDEPTH
#define MLA_SDEPTH 1
#endif

constexpr size_t MiB = 1u << 20;
constexpr size_t WS_CTL = 0, CTL_ZERO_BYTES = 1 * MiB;
constexpr size_t WS_ROPE = 1 * MiB;
constexpr size_t WS_SLAB = 4 * MiB;
constexpr size_t WS_PART = 8 * MiB;
constexpr size_t WS_MX0 = WS_SLAB, WS_MX1 = WS_PART;
constexpr size_t WS_W1GU = 16 * MiB, WS_W1D = 188 * MiB, WS_W2GU = 274 * MiB, WS_W2D = 446 * MiB;
constexpr size_t WS_WIN = 532 * MiB, WS_WG = 594 * MiB, WS_WUQ = 658 * MiB, WS_WUKV = 664 * MiB, WS_WBD = 668 * MiB, WS_WBM = 684 * MiB, WS_WO = 700 * MiB;
constexpr size_t WS_XN = 732 * MiB;
constexpr size_t WS_H = 862 * MiB;
constexpr size_t WS_P = 862 * MiB;
constexpr size_t WS_CQN = 1114 * MiB, WS_CKVN = 1147 * MiB;
constexpr size_t WS_QM = 1164 * MiB;
constexpr size_t WS_KV = 1262 * MiB;
constexpr size_t WS_ORAW = 1392 * MiB;
constexpr size_t WS_OM = 1520 * MiB, WS_OD = 1584 * MiB;
constexpr size_t WS_GATES = 862 * MiB;
constexpr size_t WS_T1 = 1164 * MiB;
constexpr size_t WS_MERGED = 1292 * MiB;
constexpr size_t WS_END = 1648 * MiB;
static_assert(WS_W1GU + (size_t)2 * DFF * DM * 2 <= WS_W1D && WS_W1D + (size_t)DM * DFF * 2 <= WS_W2GU && WS_W2GU + (size_t)2 * DFF * DM * 2 <= WS_W2D && WS_W2D + (size_t)DM * DFF * 2 <= WS_WIN, "ws map 1");
static_assert(WS_WIN + (size_t)INWP * DM * 2 <= WS_WG && WS_WG + (size_t)2 * DM * DM * 2 <= WS_WUQ && WS_WUQ + (size_t)3072 * 1024 * 2 <= WS_WUKV && WS_WUKV + (size_t)4096 * 512 * 2 <= WS_WBD, "ws map 2");
static_assert(WS_WBD + (size_t)DM * 2048 * 2 <= WS_WBM && WS_WBM + (size_t)DM * 2048 * 2 <= WS_WO && WS_WO + (size_t)DM * DM * 2 <= WS_XN && WS_XN + (size_t)MP * DM * 2 <= WS_H, "ws map 3");
static_assert(WS_H + (size_t)MP * DFF * 2 <= WS_END && WS_P + (size_t)MP * INWP * 2 <= WS_CQN && WS_CQN + (size_t)MP * 1024 * 2 <= WS_CKVN && WS_CKVN + (size_t)MP * 512 * 2 <= WS_QM, "ws map 4");
static_assert(WS_QM + (size_t)MP * 3072 * 2 <= WS_KV && WS_KV + (size_t)MP * 4096 * 2 <= WS_ORAW && WS_ORAW + (size_t)MR * 4096 * 2 <= WS_OM && WS_OM + (size_t)MR * 2048 * 2 <= WS_OD && WS_OD + (size_t)MR * 2048 * 2 <= WS_END, "ws map 5");
static_assert(WS_GATES + (size_t)MR * 2 * DM * 2 <= WS_QM && WS_T1 + (size_t)MR * DM * 2 <= WS_MERGED && WS_MERGED + (size_t)MR * DM * 2 <= WS_OM, "ws map 6");
static_assert(WS_ROPE + (size_t)(SEQ + NMETA) * 32 * 8 <= WS_SLAB && WS_SLAB + (size_t)16 * NMETA * DM * 4 <= WS_PART && WS_PART + (size_t)MP * 64 * 4 <= WS_W1GU, "ws map 7");
constexpr int CW_BAR = 4096;
constexpr int CW_SSQ1 = 65536, CW_SSQ2 = 98304, CW_SSQ3 = 131072;
static_assert(CW_BAR + 16 * 3456 <= CW_SSQ1 && CW_SSQ1 + MP <= CW_SSQ2 && CW_SSQ2 + MP <= CW_SSQ3 && (size_t)(CW_SSQ3 + MP) * 4 <= CTL_ZERO_BYTES, "CTL map");

constexpr int RING_OFF = 0, RING_BYTES = 155648;
constexpr int LDSCTL_OFF = RING_BYTES, MISC_OFF = LDSCTL_OFF + 320;
constexpr int LDS_BYTES = 156672;
static_assert(att::shm_total<128>() <= RING_BYTES && att::shm_total<192>() <= RING_BYTES && pg8::STAGE_BYTES <= RING_BYTES && LDS_BYTES <= 163840, "LDS map");
static_assert(MISC_OFF + 128 <= LDS_BYTES, "LDS map");

#define GAS __attribute__((address_space(1)))
#define LAS __attribute__((address_space(3)))
typedef unsigned short bf16;
typedef unsigned v4u __attribute__((ext_vector_type(4)));
typedef unsigned v2u __attribute__((ext_vector_type(2)));
typedef float f32x4 __attribute__((ext_vector_type(4)));
typedef GAS unsigned gu32;
#define RLX_AGENT __ATOMIC_RELAXED, __HIP_MEMORY_SCOPE_AGENT
#define LDS_WAIT() asm volatile("s_waitcnt lgkmcnt(0)" ::: "memory")
#define VM_WAIT() asm volatile("s_waitcnt vmcnt(0)" ::: "memory")
__device__ __forceinline__ unsigned f2bf(float f) { unsigned u = __builtin_bit_cast(unsigned, f); return (u + 0x7fffu + ((u >> 16) & 1u)) >> 16; }
__device__ __forceinline__ unsigned pk2(float lo, float hi) { return f2bf(lo) | (f2bf(hi) << 16); }
__device__ __forceinline__ float bflo(unsigned w) { return __uint_as_float(w << 16); }
__device__ __forceinline__ float bfhi(unsigned w) { return __uint_as_float(w & 0xffff0000u); }
__device__ __forceinline__ float wave_sum(float v) {
#pragma unroll
    for (int o = 1; o < 64; o <<= 1) v += __shfl_xor(v, o);
    return v;
}

#define XB_TMO      128
#define XB_XCNT(j)  (256  + 64 * (j))
#define XB_XSUB(j)  (1280 + 64 * (j))
#define XB_XGEN(j)  (2304 + 64 * (j))
#define XB_TOP      3328
#define XB_TOPGEN   3392
#define XCD_BAR_WORDS 3456
#define XB_SPIN_CAP (1u << 18)

__device__ __forceinline__ unsigned xb_ld(unsigned* p)              { return __hip_atomic_load(p, __ATOMIC_RELAXED, __HIP_MEMORY_SCOPE_AGENT); }
__device__ __forceinline__ unsigned xb_add(unsigned* p, unsigned v) { return __hip_atomic_fetch_add(p, v, __ATOMIC_RELAXED, __HIP_MEMORY_SCOPE_AGENT); }
__device__ __forceinline__ unsigned xb_xcc_id() { return (unsigned)__builtin_amdgcn_s_getreg((3 << 11) | 20) & 0xFu; }
#define XB_SPIN(cond, bar) do { unsigned _sp = 0; while (cond) { __builtin_amdgcn_s_sleep(1); \
    if ((++_sp & 255u) == 0u) { if (xb_ld(&(bar)[XB_TMO])) break; if (_sp > XB_SPIN_CAP) { atomicAdd(&(bar)[XB_TMO], 1u); break; } } } } while (0)

struct XcdBarrier {
    unsigned* bar; unsigned x;
    volatile LAS unsigned* st;
};

__device__ __forceinline__ XcdBarrier xcd_barrier_post(unsigned* bar, volatile LAS unsigned* st) {
    XcdBarrier b; b.bar = bar; b.x = xb_xcc_id(); b.st = st;
    if (threadIdx.x == 0) (void)xb_add(&bar[XB_XCNT(b.x)], 1u);
    return b;
}
__device__ __forceinline__ void xcd_barrier_complete(unsigned* bar, unsigned x, unsigned& nloc, unsigned& nx) {
    const unsigned G = gridDim.x * gridDim.y * gridDim.z;
    unsigned sum, cnt, mine, sp = 0u;
    for (;;) {
        sum = 0u; cnt = 0u; mine = 0u;
#pragma unroll
        for (unsigned j = 0; j < 16; ++j) { const unsigned c = xb_ld(&bar[XB_XCNT(j)]); sum += c; cnt += (c > 0u) ? 1u : 0u; mine = (j == x) ? c : mine; }
        if (sum == G) break;
        __builtin_amdgcn_s_sleep(1);
        if ((++sp & 255u) == 0u) { if (xb_ld(&bar[XB_TMO])) break; if (sp > XB_SPIN_CAP) { atomicAdd(&bar[XB_TMO], 1u); break; } }
    }
    nloc = mine > 0u ? mine : 1u; nx = cnt > 0u ? cnt : 1u;
}

__device__ __forceinline__ void xcd_barrier(const XcdBarrier& b) {
    asm volatile("s_waitcnt vmcnt(0)" ::: "memory");
    __syncthreads();
    if (threadIdx.x == 0) {
        unsigned* bar = b.bar;
        __builtin_amdgcn_s_waitcnt(0);
        unsigned nloc = b.st[0], nx = b.st[1];
        if (nloc == 0u) { xcd_barrier_complete(bar, b.x, nloc, nx); b.st[0] = nloc; b.st[1] = nx; }
        const unsigned old = xb_add(&bar[XB_XSUB(b.x)], 1u);
        const unsigned gen = old / nloc;
        if (old + 1u == (gen + 1u) * nloc) {
            __builtin_amdgcn_fence(__ATOMIC_RELEASE, "agent");
            asm volatile("s_waitcnt vmcnt(0)" ::: "memory");
            const unsigned og = xb_add(&bar[XB_TOP], 1u);
            const unsigned tg = og / nx;
            if (og + 1u == (tg + 1u) * nx) xb_add(&bar[XB_TOPGEN], 1u);
            else XB_SPIN(xb_ld(&bar[XB_TOPGEN]) == tg, bar);
            __builtin_amdgcn_fence(__ATOMIC_ACQUIRE, "agent");
            xb_add(&bar[XB_XGEN(b.x)], 1u);
            asm volatile("s_waitcnt vmcnt(0)" ::: "memory");
        } else {
            XB_SPIN(xb_ld(&bar[XB_XGEN(b.x)]) == gen, bar);
            __builtin_amdgcn_fence(__ATOMIC_ACQUIRE, "agent");
            asm volatile("s_waitcnt vmcnt(0)" ::: "memory");
        }
    }
    __syncthreads();
}

template <int MAP> __device__ __forceinline__ int map_row(int n) {
    if (MAP == 1) return 256 * (n >> 7) + (n & 127);
    if (MAP == 2) return 256 * (n >> 7) + 128 + (n & 127);
    if (MAP == 3) { if (n < PC_KR) return n; const int j = n - PC_KR; return PC_KR + (j < 32 ? 2 * j : 2 * (j - 32) + 1); }
    if (MAP == 4) { const int h = n / 192, d = n % 192; if (d < 128) return n; const int j = d - 128; return h * 192 + 128 + (j < 32 ? 2 * j : 2 * (j - 32) + 1); }
    return n;
}
template <int MAP> __device__ __forceinline__ void p0_transpose_item(const float* W, int K, int N, bf16* WT, LAS float* scr, int item, int lane, const float* gain = nullptr) {
    const int nblk = N / 32, kb = item / nblk, nb = item % nblk, k0 = 64 * kb, n0 = 32 * nb;
#pragma unroll 8
    for (int i = 0; i < 32; ++i) { const int kk = 2 * i + (lane >> 5); scr[kk * 33 + (lane & 31)] = W[(size_t)(k0 + kk) * N + n0 + (lane & 31)]; }
    LDS_WAIT(); asm volatile("" ::: "memory");
    const int c = lane & 7;
    f32x4 g0 = (f32x4){1.f, 1.f, 1.f, 1.f}, g1 = g0;
    if (gain) { g0 = *(const GAS f32x4*)(gain + k0 + 8 * c); g1 = *(const GAS f32x4*)(gain + k0 + 8 * c + 4); }
#pragma unroll
    for (int j = 0; j < 4; ++j) { const int n = (lane >> 3) + 8 * j; const LAS float* s = scr + (8 * c) * 33 + n;
        v4u o; o.x = pk2(s[0 * 33] * g0.x, s[1 * 33] * g0.y); o.y = pk2(s[2 * 33] * g0.z, s[3 * 33] * g0.w); o.z = pk2(s[4 * 33] * g1.x, s[5 * 33] * g1.y); o.w = pk2(s[6 * 33] * g1.z, s[7 * 33] * g1.w);
        *(GAS v4u*)(WT + (size_t)map_row<MAP>(n0 + n) * K + k0 + 8 * c) = o; }
    LDS_WAIT(); asm volatile("" ::: "memory");
}
__device__ __forceinline__ void rms_row_to_bf16(const float* xrow, const float* g, bf16* orow, int lane) {
    const GAS f32x4* xr = (const GAS f32x4*)xrow + lane; const GAS f32x4* gr = (const GAS f32x4*)g + lane;
    f32x4 v[16]; float s = 0.f;
#pragma unroll
    for (int j = 0; j < 16; ++j) { v[j] = xr[64 * j]; s += (v[j].x * v[j].x + v[j].y * v[j].y) + (v[j].z * v[j].z + v[j].w * v[j].w); }
    const float rstd = 1.f / sqrtf(wave_sum(s) * (1.f / DM) + EPS);
    GAS v2u* o8 = (GAS v2u*)orow + lane;
#pragma unroll
    for (int j = 0; j < 16; ++j) { const f32x4 gg = gr[64 * j]; v2u w; w.x = pk2(v[j].x * rstd * gg.x, v[j].y * rstd * gg.y); w.y = pk2(v[j].z * rstd * gg.z, v[j].w * rstd * gg.w); o8[64 * j] = w; }
}
__device__ __forceinline__ void zero_row_bf16(bf16* orow, int nelem, int lane) {
    GAS v4u* o = (GAS v4u*)orow + lane;
    for (int j = 0; j < nelem / 512; ++j) o[64 * j] = (v4u){0u, 0u, 0u, 0u};
}
__device__ __forceinline__ void rms_row_inplace(float* xrow, const float* g, int lane) {
    GAS f32x4* xr = (GAS f32x4*)xrow + lane; const GAS f32x4* gr = (const GAS f32x4*)g + lane;
    f32x4 v[16]; float s = 0.f;
#pragma unroll
    for (int j = 0; j < 16; ++j) { v[j] = xr[64 * j]; s += (v[j].x * v[j].x + v[j].y * v[j].y) + (v[j].z * v[j].z + v[j].w * v[j].w); }
    const float rstd = 1.f / sqrtf(wave_sum(s) * (1.f / DM) + EPS);
#pragma unroll
    for (int j = 0; j < 16; ++j) { const f32x4 gg = gr[64 * j]; xr[64 * j] = v[j] * rstd * gg; }
}

struct Args { const float* in[27]; float* out; unsigned char* ws; int ph_lo, ph_hi; };
static_assert(sizeof(Args) == 27 * 8 + 8 + 8 + 8, "Args has no padding");
enum { I_X = 0, I_META, I_N1, I_W1G, I_W1U, I_W1D, I_NMIX, I_WIN, I_LQ1, I_LK1, I_LQ2, I_LK2, I_SUBLN, I_QNORM, I_WUQ, I_KVNORM, I_WUKV, I_WG, I_BG, I_WBD, I_WBM, I_WO, I_N2, I_W2G, I_W2U, I_W2D, I_NF };

__global__ void __launch_bounds__(NWAVES * 64, 2) fwd(Args  ) {
    extern __shared__ __attribute__((aligned(16))) unsigned char lds[];
    LAS unsigned char* const L = (LAS unsigned char*)lds;
    volatile LAS unsigned* const MISC = (volatile LAS unsigned*)(L + MISC_OFF);
    const int tid = threadIdx.x, lane = tid & 63, wave = __builtin_amdgcn_readfirstlane(tid >> 6);
    const int G = gridDim.x; const int bx = blockIdx.x; const int vcu = (G % 8 == 0) ? (bx % 8) * (G / 8) + bx / 8 : bx;
typedef const __attribute__((address_space(4))) Args* CArgsP;
#define KARGS() ({ CArgsP p_ = (CArgsP)__builtin_amdgcn_kernarg_segment_ptr(); asm volatile("" : "+s"(p_)); p_; })
    int lo, hi; { CArgsP A0 = KARGS(); lo = A0->ph_lo; hi = A0->ph_hi; }
    gu32* const ctl = (gu32*)(KARGS()->ws + WS_CTL);
    for (int u = tid; u < (LDS_BYTES - LDSCTL_OFF) / 4; u += NWAVES * 64) ((LAS unsigned*)(L + LDSCTL_OFF))[u] = 0u;
    __syncthreads();
    const XcdBarrier bar = xcd_barrier_post((unsigned*)(ctl + CW_BAR) + lo * XCD_BAR_WORDS, MISC + 8);
#define GRID_BAR() xcd_barrier(bar)
#ifndef PH_MASK
#define PH_MASK 0xFFFF
#endif
#define IN(k) ((((PH_MASK) >> (k)) & 1) && lo <= (k) && (k) < hi)
#define BOTH(k) (IN(k) && IN((k) + 1))
    const int gw = vcu * NWAVES + wave, NGW = G * NWAVES;
#define PHASE_PTRS() CArgsP const A = KARGS(); unsigned char* const ws = A->ws; float* const out = A->out; (void)out; \
    bf16* const XN = (bf16*)(ws + WS_XN); bf16* const HB = (bf16*)(ws + WS_H); bf16* const PB = (bf16*)(ws + WS_P); (void)XN; (void)HB; (void)PB; \
    bf16* const CQN = (bf16*)(ws + WS_CQN); bf16* const CKVN = (bf16*)(ws + WS_CKVN); bf16* const QM = (bf16*)(ws + WS_QM); bf16* const KV = (bf16*)(ws + WS_KV); (void)CQN; (void)CKVN; (void)QM; (void)KV; \
    bf16* const ORAW = (bf16*)(ws + WS_ORAW); bf16* const OM = (bf16*)(ws + WS_OM); bf16* const OD = (bf16*)(ws + WS_OD); (void)ORAW; (void)OM; (void)OD; \
    bf16* const GATES = (bf16*)(ws + WS_GATES); bf16* const T1 = (bf16*)(ws + WS_T1); bf16* const MERGED = (bf16*)(ws + WS_MERGED); (void)GATES; (void)T1; (void)MERGED; \
    float* const SLAB = (float*)(ws + WS_SLAB); float* const PART = (float*)(ws + WS_PART); float* const ROPE = (float*)(ws + WS_ROPE); (void)SLAB; (void)PART; (void)ROPE
    typedef pg8::bf16_t pbf;
#define GEMM_PHASE(EPI_T, Aptr, Btptr, Mr, Nr, Kr, LDA, LDB, EPI) GEMM_PHASE_S(EPI_T, Aptr, Btptr, Mr, Nr, Kr, LDA, LDB, EPI, 0)
#define GEMM_PHASE_S(EPI_T, Aptr, Btptr, Mr, Nr, Kr, LDA, LDB, EPI, NSPLIT) do { pg8::Gemm g_{(const pbf*)(Aptr), (const pbf*)(Btptr), (Mr), (Nr), (Kr), (LDA), (LDB)}; \
        pg8::StaticOrder S_; S_.init((Mr), (Nr), (Kr), G, bx, (NSPLIT)); pg8::gemm_phase<EPI_T, pg8::StaticOrder, true, true>(L + RING_OFF, g_, S_, EPI); } while (0)

    if (IN(0)) { PHASE_PTRS();
        LAS float* scr = (LAS float*)(L + RING_OFF + wave * 16384);
        constexpr int IT_FG = (DM / 64) * (DFF / 32), IT_FD = (DFF / 64) * (DM / 32), IT_WIN = (DM / 64) * (INW / 32), IT_WG = (DM / 64) * (2 * DM / 32),
                      IT_UQ = (1024 / 64) * (3072 / 32), IT_UKV = (512 / 64) * (4096 / 32), IT_BR = (2048 / 64) * (DM / 32), IT_WO = (DM / 64) * (DM / 32);
        constexpr int NITEMS = 4 * IT_FG + 2 * IT_FD + IT_WIN + IT_WG + IT_UQ + IT_UKV + 2 * IT_BR + IT_WO;
        for (int it = gw; it < NITEMS; it += NGW) {
            int r = it;
            if (r < IT_FG) { p0_transpose_item<1>(A->in[I_W1G], DM, DFF, (bf16*)(ws + WS_W1GU), scr, r, lane); continue; } r -= IT_FG;
            if (r < IT_FG) { p0_transpose_item<2>(A->in[I_W1U], DM, DFF, (bf16*)(ws + WS_W1GU), scr, r, lane); continue; } r -= IT_FG;
            if (r < IT_FD) { p0_transpose_item<0>(A->in[I_W1D], DFF, DM, (bf16*)(ws + WS_W1D), scr, r, lane); continue; } r -= IT_FD;
            if (r < IT_WIN) { p0_transpose_item<3>(A->in[I_WIN], DM, INW, (bf16*)(ws + WS_WIN), scr, r, lane, A->in[I_NMIX]); continue; } r -= IT_WIN;
            if (r < IT_WG) { p0_transpose_item<0>(A->in[I_WG], DM, 2 * DM, (bf16*)(ws + WS_WG), scr, r, lane, A->in[I_NMIX]); continue; } r -= IT_WG;
            if (r < IT_UQ) { p0_transpose_item<4>(A->in[I_WUQ], 1024, 3072, (bf16*)(ws + WS_WUQ), scr, r, lane); continue; } r -= IT_UQ;
            if (r < IT_UKV) { p0_transpose_item<0>(A->in[I_WUKV], 512, 4096, (bf16*)(ws + WS_WUKV), scr, r, lane); continue; } r -= IT_UKV;
            if (r < IT_BR) { p0_transpose_item<0>(A->in[I_WBD], 2048, DM, (bf16*)(ws + WS_WBD), scr, r, lane); continue; } r -= IT_BR;
            if (r < IT_BR) { p0_transpose_item<0>(A->in[I_WBM], 2048, DM, (bf16*)(ws + WS_WBM), scr, r, lane); continue; } r -= IT_BR;
            if (r < IT_WO) { p0_transpose_item<0>(A->in[I_WO], DM, DM, (bf16*)(ws + WS_WO), scr, r, lane); continue; } r -= IT_WO;
            if (r < IT_FG) { p0_transpose_item<1>(A->in[I_W2G], DM, DFF, (bf16*)(ws + WS_W2GU), scr, r, lane, A->in[I_N2]); continue; } r -= IT_FG;
            if (r < IT_FG) { p0_transpose_item<2>(A->in[I_W2U], DM, DFF, (bf16*)(ws + WS_W2GU), scr, r, lane, A->in[I_N2]); continue; } r -= IT_FG;
            p0_transpose_item<0>(A->in[I_W2D], DFF, DM, (bf16*)(ws + WS_W2D), scr, r, lane);
        }
        for (int m = gw; m < INWP - INW; m += NGW) zero_row_bf16((bf16*)(ws + WS_WIN) + (size_t)(INW + m) * DM, DM, lane);
        for (int m = gw; m < MP; m += NGW) {
            if (m < MR) rms_row_to_bf16(A->in[I_X] + (size_t)m * DM, A->in[I_N1], XN + (size_t)m * DM, lane);
            else if (m < MR + NMETA) rms_row_to_bf16(A->in[I_META] + (size_t)(m - MR) * DM, A->in[I_N1], XN + (size_t)m * DM, lane);
            else zero_row_bf16(XN + (size_t)m * DM, DM, lane);
        }
        {
            static constexpr double INVF[32] = {1.0, 0.7498942093324559, 0.5623413251903491, 0.4216965034285822, 0.31622776601683794, 0.23713737056616552, 0.1778279410038923, 0.1333521432163324,
                0.1, 0.07498942093324558, 0.05623413251903491, 0.042169650342858224, 0.03162277660168379, 0.023713737056616554, 0.01778279410038923, 0.01333521432163324,
                0.01, 0.007498942093324558, 0.005623413251903491, 0.004216965034285823, 0.0031622776601683794, 0.0023713737056616554, 0.0017782794100389228, 0.001333521432163324,
                0.001, 0.0007498942093324559, 0.0005623413251903491, 0.00042169650342858224, 0.00031622776601683794, 0.00023713737056616554, 0.00017782794100389227, 0.0001333521432163324};
            for (int idx = (vcu * NWAVES + wave) * 64 + lane; idx < (SEQ + NMETA) * 32; idx += NGW * 64) {
                const int pos = idx >> 5, i = idx & 31; double rev = (double)pos * INVF[i] * 0.15915494309189535; rev -= __builtin_floor(rev);
                const float fr = (float)rev; ROPE[2 * idx] = __builtin_amdgcn_cosf(fr); ROPE[2 * idx + 1] = __builtin_amdgcn_sinf(fr);
            }
        }
        if (BOTH(0)) GRID_BAR();
    }

    if (IN(1)) { PHASE_PTRS(); pg8::EpiSwiglu E{(pbf*)HB, DFF, nullptr}; GEMM_PHASE(pg8::EpiSwiglu, XN, ws + WS_W1GU, MP, 2 * DFF, DM, DM, DM, E); if (BOTH(1)) GRID_BAR(); }
    if (IN(2)) { PHASE_PTRS(); pg8::EpiResid E{A->in[I_X], out, SLAB, (pbf*)XN, PART, 0.5f}; GEMM_PHASE_S(pg8::EpiResid, HB, ws + WS_W1D, MR, DM, DFF, DFF, DFF, E, 16); if (BOTH(2)) GRID_BAR(); }
    if (IN(3)) { PHASE_PTRS(); float* const ssq = (float*)(ctl + CW_SSQ1);
        for (int m = gw; m < MR; m += NGW) { const float q = wave_sum(PART[(size_t)m * 64 + lane]); if (lane == 0) ssq[m] = q; }
        if (gw >= NGW - NMETA) { const int r = gw - (NGW - NMETA); const GAS f32x4* xr = (const GAS f32x4*)(A->in[I_META] + (size_t)r * DM) + lane; GAS v2u* o8 = (GAS v2u*)(XN + (size_t)(MR + r) * DM) + lane; float q = 0.f;
            for (int j = 0; j < 16; ++j) { f32x4 v = xr[64 * j];
                for (int sp = 0; sp < 16; ++sp) v = v + ((const GAS f32x4*)(SLAB + ((size_t)sp * NMETA + r) * DM) + lane)[64 * j];
                q += (v.x * v.x + v.y * v.y) + (v.z * v.z + v.w * v.w); v2u w; w.x = pk2(v.x, v.y); w.y = pk2(v.z, v.w); o8[64 * j] = w; }
            q = wave_sum(q); if (lane == 0) ssq[MR + r] = q; }
        if (BOTH(3)) GRID_BAR();
    }
    if (IN(4)) { PHASE_PTRS(); pg8::EpiB<pg8::MB_WIN> E{(pbf*)PB, INWP, nullptr, nullptr, nullptr, ROPE, (const float*)(ctl + CW_SSQ1)}; GEMM_PHASE(pg8::EpiB<pg8::MB_WIN>, XN, ws + WS_WIN, MP, INWP, DM, DM, DM, E); if (BOTH(4)) GRID_BAR(); }
    if (IN(5)) { PHASE_PTRS();
        for (int m = gw; m < MP; m += NGW) {
            const bf16* prow = PB + (size_t)m * INWP;
            {   const v4u a = *(const GAS v4u*)(prow + PC_CQ + 8 * lane), b = *(const GAS v4u*)(prow + PC_CQ + 512 + 8 * lane);
                float x[16] = {bflo(a.x), bfhi(a.x), bflo(a.y), bfhi(a.y), bflo(a.z), bfhi(a.z), bflo(a.w), bfhi(a.w), bflo(b.x), bfhi(b.x), bflo(b.y), bfhi(b.y), bflo(b.z), bfhi(b.z), bflo(b.w), bfhi(b.w)};
                float s = 0.f;
#pragma unroll
                for (int j = 0; j < 16; ++j) s += x[j] * x[j];
                const float rstd = 1.f / sqrtf(wave_sum(s) * (1.f / 1024.f) + EPS);
                const float* g = A->in[I_QNORM];
#pragma unroll
                for (int hseg = 0; hseg < 2; ++hseg) { const f32x4 g0 = *(const GAS f32x4*)(g + hseg * 512 + 8 * lane), g1 = *(const GAS f32x4*)(g + hseg * 512 + 8 * lane + 4); const float* xx = x + 8 * hseg;
                    v4u o; o.x = pk2(xx[0] * rstd * g0.x, xx[1] * rstd * g0.y); o.y = pk2(xx[2] * rstd * g0.z, xx[3] * rstd * g0.w); o.z = pk2(xx[4] * rstd * g1.x, xx[5] * rstd * g1.y); o.w = pk2(xx[6] * rstd * g1.z, xx[7] * rstd * g1.w);
                    *(GAS v4u*)(CQN + (size_t)m * 1024 + hseg * 512 + 8 * lane) = o; } }
            {   const v4u a = *(const GAS v4u*)(prow + PC_CKV + 8 * lane);
                float x[8] = {bflo(a.x), bfhi(a.x), bflo(a.y), bfhi(a.y), bflo(a.z), bfhi(a.z), bflo(a.w), bfhi(a.w)};
                float s = 0.f;
#pragma unroll
                for (int j = 0; j < 8; ++j) s += x[j] * x[j];
                const float rstd = 1.f / sqrtf(wave_sum(s) * (1.f / 512.f) + EPS);
                const float* g = A->in[I_KVNORM];
                const f32x4 g0 = *(const GAS f32x4*)(g + 8 * lane), g1 = *(const GAS f32x4*)(g + 8 * lane + 4);
                v4u o; o.x = pk2(x[0] * rstd * g0.x, x[1] * rstd * g0.y); o.y = pk2(x[2] * rstd * g0.z, x[3] * rstd * g0.w); o.z = pk2(x[4] * rstd * g1.x, x[5] * rstd * g1.y); o.w = pk2(x[6] * rstd * g1.z, x[7] * rstd * g1.w);
                *(GAS v4u*)(CKVN + (size_t)m * 512 + 8 * lane) = o; }
        }
        if (BOTH(5)) GRID_BAR();
    }
    if (IN(6)) { PHASE_PTRS();
        { pg8::EpiB<pg8::MB_QUP> E{(pbf*)QM, 3072, nullptr, nullptr, nullptr, ROPE, nullptr}; GEMM_PHASE(pg8::EpiB<pg8::MB_QUP>, CQN, ws + WS_WUQ, MP, 3072, 1024, 1024, 1024, E); }
        { pg8::EpiB<pg8::MB_PLAIN> E{(pbf*)KV, 4096, nullptr, nullptr, nullptr, nullptr, nullptr}; GEMM_PHASE(pg8::EpiB<pg8::MB_PLAIN>, CKVN, ws + WS_WUKV, MP, 4096, 512, 512, 512, E); }
        if (BOTH(6)) GRID_BAR();
    }
    if (IN(7)) { PHASE_PTRS();
        char* const al = (char*)lds + RING_OFF;
#ifndef ATT_NO_DIFF
        for (int Lu = vcu; Lu < 2048; Lu += G) {
            const int i = Lu >> 8, x = (Lu >> 5) & 7, j = Lu & 31, bh = 4 * x + (i >> 1), b = bh >> 3, h = bh & 7, c = i & 1, vh = j >> 4, qb = j & 15;
            const size_t qrow = (size_t)b * SEQ + (size_t)qb * 256;
            const float nslope = -__builtin_amdgcn_exp2f(-(float)(h + 1)) * 11.313708498984761f;
            att::attn_unit<128, true, 2>(PB + qrow * INWP + PC_DQ + h * 256 + c * 128, INWP, PB + PC_DK + h * 256 + c * 128, INWP, nullptr, 0, PB + PC_DV + h * 256 + vh * 128, INWP,
                                         ORAW + qrow * 4096 + c * 2048 + h * 256 + vh * 128, 4096, b * SEQ, qb * 256, nslope, al);
        }
#endif
#ifndef ATT_NO_MLA
        for (int Lu = vcu; Lu < 1024; Lu += G) {
            const int i = Lu >> 8, x = (Lu >> 5) & 7, j = Lu & 31, bh = 8 * x + 2 * i + (j >> 4), b = bh >> 4, h = bh & 15, qb = j & 15;
            const size_t qrow = (size_t)b * SEQ + (size_t)qb * 256;
            att::attn_unit<192, false, MLA_SDEPTH>(QM + qrow * 3072 + h * 192, 3072, KV + h * 256, 4096, PB + PC_KR, INWP, KV + h * 256 + 128, 4096,
                                                   OM + qrow * 2048 + h * 128, 2048, b * SEQ, qb * 256, 0.f, al);
        }
#endif
        if (BOTH(7)) GRID_BAR();
    }
    if (IN(8)) { PHASE_PTRS();
        float lam;
        {   const float* q1 = A->in[I_LQ1]; const float* k1 = A->in[I_LK1]; const float* q2 = A->in[I_LQ2]; const float* k2 = A->in[I_LK2];
            const float s1 = wave_sum(q1[lane] * k1[lane] + q1[lane + 64] * k1[lane + 64]), s2 = wave_sum(q2[lane] * k2[lane] + q2[lane + 64] * k2[lane + 64]);
            lam = __builtin_amdgcn_exp2f(s1 * 1.4426950408889634f) - __builtin_amdgcn_exp2f(s2 * 1.4426950408889634f) + 0.2f; }
        const f32x4 sg = *(const GAS f32x4*)(A->in[I_SUBLN] + 4 * lane);
        for (int m = gw; m < MR; m += NGW) {
            const bf16* o1 = ORAW + (size_t)m * 4096; const bf16* o2 = o1 + 2048;
#pragma unroll 2
            for (int h = 0; h < 8; ++h) {
                const v2u a = *(const GAS v2u*)(o1 + h * 256 + 4 * lane), b = *(const GAS v2u*)(o2 + h * 256 + 4 * lane);
                const float f0 = bflo(a.x) - lam * bflo(b.x), f1 = bfhi(a.x) - lam * bfhi(b.x), f2 = bflo(a.y) - lam * bflo(b.y), f3 = bfhi(a.y) - lam * bfhi(b.y);
                const float rstd = 1.f / sqrtf(wave_sum((f0 * f0 + f1 * f1) + (f2 * f2 + f3 * f3)) * (1.f / 256.f) + EPS);
                v2u o; o.x = pk2(f0 * rstd * sg.x * 0.8f, f1 * rstd * sg.y * 0.8f); o.y = pk2(f2 * rstd * sg.z * 0.8f, f3 * rstd * sg.w * 0.8f);
                *(GAS v2u*)(OD + (size_t)m * 2048 + h * 256 + 4 * lane) = o;
            }
        }
        { pg8::EpiB<pg8::MB_GATE> E{(pbf*)GATES, 2 * DM, A->in[I_BG], nullptr, nullptr, nullptr, (const float*)(ctl + CW_SSQ1)}; GEMM_PHASE(pg8::EpiB<pg8::MB_GATE>, XN, ws + WS_WG, MR, 2 * DM, DM, DM, DM, E); }
        if (BOTH(8)) GRID_BAR();
    }
    if (IN(9)) { PHASE_PTRS(); pg8::EpiB<pg8::MB_BR1> E{(pbf*)T1, DM, nullptr, (const pbf*)GATES, nullptr, nullptr, nullptr}; GEMM_PHASE(pg8::EpiB<pg8::MB_BR1>, OD, ws + WS_WBD, MR, DM, 2048, 2048, 2048, E); if (BOTH(9)) GRID_BAR(); }
    if (IN(10)) { PHASE_PTRS(); pg8::EpiB<pg8::MB_BR2> E{(pbf*)MERGED, DM, nullptr, (const pbf*)GATES, (const pbf*)T1, nullptr, nullptr}; GEMM_PHASE(pg8::EpiB<pg8::MB_BR2>, OM, ws + WS_WBM, MR, DM, 2048, 2048, 2048, E); if (BOTH(10)) GRID_BAR(); }
    if (IN(11)) { PHASE_PTRS(); pg8::EpiResid E{out, out, SLAB, (pbf*)XN, PART, 1.0f}; GEMM_PHASE(pg8::EpiResid, MERGED, ws + WS_WO, MR, DM, DM, DM, DM, E); if (BOTH(11)) GRID_BAR(); }
    if (IN(12)) { PHASE_PTRS(); float* const ssq = (float*)(ctl + CW_SSQ2);
        for (int m = gw; m < MR; m += NGW) { const float q = wave_sum(PART[(size_t)m * 64 + lane]); if (lane == 0) ssq[m] = q; }
        if (BOTH(12)) GRID_BAR();
    }
    if (IN(13)) { PHASE_PTRS(); pg8::EpiSwiglu E{(pbf*)HB, DFF, (const float*)(ctl + CW_SSQ2)}; GEMM_PHASE(pg8::EpiSwiglu, XN, ws + WS_W2GU, MR, 2 * DFF, DM, DM, DM, E); if (BOTH(13)) GRID_BAR(); }
    if (IN(14)) { PHASE_PTRS(); pg8::EpiResid E{out, out, SLAB, nullptr, PART, 0.5f}; GEMM_PHASE(pg8::EpiResid, HB, ws + WS_W2D, MR, DM, DFF, DFF, DFF, E); if (BOTH(14)) GRID_BAR(); }
    if (IN(15)) { PHASE_PTRS();
        for (int m = gw; m < MR; m += NGW) { GAS f32x4* xr = (GAS f32x4*)(out + (size_t)m * DM) + lane; const GAS f32x4* gr = (const GAS f32x4*)A->in[I_NF] + lane;
            const float rstd = 1.0f / sqrtf(wave_sum(PART[(size_t)m * 64 + lane]) * (1.0f / DM) + EPS);
#pragma unroll
            for (int j = 0; j < 16; ++j) xr[64 * j] = xr[64 * j] * rstd * gr[64 * j]; }
    }
#undef IN
#undef BOTH
#undef GRID_BAR
#undef GEMM_PHASE
}

extern "C" void kernel_launch(void* const* d_in, const int* in_sizes, int n_in, void* d_out, int out_size, void* d_ws, size_t ws_size, hipStream_t stream) {
    static int grid = 0;
    if (grid == 0) {
        if (n_in != 27 || in_sizes[0] != MR * DM || out_size != MR * DM || ws_size < WS_END) {
            fprintf(stderr, "kernel_launch: built for 27 inputs, x/out of %d floats, >= %zu bytes of workspace; got n_in %d, in0 %d, out %d, ws %zu; nothing launched\n", MR * DM, (size_t)WS_END, n_in, n_in > 0 ? in_sizes[0] : -1, out_size, ws_size);
            grid = -1; return; }
        int dev = 0, cus = 0, per_cu = 0;
        if (hipGetDevice(&dev) != hipSuccess || hipDeviceGetAttribute(&cus, hipDeviceAttributeMultiprocessorCount, dev) != hipSuccess) { fprintf(stderr, "kernel_launch: device query failed\n"); grid = -1; return; }
        if (hipFuncSetAttribute((const void*)fwd, hipFuncAttributeMaxDynamicSharedMemorySize, LDS_BYTES) != hipSuccess) { fprintf(stderr, "kernel_launch: hipFuncSetAttribute failed\n"); grid = -1; return; }
        if (hipOccupancyMaxActiveBlocksPerMultiprocessor(&per_cu, (const void*)fwd, NWAVES * 64, LDS_BYTES) != hipSuccess || per_cu < 1)
            fprintf(stderr, "kernel_launch: note: occupancy query reports %d workgroups per CU\n", per_cu);
        (void)hipGetLastError();
        grid = cus;
    }
    if (grid < 0) return;
    if (hipMemsetAsync((char*)d_ws + WS_CTL, 0, CTL_ZERO_BYTES, stream) != hipSuccess) { fprintf(stderr, "kernel_launch: memset failed\n"); return; }
    Args a{};
    for (int i = 0; i < 27; ++i) a.in[i] = (const float*)d_in[i];
    a.out = (float*)d_out; a.ws = (unsigned char*)d_ws;
#ifdef PROBE_DUP
    const int cuts[4] = {0, PROBE_DUP + 1, PROBE_DUP + 1, NPH}; const int nl = (PROBE_DUP + 1 < NPH) ? 3 : 2;
    for (int li = 0; li < nl; ++li) {
        a.ph_lo = li == 1 ? PROBE_DUP : cuts[li]; a.ph_hi = cuts[li + 1];
#else
    for (int li = 0; li < N_LAUNCHES; ++li) {
        a.ph_lo = (N_LAUNCHES == 1) ? 0 : li * NPH / N_LAUNCHES; a.ph_hi = (N_LAUNCHES == 1) ? NPH : (li + 1) * NPH / N_LAUNCHES;
#endif
        hipLaunchKernelGGL(fwd, dim3(grid), dim3(NWAVES * 64), LDS_BYTES, stream, a);
        const hipError_t le = hipPeekAtLastError();
        if (le != hipSuccess) { fprintf(stderr, "kernel_launch: launch %d failed: %s\n", li, hipGetErrorName(le)); break; }
    }
}
```

```cpp
#include <hip/hip_runtime.h>
#include <cstdio>
#include <cstdint>

constexpr int DM = 4096, BATCH = 4, SEQ = 4096, NMETA = 16, DFF = 11008;
#ifndef LDH_PAD
#define LDH_PAD 64
#endif
constexpr int LDH = DFF + LDH_PAD;
constexpr int MR = BATCH * SEQ;
constexpr int MP = MR + 256;
constexpr int INW = 7744, INWP = 7936;
constexpr int PC_DQ = 0, PC_DK = 2048, PC_DV = 4096, PC_CQ = 6144, PC_CKV = 7168, PC_KR = 7680;
constexpr float EPS = 1e-6f;
constexpr float QSCALE_DIFF = 0.12751743082459868f;
constexpr float QSCALE_MLA = 0.10411754627697264f;
#ifndef MLA_B
#define MLA_B 1
#endif
constexpr bool QUP_PRESCALE = MLA_B != 0;

#ifndef PROBE_MODE_CONST
#define PROBE_MODE_CONST 0
#endif
__device__ __forceinline__ constexpr int probe_mode() { return PROBE_MODE_CONST; }
namespace pg8 {
#define PG8_LAS __attribute__((address_space(3)))
typedef unsigned short bf16_t;
typedef short bf16x8 __attribute__((ext_vector_type(8)));
typedef float f32x4 __attribute__((ext_vector_type(4)));
typedef unsigned u32x4 __attribute__((ext_vector_type(4)));
constexpr int BM = 256, BK = 64, HALF = 128, HTB = HALF * BK * 2  , STAGE_BYTES = 8 * HTB, NXCD = 8;

__host__ __device__ __forceinline__ int lds_byte(int r, int c) { const int st = (r >> 4) * 2 + (c >> 5), rr = r & 15, cc = c & 31, ob = rr * 64 + cc * 2; return st * 1024 + (ob ^ (((ob >> 9) & 1) << 5)); }
__host__ __device__ __forceinline__ void stage_rc(int b, int& R, int& C) { const int st = b / 1024, sb = b % 1024, swz = sb ^ (((sb >> 9) & 1) << 5); R = (st >> 1) * 16 + swz / 64; C = (st & 1) * 32 + (swz % 64) / 2; }
__host__ __device__ __forceinline__ int perm32(int rho) { const int n = rho >> 4, i = rho & 15; return 8 * (i >> 2) + 4 * n + (i & 3); }

struct Unit { int pm, pn, kt0, nkt, sp; };
struct Gemm { const bf16_t* A; const bf16_t* Bt; int M, N, K, lda, ldb, blk; };

#ifndef SPLIT_FIRST_ODD
#define SPLIT_FIRST_ODD 0
#endif
struct StaticOrder {
    int nM, nN, nwg, G, c, nkt, nsplit, WGM;
    __host__ __device__ void init(int M, int N, int K, int G_, int c_, int nsplit_ = 0, int wgm_ = 8) { nM = M / BM; nN = N / BM; nwg = nM * nN; G = G_; c = c_; nkt = K / BK; nsplit = nsplit_; WGM = wgm_; }
    __host__ __device__ bool next(int i, Unit& u) const {
        const bool sfirst = SPLIT_FIRST_ODD && nsplit * nN == G && (c & 1);
        long L = (long)(sfirst ? i - 1 : i) * G + c;
        if (sfirst && i == 0) L = (long)nwg + c;
        else if (sfirst && L >= nwg) return false;
        if (L >= nwg) { const int e = (int)(L - nwg); if (e >= nsplit * nN) return false;
            const int s = e / nN, trips = nkt / 2, qd = trips / nsplit, rm = trips % nsplit;
            u.pm = nM; u.pn = e % nN; u.kt0 = 2 * (s * qd + (s < rm ? s : rm)); u.nkt = 2 * (qd + (s < rm ? 1 : 0)); u.sp = s; return true; }
        int wgid = (int)L; { const int q = nwg / NXCD, r = nwg % NXCD, xcd = wgid % NXCD, off = wgid / NXCD; wgid = (xcd < r ? xcd * (q + 1) : r * (q + 1) + (xcd - r) * q) + off; }
        const int nig = WGM * nN, gid = wgid / nig, fm = gid * WGM, gsz = (nM - fm) < WGM ? (nM - fm) : WGM;
        u.pm = fm + ((wgid % nig) % gsz); u.pn = (wgid % nig) / gsz; u.kt0 = 0; u.nkt = nkt; u.sp = 0; return true;
    }
    __device__ __forceinline__ void a_ready(const Unit&) const {}
    __device__ __forceinline__ void done(const Unit&) const {}
};

__device__ __forceinline__ unsigned cvt_pk_bf16(float lo, float hi) { unsigned r; asm volatile("v_cvt_pk_bf16_f32 %0, %1, %2" : "=v"(r) : "v"(lo), "v"(hi)); return r; }
__device__ __forceinline__ u32x4 pack8(const f32x4& a, const f32x4& b) { u32x4 w; w.x = cvt_pk_bf16(a[0], a[1]); w.y = cvt_pk_bf16(a[2], a[3]); w.z = cvt_pk_bf16(b[0], b[1]); w.w = cvt_pk_bf16(b[2], b[3]); return w; }
__device__ __forceinline__ void unpack8(const u32x4& w, f32x4& a, f32x4& b) {
    a[0] = __uint_as_float(w.x << 16); a[1] = __uint_as_float(w.x & 0xffff0000u); a[2] = __uint_as_float(w.y << 16); a[3] = __uint_as_float(w.y & 0xffff0000u);
    b[0] = __uint_as_float(w.z << 16); b[1] = __uint_as_float(w.z & 0xffff0000u); b[2] = __uint_as_float(w.w << 16); b[3] = __uint_as_float(w.w & 0xffff0000u); }
__device__ __forceinline__ float row_rstd(const float* ssq, int row) { return 1.0f / sqrtf(ssq[row] * (1.0f / DM) + EPS); }
__device__ __forceinline__ float sigmoidf_fast(float x) { return __builtin_amdgcn_rcpf(1.0f + __builtin_amdgcn_exp2f(-1.4426950408889634f * x)); }

__device__ __forceinline__ void touch_line(unsigned& d, const void* p) { asm volatile("global_load_dword %0, %1, off" : "=v"(d) : "v"(p) : "memory"); }
struct EpiSwiglu {
    static constexpr bool PERM = true, AFTER_DRAIN = false;
    __device__ __forceinline__ void init(f32x4 (&acc)[2][2][4][2], const Unit&, int, int, int, int) const {
#pragma unroll
        for (int a = 0; a < 2; ++a)
#pragma unroll
            for (int b = 0; b < 2; ++b)
#pragma unroll
                for (int m = 0; m < 4; ++m)
#pragma unroll
                    for (int n = 0; n < 2; ++n) acc[a][b][m][n] = (f32x4){0.f, 0.f, 0.f, 0.f};
    }
    __device__ __forceinline__ unsigned prefetch(const Unit&, int) const { return 0u; }
    __device__ __forceinline__ unsigned prefetch_next(const Unit&, int) const { return 0u; }
    bf16_t* H; int ldh; const float* ssq;
    __device__ __forceinline__ void operator()(const f32x4 (&acc)[2][2][4][2], const Unit& u, int wr, int wc, int fr, int fq) const {
        const int row0 = u.pm * BM + wr * 64 + fr, col0 = u.pn * HALF + wc * 32 + 8 * fq;
#pragma unroll
        for (int ai = 0; ai < 2; ++ai)
#pragma unroll
            for (int m = 0; m < 4; ++m) {
                const float rs = ssq ? row_rstd(ssq, row0 + ai * HALF + m * 16) : 1.f;
                f32x4 h[2];
#pragma unroll
                for (int n = 0; n < 2; ++n) { const f32x4 g = acc[ai][0][m][n] * rs, up = acc[ai][1][m][n] * rs;
#pragma unroll
                    for (int j = 0; j < 4; ++j) h[n][j] = g[j] * sigmoidf_fast(g[j]) * up[j]; }
                if (probe_mode() & 1) { asm volatile("" :: "v"(h[0]), "v"(h[1])); }
                else if (ldh) *(u32x4*)(H + (size_t)(row0 + ai * HALF + m * 16) * ldh + col0) = pack8(h[0], h[1]);
                else { const int rt = wr * 64 + fr + ai * HALF + m * 16;
                    *(u32x4*)(H + (((size_t)u.pm * (DFF / 64) + 2 * u.pn + (wc >> 1)) * 256 + rt) * 64 + (wc & 1) * 32 + 8 * fq) = pack8(h[0], h[1]); }
            }
    }
};
#ifndef EPI_NT
#define EPI_NT 0
#endif
#if EPI_NT
#define EPI_ST(p, v) __builtin_nontemporal_store((v), (p))
#else
#define EPI_ST(p, v) (*(p) = (v))
#endif
#ifndef RES_PREFETCH
#define RES_PREFETCH 0
#endif
struct EpiResid {
    static constexpr bool PERM = false, AFTER_DRAIN = false;
    __device__ __forceinline__ unsigned prefetch(const Unit&, int) const { return 0u; }
    __device__ __forceinline__ unsigned prefetch_next(const Unit& u, int tid) const {
        unsigned v = 0u;
        if (RES_PREFETCH && u.pm < MR / BM) {
#pragma unroll
            for (int i = 0; i < 4; ++i) { const int ln = tid + 512 * i, r = ln >> 3, c = (ln & 7) * 32; touch_line(v, res + ((size_t)u.pm * BM + r) * DM + u.pn * BM + c); } }
        return v;
    }
    const float* res; float* out; float* slab; bf16_t* xn; float* part; float alpha;
    __device__ __forceinline__ void init(f32x4 (&acc)[2][2][4][2], const Unit& u, int wr, int wc, int fr, int fq) const {
        const float ia = 1.0f / alpha;
        if (u.pm < MR / BM && !(probe_mode() & 2)) {
            const float* rb = res + ((size_t)u.pm * BM + wr * 64 + fr) * DM + u.pn * BM + wc * 32 + 4 * fq;
#pragma unroll
            for (int ai = 0; ai < 2; ++ai)
#pragma unroll
                for (int m = 0; m < 4; ++m)
#pragma unroll
                    for (int bj = 0; bj < 2; ++bj)
#pragma unroll
                        for (int n = 0; n < 2; ++n) acc[ai][bj][m][n] = *(const f32x4*)(rb + (size_t)(ai * HALF + m * 16) * DM + bj * HALF + n * 16) * ia;
        } else {
#pragma unroll
            for (int ai = 0; ai < 2; ++ai)
#pragma unroll
                for (int m = 0; m < 4; ++m)
#pragma unroll
                    for (int bj = 0; bj < 2; ++bj)
#pragma unroll
                        for (int n = 0; n < 2; ++n) acc[ai][bj][m][n] = (f32x4){0.f, 0.f, 0.f, 0.f};
        }
    }
    __device__ __forceinline__ void operator()(const f32x4 (&acc)[2][2][4][2], const Unit& u, int wr, int wc, int fr, int fq) const {
        const int col0 = u.pn * BM + wc * 32 + 4 * fq;
        if (probe_mode() & 1) { _Pragma("unroll") for (int a = 0; a < 2; ++a) _Pragma("unroll") for (int b = 0; b < 2; ++b) _Pragma("unroll") for (int m = 0; m < 4; ++m) _Pragma("unroll") for (int n = 0; n < 2; ++n) asm volatile("" :: "v"(acc[a][b][m][n])); return; }
        if (u.pm >= MR / BM) {
            if (wr == 0) { float* ob = slab + ((size_t)u.sp * NMETA + fr) * DM + col0;
#pragma unroll
                for (int bj = 0; bj < 2; ++bj)
#pragma unroll
                    for (int n = 0; n < 2; ++n) *(f32x4*)(ob + bj * HALF + n * 16) = alpha * acc[0][bj][0][n]; }
            return; }
        float* ob = out + (size_t)u.pm * BM * DM;
#pragma unroll
        for (int ai = 0; ai < 2; ++ai)
#pragma unroll
            for (int m = 0; m < 4; ++m) { const int rowt = ai * HALF + wr * 64 + m * 16 + fr; const size_t off = (size_t)rowt * DM + col0; float q = 0.f;
#pragma unroll
                for (int bj = 0; bj < 2; ++bj)
#pragma unroll
                    for (int n = 0; n < 2; ++n) { const f32x4 v = alpha * acc[ai][bj][m][n]; EPI_ST((f32x4*)(ob + off + bj * HALF + n * 16), v);
                        q += (v[0] * v[0] + v[1] * v[1]) + (v[2] * v[2] + v[3] * v[3]);
                        if (xn) { typedef unsigned u32x2 __attribute__((ext_vector_type(2))); u32x2 w; w.x = cvt_pk_bf16(v[0], v[1]); w.y = cvt_pk_bf16(v[2], v[3]); EPI_ST((u32x2*)(xn + (size_t)u.pm * BM * DM + off + bj * HALF + n * 16), w); } }
                if (part) { q += __shfl_xor(q, 16); q += __shfl_xor(q, 32); if (fq == 0) part[(size_t)(u.pm * BM + rowt) * 64 + u.pn * 4 + wc] = q; }
                if (m & 1) asm volatile("" ::: "memory"); }
    }
};
enum { MB_PLAIN = 0, MB_WIN = 1, MB_QUP = 2, MB_GATE = 3, MB_BR1 = 4, MB_BR2 = 5 };
__device__ __forceinline__ void rope8(f32x4& v0, f32x4& v1, const float* cs) {
    const f32x4 c01 = *(const f32x4*)cs, c23 = *(const f32x4*)(cs + 4);
    const f32x4 a = v0, b = v1;
    v0[0] = a[0] * c01[0] - a[1] * c01[1]; v0[1] = a[0] * c01[1] + a[1] * c01[0]; v0[2] = a[2] * c01[2] - a[3] * c01[3]; v0[3] = a[2] * c01[3] + a[3] * c01[2];
    v1[0] = b[0] * c23[0] - b[1] * c23[1]; v1[1] = b[0] * c23[1] + b[1] * c23[0]; v1[2] = b[2] * c23[2] - b[3] * c23[3]; v1[3] = b[2] * c23[3] + b[3] * c23[2];
}
template <int MODE> struct EpiB {
    static constexpr bool PERM = true, AFTER_DRAIN = false;
    __device__ __forceinline__ void init(f32x4 (&acc)[2][2][4][2], const Unit&, int, int, int, int) const {
#pragma unroll
        for (int a = 0; a < 2; ++a)
#pragma unroll
            for (int b = 0; b < 2; ++b)
#pragma unroll
                for (int m = 0; m < 4; ++m)
#pragma unroll
                    for (int n = 0; n < 2; ++n) acc[a][b][m][n] = (f32x4){0.f, 0.f, 0.f, 0.f};
    }
    __device__ __forceinline__ unsigned prefetch_next(const Unit&, int) const { return 0u; }
    __device__ __forceinline__ unsigned prefetch(const Unit& u, int tid) const {
        unsigned v = 0u;
        if (MODE == MB_BR1 || MODE == MB_BR2) {
#pragma unroll
            for (int i = 0; i < 2; ++i) { const int ln = tid + 512 * i, r = ln >> 2, c = (ln & 3) * 64; const size_t row = (size_t)u.pm * BM + r; const int col = u.pn * BM + c;
                touch_line(v, G + row * (2 * DM) + (MODE == MB_BR2 ? DM : 0) + col);
                if (MODE == MB_BR2) touch_line(v, T1 + row * DM + col); } }
        return v;
    }
    bf16_t* O; int ldc; const float* bias; const bf16_t* G; const bf16_t* T1; const float* rope; const float* ssq;
    __device__ __forceinline__ void operator()(const f32x4 (&acc)[2][2][4][2], const Unit& u, int wr, int wc, int fr, int fq) const {
        const int row0 = u.pm * BM + wr * 64 + fr, colt = u.pn * BM + wc * 32 + 8 * fq;
#pragma unroll
        for (int ai = 0; ai < 2; ++ai)
#pragma unroll
            for (int m = 0; m < 4; ++m) { const int row = row0 + ai * HALF + m * 16;
                const int pos = row < MR ? NMETA + (row & (SEQ - 1)) : (row - MR);
                const float rs = ssq ? row_rstd(ssq, row) : 1.f;
#pragma unroll
                for (int bj = 0; bj < 2; ++bj) { const int col0 = colt + bj * HALF; f32x4 v0 = acc[ai][bj][m][0] * rs, v1 = acc[ai][bj][m][1] * rs;
                    if (MODE == MB_WIN) { if (col0 < PC_DK) { v0 = v0 * QSCALE_DIFF; v1 = v1 * QSCALE_DIFF; }
                        if (col0 >= PC_KR && col0 < INW) rope8(v0, v1, rope + ((size_t)pos * 32 + ((col0 - PC_KR) >> 1)) * 2); }
                    if (MODE == MB_QUP) { if (QUP_PRESCALE) { v0 = v0 * QSCALE_MLA; v1 = v1 * QSCALE_MLA; }
                        const int d0 = col0 % 192; if (d0 >= 128) rope8(v0, v1, rope + ((size_t)pos * 32 + ((d0 - 128) >> 1)) * 2); }
                    if (MODE == MB_GATE) { const f32x4 b0 = *(const f32x4*)(bias + col0), b1 = *(const f32x4*)(bias + col0 + 4);
#pragma unroll
                        for (int j = 0; j < 4; ++j) { v0[j] = sigmoidf_fast(v0[j] + b0[j]); v1[j] = sigmoidf_fast(v1[j] + b1[j]); } }
                    if (MODE == MB_BR1) { f32x4 g0, g1; unpack8(*(const u32x4*)(G + (size_t)row * (2 * DM) + col0), g0, g1); v0 = v0 * g0; v1 = v1 * g1; }
                    if (MODE == MB_BR2) { f32x4 g0, g1, t0, t1; unpack8(*(const u32x4*)(G + (size_t)row * (2 * DM) + DM + col0), g0, g1); unpack8(*(const u32x4*)(T1 + (size_t)row * DM + col0), t0, t1);
                        v0 = t0 + v0 * g0; v1 = t1 + v1 * g1; }
                    if (probe_mode() & 1) asm volatile("" :: "v"(v0), "v"(v1)); else *(u32x4*)(O + (size_t)row * ldc + col0) = pack8(v0, v1); } }
    }
};

template <class Epi, class Sched, bool ALIGN_EPI = false, bool SP2 = false>
__device__ __forceinline__ void gemm_phase(PG8_LAS unsigned char* lds, const Gemm g, const Sched& S, const Epi& E) {
    const int tid = threadIdx.x, wid = __builtin_amdgcn_readfirstlane(tid >> 6), lane = tid & 63, wr = wid >> 2, wc = wid & 3, fr = lane & 15, fq = lane >> 4;

    unsigned voffA[2], voffB[2];
#pragma unroll
    for (int i = 0; i < 2; ++i) { int R, C; stage_rc(tid * 16 + i * 8192, R, C); const int Rb = Epi::PERM ? ((R & ~31) + perm32(R & 31)) : R;
        voffA[i] = (unsigned)(R * g.lda + C) * 2u; voffB[i] = (unsigned)(Rb * g.ldb + C) * 2u; }
    const size_t kstep = g.blk ? (size_t)(BM * BK * 2) : (size_t)(BK * 2);
    const size_t hstepA = (size_t)HALF * g.lda * 2, hstepB = (size_t)HALF * g.ldb * 2;
    const size_t tstepA = g.blk ? (size_t)(g.K / BK) * (BM * BK * 2) : 2 * hstepA, tstepB = g.blk ? (size_t)(g.K / BK) * (BM * BK * 2) : 2 * hstepB;
    const unsigned ldsw = (unsigned)wid * 1024u;
    const int aoff = lds_byte(wr * 64 + fr, fq * 8), boff = lds_byte(wc * 32 + fr, fq * 8);
#define PG8_SA(b, h) (((b) * 2 + (h)) * HTB)
#define PG8_SB(b, h) ((4 + (b) * 2 + (h)) * HTB)
#ifndef PG8_PF_TRIPS
#define PG8_PF_TRIPS 2
#endif
#ifndef PG8_B_AUX
#define PG8_B_AUX 0
#endif
#define PG8_STAGE(bufoff, gbase, voff) do { _Pragma("unroll") for (int _i = 0; _i < 2; ++_i) { \
        if ((bufoff) >= 4 * HTB) __builtin_amdgcn_global_load_lds((const unsigned*)((const char*)(gbase) + (voff)[_i]), (PG8_LAS unsigned*)(lds + (bufoff) + ldsw + _i * 8192), 16, 0, PG8_B_AUX);     \
        else __builtin_amdgcn_global_load_lds((const unsigned*)((const char*)(gbase) + (voff)[_i]), (PG8_LAS unsigned*)(lds + (bufoff) + ldsw + _i * 8192), 16, 0, 0); } } while (0)
#define PG8_LDA(dst, b, h) do { _Pragma("unroll") for (int m = 0; m < 4; ++m) _Pragma("unroll") for (int k = 0; k < 2; ++k) dst[m][k] = *(const PG8_LAS bf16x8*)(lds + PG8_SA(b, h) + aoff + m * 2048 + k * 1024); } while (0)
#define PG8_LDB(dst, b, h) do { _Pragma("unroll") for (int n = 0; n < 2; ++n) _Pragma("unroll") for (int k = 0; k < 2; ++k) dst[n][k] = *(const PG8_LAS bf16x8*)(lds + PG8_SB(b, h) + boff + n * 2048 + k * 1024); } while (0)
#define PG8_MMA(ai, bj, At, Bt) do { __builtin_amdgcn_s_setprio(1); _Pragma("unroll") for (int m = 0; m < 4; ++m) _Pragma("unroll") for (int n = 0; n < 2; ++n) _Pragma("unroll") for (int k = 0; k < 2; ++k) \
        acc[ai][bj][m][n] = __builtin_amdgcn_mfma_f32_16x16x32_bf16(Bt[n][k], At[m][k], acc[ai][bj][m][n], 0, 0, 0); __builtin_amdgcn_s_setprio(0); } while (0)
#define PG8_WAIT_V(n) asm volatile("s_waitcnt vmcnt(" #n ")" ::: "memory")
#define PG8_WAIT_L(n) asm volatile("s_waitcnt lgkmcnt(" #n ")" ::: "memory")
#define PG8_BAR __builtin_amdgcn_s_barrier()
#define PG8_SCHED __builtin_amdgcn_sched_barrier(0)
    Unit cur, nxt; int ui = 0;
    if (!S.next(0, cur)) return;
    f32x4 acc[2][2][4][2];
    E.init(acc, cur, wr, wc, fr, fq);
    bf16x8 At[4][2], B0[2][2], B1[2][2];
    const char* cA = (const char*)g.A + (size_t)cur.pm * tstepA + (size_t)cur.kt0 * kstep; const char* cB = (const char*)g.Bt + (size_t)cur.pn * tstepB + (size_t)cur.kt0 * kstep;
    S.a_ready(cur);
    if constexpr (SP2) {
        PG8_STAGE(PG8_SB(0, 0), cB, voffB); PG8_STAGE(PG8_SB(0, 1), cB + hstepB, voffB); PG8_STAGE(PG8_SA(0, 0), cA, voffA); PG8_STAGE(PG8_SA(0, 1), cA + hstepA, voffA);
        if (wr == 1) PG8_BAR;
        PG8_WAIT_V(2); PG8_BAR;
        PG8_STAGE(PG8_SB(1, 0), cB + kstep, voffB); PG8_STAGE(PG8_SA(1, 0), cA + kstep, voffA); PG8_STAGE(PG8_SB(1, 1), cB + hstepB + kstep, voffB);
        PG8_WAIT_V(6); PG8_BAR;
    } else {
        PG8_STAGE(PG8_SB(0, 0), cB, voffB); PG8_STAGE(PG8_SA(0, 0), cA, voffA); PG8_STAGE(PG8_SB(0, 1), cB + hstepB, voffB); PG8_STAGE(PG8_SA(0, 1), cA + hstepA, voffA);
        if (wr == 1) PG8_BAR;
        PG8_WAIT_V(4); PG8_BAR;
        PG8_STAGE(PG8_SB(1, 0), cB + kstep, voffB); PG8_STAGE(PG8_SA(1, 0), cA + kstep, voffA); PG8_STAGE(PG8_SB(1, 1), cB + hstepB + kstep, voffB);
        PG8_WAIT_V(6); PG8_BAR;
    }
    for (;;) {
        const bool has_next = S.next(ui + 1, nxt);
        const char* nA = has_next ? (const char*)g.A + (size_t)nxt.pm * tstepA + (size_t)nxt.kt0 * kstep : cA; const char* nB = has_next ? (const char*)g.Bt + (size_t)nxt.pn * tstepB + (size_t)nxt.kt0 * kstep : cB;
        const int nt = cur.nkt;
        const int pf_trip = nt - 2 * PG8_PF_TRIPS >= 0 ? nt - 2 * PG8_PF_TRIPS : 0; unsigned pfv = 0u, pfv2 = 0u;
        for (int t = 0; t < nt; t += 2) {
            const bool last = (t == nt - 2);
            const char* a1 = cA + (size_t)(t + 1) * kstep;
            const char* a2 = last ? nA : cA + (size_t)(t + 2) * kstep; const char* b2 = last ? nB : cB + (size_t)(t + 2) * kstep;
            const char* a3 = a2 + kstep; const char* b3 = b2 + kstep;
            if (last && has_next) S.a_ready(nxt);
            if (t == pf_trip) { pfv = E.prefetch(cur, tid); if (has_next) pfv2 = E.prefetch_next(nxt, tid); }
            if constexpr (SP2) {
            PG8_LDB(B0, 0, 0); PG8_LDB(B1, 0, 1); PG8_SCHED; PG8_LDA(At, 0, 0); PG8_STAGE(PG8_SA(1, 1), a1 + hstepA, voffA);
            PG8_WAIT_V(8); PG8_WAIT_L(0); PG8_BAR; PG8_MMA(0, 0, At, B0); PG8_MMA(0, 1, At, B1); PG8_BAR; PG8_SCHED;
            PG8_LDA(At, 0, 1); PG8_STAGE(PG8_SB(0, 0), b2, voffB); PG8_STAGE(PG8_SB(0, 1), b2 + hstepB, voffB); PG8_STAGE(PG8_SA(0, 0), a2, voffA);
            PG8_WAIT_V(8); PG8_WAIT_L(0); PG8_BAR; PG8_MMA(1, 0, At, B0); PG8_MMA(1, 1, At, B1); PG8_BAR; PG8_SCHED;
            PG8_LDB(B0, 1, 0); PG8_LDB(B1, 1, 1); PG8_SCHED; PG8_LDA(At, 1, 0); PG8_STAGE(PG8_SA(0, 1), a2 + hstepA, voffA);
            PG8_WAIT_V(8); PG8_WAIT_L(0); PG8_BAR; PG8_MMA(0, 0, At, B0); PG8_MMA(0, 1, At, B1); PG8_BAR; PG8_SCHED;
            PG8_LDA(At, 1, 1); PG8_STAGE(PG8_SB(1, 0), b3, voffB); PG8_STAGE(PG8_SB(1, 1), b3 + hstepB, voffB); PG8_STAGE(PG8_SA(1, 0), a3, voffA);
            PG8_WAIT_V(8); PG8_WAIT_L(0); PG8_BAR; PG8_MMA(1, 0, At, B0); PG8_MMA(1, 1, At, B1); PG8_BAR; PG8_SCHED;
            } else {
            PG8_LDB(B0, 0, 0); PG8_SCHED; PG8_LDA(At, 0, 0); PG8_STAGE(PG8_SA(1, 1), a1 + hstepA, voffA);
            PG8_WAIT_L(8); PG8_BAR; PG8_WAIT_L(0); PG8_MMA(0, 0, At, B0); PG8_BAR; PG8_SCHED;
            PG8_LDB(B1, 0, 1); PG8_STAGE(PG8_SB(0, 0), b2, voffB);
            PG8_BAR; PG8_WAIT_L(0); PG8_MMA(0, 1, At, B1); PG8_BAR;
            PG8_LDA(At, 0, 1); PG8_STAGE(PG8_SA(0, 0), a2, voffA);
            PG8_BAR; PG8_WAIT_L(0); PG8_MMA(1, 0, At, B0); PG8_BAR; PG8_SCHED;
            PG8_STAGE(PG8_SB(0, 1), b2 + hstepB, voffB);
            PG8_WAIT_V(6); PG8_BAR; PG8_MMA(1, 1, At, B1); PG8_BAR;
            PG8_LDB(B0, 1, 0); PG8_SCHED; PG8_LDA(At, 1, 0); PG8_STAGE(PG8_SA(0, 1), a2 + hstepA, voffA);
            PG8_WAIT_L(8); PG8_BAR; PG8_WAIT_L(0); PG8_MMA(0, 0, At, B0); PG8_BAR; PG8_SCHED;
            PG8_LDB(B1, 1, 1); PG8_STAGE(PG8_SB(1, 0), b3, voffB);
            PG8_BAR; PG8_WAIT_L(0); PG8_MMA(0, 1, At, B1); PG8_BAR;
            PG8_LDA(At, 1, 1); PG8_STAGE(PG8_SA(1, 0), a3, voffA);
            PG8_BAR; PG8_WAIT_L(0); PG8_MMA(1, 0, At, B0); PG8_BAR; PG8_SCHED;
            PG8_STAGE(PG8_SB(1, 1), b3 + hstepB, voffB);
            PG8_WAIT_V(6); PG8_BAR; PG8_MMA(1, 1, At, B1); PG8_BAR;
            }
        }
        asm volatile("" :: "v"(pfv), "v"(pfv2));
        if constexpr (ALIGN_EPI) { if (wr == 0) PG8_BAR; }
        if constexpr (!Epi::AFTER_DRAIN) { E(acc, cur, wr, wc, fr, fq); S.done(cur); }
        if (!has_next) break;
        cur = nxt; cA = nA; cB = nB; ++ui;
        E.init(acc, cur, wr, wc, fr, fq);
        if constexpr (ALIGN_EPI) { if (wr == 1) PG8_BAR; }
    }
    PG8_WAIT_V(0);
    if constexpr (!ALIGN_EPI) { if (wr == 0) PG8_BAR; }
    PG8_BAR;
    if constexpr (Epi::AFTER_DRAIN) { E.fused(acc, cur, wr, wc, fr, fq, lds, wid, lane); S.done(cur); }
#undef PG8_SA
#undef PG8_SB
#undef PG8_STAGE
#undef PG8_LDA
#undef PG8_LDB
#undef PG8_MMA
#undef PG8_WAIT_V
#undef PG8_WAIT_L
#undef PG8_BAR
#undef PG8_SCHED
}
}

namespace att {
typedef unsigned short bf16;
using bf16x8 = __attribute__((ext_vector_type(8))) short;
using s16x4  = __attribute__((ext_vector_type(4))) short;
using f32x16 = __attribute__((ext_vector_type(16))) float;
using u32x4  = __attribute__((ext_vector_type(4))) unsigned;
constexpr int NW = 8, QBLK = 32, KVBLK = 64, NT = SEQ / KVBLK + 1;
constexpr float THR = 8.f;
constexpr int SHM_V = KVBLK * 128 * 2;
template <int DQK> constexpr int shm_k() { return KVBLK * DQK * 2; }
template <int DQK> constexpr int nqreg() { return DQK == 192 ? 6 : 8; }
template <int DQK> constexpr int shm_total() { return 2 * SHM_V + 2 * shm_k<DQK>() + NW * 64 * 4 + NW * 1024 * (DQK / 16 - nqreg<DQK>()); }
#define ATT_SBAR() __builtin_amdgcn_sched_barrier(0)
__device__ __forceinline__ int crow(int r, int hi) { return (r & 3) + 8 * (r >> 2) + 4 * hi; }
__device__ __forceinline__ unsigned cvtpk(float lo, float hi) { unsigned r; asm volatile("v_cvt_pk_bf16_f32 %0, %1, %2" : "=v"(r) : "v"(lo), "v"(hi)); return r; }
template <int DQK> __device__ __forceinline__ int kswz(int row, int colB) {
    if constexpr (DQK == 128) return row * 256 + (colB ^ ((row & 15) << 4));
    else return row * 384 + (colB ^ (((row >> 1) & 7) << 4));
}
template <int DQK> __device__ __forceinline__ void partialSM(f32x16& p0, f32x16& p1, float& m_reg, float& mn, float& alpha) {
    constexpr float SCALE = DQK == 128 ? 0.08838834764831845f : 0.07216878364870322f;
    constexpr float C = SCALE * 1.4426950408889634f;
    float pmax = p0[0];
#pragma unroll
    for (int r = 1; r < 16; ++r) pmax = fmaxf(pmax, p0[r]);
#pragma unroll
    for (int r = 0; r < 16; ++r) pmax = fmaxf(pmax, p1[r]);
    { auto rr = __builtin_amdgcn_permlane32_swap(__float_as_uint(pmax), __float_as_uint(pmax), false, false);
      pmax = fmaxf(__uint_as_float(rr[0]), __uint_as_float(rr[1])); }
    if (__builtin_expect(__all(pmax - m_reg <= THR / SCALE), 1)) { mn = m_reg; alpha = 1.f; }
    else { mn = fmaxf(m_reg, pmax); alpha = __builtin_amdgcn_exp2f((m_reg - mn) * C); m_reg = mn; }
    const float mnC = -mn * C;
#pragma unroll
    for (int r = 0; r < 16; ++r) p0[r] = fmaf(p0[r], C, mnC);
#pragma unroll
    for (int r = 0; r < 16; ++r) p1[r] = fmaf(p1[r], C, mnC);
#pragma unroll
    for (int r = 0; r < 16; ++r) p0[r] = __builtin_amdgcn_exp2f(p0[r]);
}
__device__ __forceinline__ void finishSM(f32x16& p0, f32x16& p1, float alpha, float& l_reg, bf16x8& pa0, bf16x8& pa1, bf16x8& pa2, bf16x8& pa3) {
#pragma unroll
    for (int r = 0; r < 16; ++r) p1[r] = __builtin_amdgcn_exp2f(p1[r]);
    float ps = 0;
#pragma unroll
    for (int r = 0; r < 16; ++r) ps += p0[r];
#pragma unroll
    for (int r = 0; r < 16; ++r) ps += p1[r];
    { auto rr = __builtin_amdgcn_permlane32_swap(__float_as_uint(ps), __float_as_uint(ps), false, false);
      ps = __uint_as_float(rr[0]) + __uint_as_float(rr[1]); }
    l_reg = l_reg * alpha + ps;
#define ATT_PK4(P, BASE, OUT) do { unsigned a0 = cvtpk(P[BASE + 0], P[BASE + 1]), a1 = cvtpk(P[BASE + 2], P[BASE + 3]);   \
    unsigned b0 = cvtpk(P[BASE + 4], P[BASE + 5]), b1 = cvtpk(P[BASE + 6], P[BASE + 7]);                              \
    auto r0 = __builtin_amdgcn_permlane32_swap(a0, b0, false, false); auto r1 = __builtin_amdgcn_permlane32_swap(a1, b1, false, false); \
    u32x4 w = {r0[0], r1[0], r0[1], r1[1]}; OUT = *reinterpret_cast<bf16x8*>(&w); } while (0)
    ATT_PK4(p0, 0, pa0); ATT_PK4(p0, 8, pa1); ATT_PK4(p1, 0, pa2); ATT_PK4(p1, 8, pa3);
#undef ATT_PK4
}
template <int DQK> __device__ __forceinline__ void qkt(f32x16& p0, f32x16& p1, const char* Ks, const bf16x8* qr, const char* qp, int r32, int hi) {
#pragma unroll
    for (int d0 = 0; d0 < DQK / 16; ++d0) { const int cb = (d0 * 16 + hi * 8) * 2;
        const bf16x8 b0 = *reinterpret_cast<const bf16x8*>(Ks + kswz<DQK>(r32, cb));
        const bf16x8 b1 = *reinterpret_cast<const bf16x8*>(Ks + kswz<DQK>(32 + r32, cb));
        bf16x8 qv; if (d0 < nqreg<DQK>()) qv = qr[d0]; else qv = *reinterpret_cast<const bf16x8*>(qp + (d0 - nqreg<DQK>()) * 1024);
        p0 = __builtin_amdgcn_mfma_f32_32x32x16_bf16(b0, qv, p0, 0, 0, 0);
        p1 = __builtin_amdgcn_mfma_f32_32x32x16_bf16(b1, qv, p1, 0, 0, 0); }
}
__device__ __forceinline__ bf16x8 lds_rd128(int addr) { bf16x8 r; asm volatile("ds_read_b128 %0, %1" : "=&v"(r) : "v"(addr) : "memory"); return r; }
template <int NQ, int D0> __device__ __forceinline__ void qk_rd(int kb, int qpb, int r32, int hi, bf16x8& b0, bf16x8& b1, bf16x8& qv, const bf16x8* qr) {
    constexpr int cb0 = D0 * 32; const int cb = cb0 + hi * 16;
    b0 = lds_rd128(kb + kswz<128>(r32, cb)); b1 = lds_rd128(kb + kswz<128>(32 + r32, cb));
    if (D0 < NQ) qv = qr[D0 < NQ ? D0 : 0]; else qv = lds_rd128(qpb + (D0 - NQ) * 1024);
}
template <int NQ> __device__ __forceinline__ void qkt_pipe(f32x16& p0, f32x16& p1, const char* Ks, const bf16x8* qr, const char* qp, int r32_, int hi) {
    int r32 = r32_; asm volatile("" : "+v"(r32));
    const int kb = (int)(uintptr_t)Ks, qpb = (int)(uintptr_t)qp;
    bf16x8 a0, a1, aq, c0, c1, cq;
    qk_rd<NQ, 0>(kb, qpb, r32, hi, a0, a1, aq, qr);
#define ATT_QKSTEP(D, N0, N1, NQV, C0, C1, CQV) do { qk_rd<NQ, (D) + 1>(kb, qpb, r32, hi, N0, N1, NQV, qr); \
        if ((D) + 1 < NQ) asm volatile("s_waitcnt lgkmcnt(2)" ::: "memory"); else asm volatile("s_waitcnt lgkmcnt(3)" ::: "memory"); ATT_SBAR(); \
        p0 = __builtin_amdgcn_mfma_f32_32x32x16_bf16(C0, CQV, p0, 0, 0, 0); p1 = __builtin_amdgcn_mfma_f32_32x32x16_bf16(C1, CQV, p1, 0, 0, 0); ATT_SBAR(); } while (0)
    ATT_QKSTEP(0, c0, c1, cq, a0, a1, aq); ATT_QKSTEP(1, a0, a1, aq, c0, c1, cq); ATT_QKSTEP(2, c0, c1, cq, a0, a1, aq); ATT_QKSTEP(3, a0, a1, aq, c0, c1, cq);
    ATT_QKSTEP(4, c0, c1, cq, a0, a1, aq); ATT_QKSTEP(5, a0, a1, aq, c0, c1, cq); ATT_QKSTEP(6, c0, c1, cq, a0, a1, aq);
    asm volatile("s_waitcnt lgkmcnt(0)" ::: "memory"); ATT_SBAR();
    p0 = __builtin_amdgcn_mfma_f32_32x32x16_bf16(c0, cq, p0, 0, 0, 0); p1 = __builtin_amdgcn_mfma_f32_32x32x16_bf16(c1, cq, p1, 0, 0, 0);
#undef ATT_QKSTEP
}
#ifndef QKT_GRP
#define QKT_GRP 2
#endif
template <int NQ> __device__ __forceinline__ void qkt_b(f32x16& p0, f32x16& p1, const char* Ks, const bf16x8* qr, const char* qp, int r32_, int hi) {
    int r32 = r32_; asm volatile("" : "+v"(r32));
#pragma unroll
    for (int d0 = 0; d0 < 8; ++d0) { const int cb = (d0 * 16 + hi * 8) * 2;
        const bf16x8 b0 = *reinterpret_cast<const bf16x8*>(Ks + kswz<128>(r32, cb));
        const bf16x8 b1 = *reinterpret_cast<const bf16x8*>(Ks + kswz<128>(32 + r32, cb));
        bf16x8 qv; if (d0 < NQ) qv = qr[d0 < NQ ? d0 : 0]; else qv = *reinterpret_cast<const bf16x8*>(qp + (d0 - NQ) * 1024);
        p0 = __builtin_amdgcn_mfma_f32_32x32x16_bf16(b0, qv, p0, 0, 0, 0);
        p1 = __builtin_amdgcn_mfma_f32_32x32x16_bf16(b1, qv, p1, 0, 0, 0);
        if ((d0 % QKT_GRP) == QKT_GRP - 1) ATT_SBAR(); }
}
__device__ __forceinline__ int v_st(int k, int c) { const int kk = (k & ~0xC) | ((k & 4) << 1) | ((k & 8) >> 1); return ((kk >> 3) * 4 + (c >> 5)) * 512 + ((kk & 7) * 32 + (c & 31)) * 2; }
__device__ __forceinline__ int v_rd_base(int lane) { return ((lane & 3) << 3) | (((lane >> 2) & 3) << 6) | (((lane >> 4) & 1) << 5) | (((lane >> 5) & 1) << 8); }
constexpr int v_rd_off(int d0, int ks, int half) { return d0 * 512 + ks * 4096 + half * 2048; }
template <int OFF> __device__ __forceinline__ s16x4 tr_read(int vb) { s16x4 r; asm volatile("ds_read_b64_tr_b16 %0, %1 offset:%2" : "=&v"(r) : "v"(vb), "i"(OFF) : "memory"); return r; }
template <int D0> __device__ __forceinline__ void pv_one(f32x16& od, int vb, bf16x8 pa0, bf16x8 pa1, bf16x8 pa2, bf16x8 pa3) {
    const s16x4 l0 = tr_read<v_rd_off(D0, 0, 0)>(vb), h0 = tr_read<v_rd_off(D0, 0, 1)>(vb), l1 = tr_read<v_rd_off(D0, 1, 0)>(vb), h1 = tr_read<v_rd_off(D0, 1, 1)>(vb);
    const s16x4 l2 = tr_read<v_rd_off(D0, 2, 0)>(vb), h2 = tr_read<v_rd_off(D0, 2, 1)>(vb), l3 = tr_read<v_rd_off(D0, 3, 0)>(vb), h3 = tr_read<v_rd_off(D0, 3, 1)>(vb);
    asm volatile("s_waitcnt lgkmcnt(0)" ::: "memory"); ATT_SBAR();
#define ATT_PK(L, H) (bf16x8){L[0], L[1], L[2], L[3], H[0], H[1], H[2], H[3]}
    od = __builtin_amdgcn_mfma_f32_32x32x16_bf16(pa0, ATT_PK(l0, h0), od, 0, 0, 0);
    od = __builtin_amdgcn_mfma_f32_32x32x16_bf16(pa1, ATT_PK(l1, h1), od, 0, 0, 0);
    od = __builtin_amdgcn_mfma_f32_32x32x16_bf16(pa2, ATT_PK(l2, h2), od, 0, 0, 0);
    od = __builtin_amdgcn_mfma_f32_32x32x16_bf16(pa3, ATT_PK(l3, h3), od, 0, 0, 0);
#undef ATT_PK
}
template <int D0> __device__ __forceinline__ void pv_one_h(f32x16& od, int vb, bf16x8 pa0, bf16x8 pa1, bf16x8 pa2, bf16x8 pa3) {
#define ATT_PK(L, H) (bf16x8){L[0], L[1], L[2], L[3], H[0], H[1], H[2], H[3]}
    { const s16x4 l0 = tr_read<v_rd_off(D0, 0, 0)>(vb), h0 = tr_read<v_rd_off(D0, 0, 1)>(vb), l1 = tr_read<v_rd_off(D0, 1, 0)>(vb), h1 = tr_read<v_rd_off(D0, 1, 1)>(vb);
      asm volatile("s_waitcnt lgkmcnt(0)" ::: "memory"); ATT_SBAR();
      od = __builtin_amdgcn_mfma_f32_32x32x16_bf16(pa0, ATT_PK(l0, h0), od, 0, 0, 0); od = __builtin_amdgcn_mfma_f32_32x32x16_bf16(pa1, ATT_PK(l1, h1), od, 0, 0, 0); }
    ATT_SBAR();
    { const s16x4 l2 = tr_read<v_rd_off(D0, 2, 0)>(vb), h2 = tr_read<v_rd_off(D0, 2, 1)>(vb), l3 = tr_read<v_rd_off(D0, 3, 0)>(vb), h3 = tr_read<v_rd_off(D0, 3, 1)>(vb);
      asm volatile("s_waitcnt lgkmcnt(0)" ::: "memory"); ATT_SBAR();
      od = __builtin_amdgcn_mfma_f32_32x32x16_bf16(pa2, ATT_PK(l2, h2), od, 0, 0, 0); od = __builtin_amdgcn_mfma_f32_32x32x16_bf16(pa3, ATT_PK(l3, h3), od, 0, 0, 0); }
#undef ATT_PK
}
__device__ __forceinline__ void pv_d0_h(f32x16* o, int vb, bf16x8 pa0, bf16x8 pa1, bf16x8 pa2, bf16x8 pa3) {
    pv_one_h<0>(o[0], vb, pa0, pa1, pa2, pa3); pv_one_h<1>(o[1], vb, pa0, pa1, pa2, pa3); pv_one_h<2>(o[2], vb, pa0, pa1, pa2, pa3); pv_one_h<3>(o[3], vb, pa0, pa1, pa2, pa3);
}
template <int H> __device__ __forceinline__ void pv_rd(int vb, s16x4& la, s16x4& ha, s16x4& lb, s16x4& hb) {
    constexpr int D0 = H >> 1, KS = 2 * (H & 1);
    la = tr_read<v_rd_off(D0, KS, 0)>(vb); ha = tr_read<v_rd_off(D0, KS, 1)>(vb); lb = tr_read<v_rd_off(D0, KS + 1, 0)>(vb); hb = tr_read<v_rd_off(D0, KS + 1, 1)>(vb);
}
#define ATT_PK2(L, Hh) (bf16x8){L[0], L[1], L[2], L[3], Hh[0], Hh[1], Hh[2], Hh[3]}
template <int H> __device__ __forceinline__ void pv_mm(f32x16* o, const s16x4& la, const s16x4& ha, const s16x4& lb, const s16x4& hb, bf16x8 pa0, bf16x8 pa1, bf16x8 pa2, bf16x8 pa3) {
    constexpr int D0 = H >> 1;
    o[D0] = __builtin_amdgcn_mfma_f32_32x32x16_bf16((H & 1) ? pa2 : pa0, ATT_PK2(la, ha), o[D0], 0, 0, 0);
    o[D0] = __builtin_amdgcn_mfma_f32_32x32x16_bf16((H & 1) ? pa3 : pa1, ATT_PK2(lb, hb), o[D0], 0, 0, 0);
}
__device__ __forceinline__ void pv_pipe(f32x16* o, int vb, bf16x8 pa0, bf16x8 pa1, bf16x8 pa2, bf16x8 pa3) {
    s16x4 a0, a1, a2, a3, b0, b1, b2, b3;
    pv_rd<0>(vb, a0, a1, a2, a3);
#define ATT_PVSTEP(H, RN0, RN1, RN2, RN3, RC0, RC1, RC2, RC3) do { pv_rd<(H) + 1>(vb, RN0, RN1, RN2, RN3); asm volatile("s_waitcnt lgkmcnt(4)" ::: "memory"); ATT_SBAR(); \
        pv_mm<(H)>(o, RC0, RC1, RC2, RC3, pa0, pa1, pa2, pa3); ATT_SBAR(); } while (0)
    ATT_PVSTEP(0, b0, b1, b2, b3, a0, a1, a2, a3); ATT_PVSTEP(1, a0, a1, a2, a3, b0, b1, b2, b3); ATT_PVSTEP(2, b0, b1, b2, b3, a0, a1, a2, a3); ATT_PVSTEP(3, a0, a1, a2, a3, b0, b1, b2, b3);
    ATT_PVSTEP(4, b0, b1, b2, b3, a0, a1, a2, a3); ATT_PVSTEP(5, a0, a1, a2, a3, b0, b1, b2, b3); ATT_PVSTEP(6, b0, b1, b2, b3, a0, a1, a2, a3);
    asm volatile("s_waitcnt lgkmcnt(0)" ::: "memory"); ATT_SBAR(); pv_mm<7>(o, b0, b1, b2, b3, pa0, pa1, pa2, pa3);
#undef ATT_PVSTEP
}
#undef ATT_PK2
__device__ __forceinline__ void pv_d0(f32x16* o, int vb, bf16x8 pa0, bf16x8 pa1, bf16x8 pa2, bf16x8 pa3) {
    pv_one<0>(o[0], vb, pa0, pa1, pa2, pa3); pv_one<1>(o[1], vb, pa0, pa1, pa2, pa3); pv_one<2>(o[2], vb, pa0, pa1, pa2, pa3); pv_one<3>(o[3], vb, pa0, pa1, pa2, pa3);
}
template <bool ALIBI> __device__ __forceinline__ void init_real(f32x16& p0, f32x16& p1, float dq, float nslope) {
    if constexpr (ALIBI) {
#pragma unroll
        for (int r = 0; r < 16; ++r) { const float cr = (float)((r & 3) + 8 * (r >> 2)); p0[r] = nslope * fabsf(dq - cr); p1[r] = nslope * fabsf(dq - (cr + 32.f)); }
    } else { p0 = f32x16{}; p1 = f32x16{}; }
}
__device__ __forceinline__ void init_meta(f32x16& p0, f32x16& p1) {
#pragma unroll
    for (int r = 0; r < 16; ++r) { p0[r] = (r < 8) ? 0.f : -1e30f; p1[r] = -1e30f; }
}


constexpr float THR2 = 11.5f;
template <bool FIRST> __device__ __forceinline__ void partialSM_rel(f32x16& p0, f32x16& p1, float& m_ref, float& alpha) {
    float pmax = fmaxf(fmaxf(p0[0], p0[1]), p1[0]);
#pragma unroll
    for (int r = 2; r < 16; r += 2) pmax = fmaxf(fmaxf(pmax, p0[r]), p0[r + 1]);
#pragma unroll
    for (int r = 1; r < 15; r += 2) pmax = fmaxf(fmaxf(pmax, p1[r]), p1[r + 1]);
    pmax = fmaxf(pmax, p1[15]);
    { auto rr = __builtin_amdgcn_permlane32_swap(__float_as_uint(pmax), __float_as_uint(pmax), false, false);
      pmax = fmaxf(__uint_as_float(rr[0]), __uint_as_float(rr[1])); }
    if (!FIRST && __builtin_expect(__all(pmax <= THR2), 1)) { alpha = 1.f; }
    else { const float dl = FIRST ? pmax : fmaxf(pmax, 0.f); m_ref += dl; alpha = FIRST ? 1.f : __builtin_amdgcn_exp2f(-dl);
#pragma unroll
        for (int r = 0; r < 16; ++r) { p0[r] -= dl; p1[r] -= dl; } }
#pragma unroll
    for (int r = 0; r < 16; ++r) p0[r] = __builtin_amdgcn_exp2f(p0[r]);
}
__device__ __forceinline__ void init_real_rel(f32x16& p0, f32x16& p1, float dq, float sl2, float m, int mode) {
    if (mode != 2) { const float S = mode == 0 ? sl2 : -sl2, S2 = 2.f * S, S3 = 3.f * S; const float base = -S * dq - m, base32 = fmaf(S, 32.f, base);
#pragma unroll
        for (int jj = 0; jj < 4; ++jj) { const float t0 = fmaf(S, 8.f * jj, base), t1 = fmaf(S, 8.f * jj, base32);
            p0[4 * jj] = t0; p0[4 * jj + 1] = t0 + S; p0[4 * jj + 2] = t0 + S2; p0[4 * jj + 3] = t0 + S3;
            p1[4 * jj] = t1; p1[4 * jj + 1] = t1 + S; p1[4 * jj + 2] = t1 + S2; p1[4 * jj + 3] = t1 + S3; }
    } else {
#pragma unroll
        for (int r = 0; r < 16; ++r) { const float cr = (float)((r & 3) + 8 * (r >> 2)); p0[r] = -sl2 * fabsf(dq - cr) - m; p1[r] = -sl2 * fabsf(dq - (cr + 32.f)) - m; }
    }
}

#ifndef ATT_PVA
#define ATT_PVA pv_d0
#endif
template <int DQK, bool ALIBI, int SDEPTH>
__device__ __forceinline__ void attn_unit(const bf16* __restrict__ Qb, const int ldq,
                                          const bf16* __restrict__ K0, const int ldk0, const bf16* __restrict__ K1, const int ldk1,
                                          const bf16* __restrict__ Vg, const int ldv, bf16* __restrict__ Ob, const int ldo,
                                          const int kbase, const int q0, const float nslope, const int t_lo, const int t_hi, char* lds, const int tid) {
    constexpr int SHM_K = shm_k<DQK>(), ND0 = DQK / 16, NLD = (DQK == 192) ? 5 : 4;
    const int wid = tid >> 6, lane = tid & 63, r32 = lane & 31, hi = lane >> 5;
    char* V_lds = lds; char* K_lds = lds + 2 * SHM_V;
    float* ws = (float*)(lds + 2 * SHM_V + 2 * SHM_K) + wid * 64; float* li_l = ws; float* al_l = ws + 32;
    constexpr int NQR = nqreg<DQK>();
    float m_reg = ALIBI ? 0.f : -1e30f, l_reg = 0; f32x16 o[4] = {}; bf16x8 qr[NQR];
    const bf16* Qw = Qb + (long)(wid * QBLK + r32) * ldq + hi * 8;
    char* const qp = lds + 2 * SHM_V + 2 * SHM_K + NW * 64 * 4 + wid * (1024 * (ND0 - NQR)) + hi * 512 + r32 * 16;
#pragma unroll
    for (int d0 = 0; d0 < NQR; ++d0) qr[d0] = *reinterpret_cast<const bf16x8*>(Qw + d0 * 16);
#pragma unroll
    for (int d0 = NQR; d0 < ND0; ++d0) *reinterpret_cast<bf16x8*>(qp + (d0 - NQR) * 1024) = *reinterpret_cast<const bf16x8*>(Qw + d0 * 16);
    const int sr = tid >> 4, sc = (tid & 15) * 8, vst0 = v_st(sr, sc), vst1 = v_st(32 + sr, sc);
    const int kr2 = tid >> 3, sc2 = (tid & 7) * 8;
    const int vb0 = (int)(uintptr_t)V_lds + v_rd_base(lane);
    struct { bf16x8 vs0, vs1, ks0, ks1, ks2; } sr_[SDEPTH];
    const float qs = (float)(q0 + wid * QBLK + r32 - 4 * hi);
    const int qw0 = q0 + wid * QBLK;
#define ATT_SLOAD(i, t) do { const int t_ = (t); const long g0 = t_ == 0 ? (long)(MR + (sr & 15)) : (long)(kbase + (t_ - 1) * KVBLK + sr); const long g1 = t_ == 0 ? g0 : g0 + 32; \
        sr_[i].vs0 = *reinterpret_cast<const bf16x8*>(Vg + g0 * ldv + sc); sr_[i].vs1 = *reinterpret_cast<const bf16x8*>(Vg + g1 * ldv + sc); \
        sr_[i].ks0 = *reinterpret_cast<const bf16x8*>(K0 + g0 * ldk0 + sc); sr_[i].ks1 = *reinterpret_cast<const bf16x8*>(K0 + g1 * ldk0 + sc); \
        if constexpr (DQK == 192) { const long g2 = t_ == 0 ? (long)(MR + (kr2 & 15)) : (long)(kbase + (t_ - 1) * KVBLK + kr2); sr_[i].ks2 = *reinterpret_cast<const bf16x8*>(K1 + g2 * ldk1 + sc2); } } while (0)
#define ATT_SWRITE(b, i) do { *(bf16x8*)(V_lds + (b) * SHM_V + vst0) = sr_[i].vs0; *(bf16x8*)(V_lds + (b) * SHM_V + vst1) = sr_[i].vs1; \
        *(bf16x8*)(K_lds + (b) * SHM_K + kswz<DQK>(sr, sc * 2)) = sr_[i].ks0; *(bf16x8*)(K_lds + (b) * SHM_K + kswz<DQK>(32 + sr, sc * 2)) = sr_[i].ks1; \
        if constexpr (DQK == 192) *(bf16x8*)(K_lds + (b) * SHM_K + kswz<DQK>(kr2, (128 + sc2) * 2)) = sr_[i].ks2; } while (0)
#define ATT_SWAIT() do { if constexpr (SDEPTH == 2) { if constexpr (NLD == 5) asm volatile("s_waitcnt vmcnt(5)" ::: "memory"); else asm volatile("s_waitcnt vmcnt(4)" ::: "memory"); } \
        else asm volatile("s_waitcnt vmcnt(0)" ::: "memory"); } while (0)
#define ATT_RESC(a) do { if (__any((a) < 1.f)) { if (hi == 0) al_l[r32] = (a); asm volatile("s_waitcnt lgkmcnt(0)" ::: "memory"); \
        _Pragma("unroll") for (int d = 0; d < 4; ++d) _Pragma("unroll") for (int r = 0; r < 16; ++r) o[d][r] *= al_l[crow(r, hi)]; } } while (0)
    f32x16 pA0, pA1, pB0, pB1; float mnA, mnB, alA, alB; bf16x8 pa0, pa1, pa2, pa3;
    constexpr int SE = 0, SO = SDEPTH - 1;
    constexpr int pm_ = probe_mode();
    if (pm_) { pa0 = bf16x8{}; pa1 = bf16x8{}; pa2 = bf16x8{}; pa3 = bf16x8{}; alA = alB = 1.f; mnA = mnB = 0.f; }
    ATT_SLOAD(SE, 0); asm volatile("s_waitcnt vmcnt(0)" ::: "memory"); ATT_SWRITE(0, SE); __syncthreads();
#define ATT_QK(P0, P1, KS) do { if (!(pm_ & 8)) qkt<DQK>(P0, P1, KS, qr, qp, r32, hi); } while (0)
#define ATT_FSM(P0, P1, AL) do { if (!(pm_ & 16)) finishSM(P0, P1, AL, l_reg, pa0, pa1, pa2, pa3); else asm volatile("" : "+v"(P0), "+v"(P1)); } while (0)
#define ATT_PVX(VB) do { if (!(pm_ & 32)) ATT_PVA(o, VB, pa0, pa1, pa2, pa3); } while (0)
#define ATT_INIT(P0, P1, t) do { if constexpr (ALIBI) { const int k0_ = ((t) - 1) * KVBLK; init_real_rel(P0, P1, qs - (float)k0_, nslope, m_reg, (k0_ + KVBLK - 1 <= qw0) ? 0 : (k0_ >= qw0 + QBLK - 1) ? 1 : 2); } \
        else init_real<false>(P0, P1, 0.f, 0.f); } while (0)
#define ATT_PSM(P0, P1, MN, AL) do { if (!(pm_ & 16)) { if constexpr (ALIBI) partialSM_rel<false>(P0, P1, m_reg, AL); else partialSM<DQK>(P0, P1, m_reg, MN, AL); } } while (0)
    init_meta(pA0, pA1); ATT_QK(pA0, pA1, K_lds);
    if (!(pm_ & 16)) { if constexpr (ALIBI) partialSM_rel<true>(pA0, pA1, m_reg, alA); else partialSM<DQK>(pA0, pA1, m_reg, mnA, alA); }
    ATT_SLOAD(SO, t_lo); if constexpr (SDEPTH == 2) ATT_SLOAD(SE, t_lo + 1);
    ATT_SWAIT(); ATT_SWRITE(1, SO); __syncthreads();
    for (int j = t_lo; j < t_hi; j += 2) {
        ATT_SBAR(); ATT_INIT(pB0, pB1, j); ATT_QK(pB0, pB1, K_lds + SHM_K);
        ATT_FSM(pA0, pA1, alA); ATT_SBAR();
        if (!(pm_ & 64)) { const int tn = j + SDEPTH; ATT_SLOAD(SO, tn < t_hi ? tn : t_hi); } ATT_SBAR();
        ATT_PVX(vb0); ATT_PSM(pB0, pB1, mnB, alB);
        __syncthreads(); if (!(pm_ & 64)) { ATT_SWAIT(); ATT_SWRITE(0, SE); }
        ATT_RESC(alB); __syncthreads();
        ATT_SBAR(); ATT_INIT(pA0, pA1, j + 1); ATT_QK(pA0, pA1, K_lds);
        ATT_FSM(pB0, pB1, alB); ATT_SBAR();
        if (!(pm_ & 64)) { const int tn = j + 1 + SDEPTH; ATT_SLOAD(SE, tn < t_hi ? tn : t_hi); } ATT_SBAR();
        ATT_PVX(vb0 + SHM_V); ATT_PSM(pA0, pA1, mnA, alA);
        __syncthreads(); if (!(pm_ & 64)) { ATT_SWAIT(); ATT_SWRITE(1, SO); }
        ATT_RESC(alA); __syncthreads();
    }
    ATT_FSM(pA0, pA1, alA); ATT_SBAR();
    ATT_PVX(vb0);
    asm volatile("s_waitcnt vmcnt(0)" ::: "memory");
    if (hi == 0) li_l[r32] = l_reg; asm volatile("s_waitcnt lgkmcnt(0)" ::: "memory");
    float rli[16];
#pragma unroll
    for (int r = 0; r < 16; ++r) rli[r] = __builtin_amdgcn_rcpf(li_l[crow(r, hi)]);
    bf16* Ow = Ob + (long)(wid * QBLK) * ldo;
#pragma unroll
    for (int r = 0; r < 16; ++r) { const int orow = crow(r, hi);
#pragma unroll
        for (int d0 = 0; d0 < 4; d0 += 1) { const unsigned w = cvtpk(o[d0][r] * rli[r], 0.f); if (pm_ & 4) asm volatile("" :: "v"(w)); else Ow[(long)orow * ldo + d0 * 32 + r32] = (bf16)(w & 0xffffu); } }
    __syncthreads();
#undef ATT_QK
#undef ATT_FSM
#undef ATT_PVX
#undef ATT_INIT
#undef ATT_PSM
#undef ATT_SLOAD
#undef ATT_SWRITE
#undef ATT_SWAIT
#undef ATT_RESC
}

#ifndef NQRB
#define NQRB 2
#endif
constexpr int SHMB_V = 2 * SHM_V, SHMB_K = shm_k<128>(), SHMB_TOTAL = 2 * SHMB_V + 2 * SHMB_K + NW * 64 * 4 + NW * 1024 * (8 - NQRB);
__device__ __forceinline__ void attn_unit_b(const bf16* __restrict__ Qb, const int ldq, const bf16* __restrict__ K0, const int ldk0, const bf16* __restrict__ Vg, const int ldv,
                                            bf16* __restrict__ Ob, const int ldo, const int kbase, const int q0, const float sl2, const int t_lo, const int t_hi, char* lds, const int tid) {
    const int wid = tid >> 6, lane = tid & 63, r32 = lane & 31, hi = lane >> 5;
    char* V_lds = lds; char* K_lds = lds + 2 * SHMB_V;
    float* ws = (float*)(lds + 2 * SHMB_V + 2 * SHMB_K) + wid * 64; float* li_l = ws; float* al_l = ws + 32;
    char* const qp = lds + 2 * SHMB_V + 2 * SHMB_K + NW * 64 * 4 + wid * (1024 * (8 - NQRB)) + hi * 512 + r32 * 16;
    float m_reg = 0.f, l_reg = 0; f32x16 o[8] = {}; bf16x8 qr[NQRB > 0 ? NQRB : 1];
    const bf16* Qw = Qb + (long)(wid * QBLK + r32) * ldq + hi * 8;
#pragma unroll
    for (int d0 = 0; d0 < NQRB; ++d0) qr[d0] = *reinterpret_cast<const bf16x8*>(Qw + d0 * 16);
#pragma unroll
    for (int d0 = NQRB; d0 < 8; ++d0) *reinterpret_cast<bf16x8*>(qp + (d0 - NQRB) * 1024) = *reinterpret_cast<const bf16x8*>(Qw + d0 * 16);
    const int vb0 = (int)(uintptr_t)V_lds + v_rd_base(lane);
    const float qs = (float)(q0 + wid * QBLK + r32 - 4 * hi); const int qw0 = q0 + wid * QBLK;
    typedef __attribute__((address_space(3))) unsigned las_u32;
    const unsigned ldsw = (unsigned)__builtin_amdgcn_readfirstlane(wid) * 2048u;
#define ATB_DMA(t, b) do { const int t_ = (t); int ln_ = lane; asm volatile("" : "+v"(ln_));     \
        _Pragma("unroll") for (int i_ = 0; i_ < 2; ++i_) { \
        const int p_ = (2 * wid + i_) * 1024 + ln_ * 16, kr_ = p_ >> 8, kc_ = ((((p_ >> 4) & 15) ^ (kr_ & 15)) << 3);            \
        const int st_ = p_ >> 9, q_ = p_ & 511, kk_ = (st_ >> 2) * 8 + (q_ >> 6), vr_ = (kk_ & ~0xC) | ((kk_ & 4) << 1) | ((kk_ & 8) >> 1), vc_ = (st_ & 3) * 32 + ((q_ & 63) >> 1);     \
        const long gk = t_ == 0 ? (long)(MR + (kr_ & 15)) : (long)(kbase + (t_ - 1) * KVBLK + kr_); const long gv = t_ == 0 ? (long)(MR + (vr_ & 15)) : (long)(kbase + (t_ - 1) * KVBLK + vr_); \
        __builtin_amdgcn_global_load_lds((const unsigned*)(K0 + gk * ldk0 + kc_), (las_u32*)(K_lds + (b) * SHMB_K + ldsw + i_ * 1024), 16, 0, 0); \
        __builtin_amdgcn_global_load_lds((const unsigned*)(Vg + gv * ldv + vc_), (las_u32*)(V_lds + (b) * SHMB_V + ldsw + i_ * 1024), 16, 0, 0); \
        __builtin_amdgcn_global_load_lds((const unsigned*)(Vg + gv * ldv + 128 + vc_), (las_u32*)(V_lds + (b) * SHMB_V + SHM_V + ldsw + i_ * 1024), 16, 0, 0); } } while (0)
#ifndef ATB_PV
#define ATB_PV pv_pipe
#endif
#ifndef ATB_QK
#define ATB_QK qkt_b
#endif
    f32x16 p0, p1; float al; bf16x8 pa0, pa1, pa2, pa3;
#define ATB_TILE(FIRST, t, bufi) do { \
        if (FIRST) init_meta(p0, p1); else { const int k0_ = ((t) - 1) * KVBLK; init_real_rel(p0, p1, qs - (float)k0_, sl2, m_reg, (k0_ + KVBLK - 1 <= qw0) ? 0 : (k0_ >= qw0 + QBLK - 1) ? 1 : 2); } \
        if (!(pm_ & 8)) ATB_QK<NQRB>(p0, p1, K_lds + (bufi) * SHMB_K, qr, qp, r32, hi); \
        if (!(pm_ & 16)) { if (FIRST) partialSM_rel<true>(p0, p1, m_reg, al); else partialSM_rel<false>(p0, p1, m_reg, al); \
        if (!(FIRST)) { if (__any(al < 1.f)) { if (hi == 0) al_l[r32] = al; asm volatile("s_waitcnt lgkmcnt(0)" ::: "memory"); \
            _Pragma("unroll") for (int d = 0; d < 8; ++d) _Pragma("unroll") for (int r = 0; r < 16; ++r) o[d][r] *= al_l[crow(r, hi)]; } } \
        finishSM(p0, p1, al, l_reg, pa0, pa1, pa2, pa3); } else { asm volatile("" : "+v"(p0), "+v"(p1)); } ATT_SBAR(); \
        if (!(pm_ & 32)) { ATB_PV(o, vb0 + (bufi) * SHMB_V, pa0, pa1, pa2, pa3); ATB_PV(o + 4, vb0 + (bufi) * SHMB_V + SHM_V, pa0, pa1, pa2, pa3); } } while (0)
    const int pm_ = probe_mode();
    if (pm_) { pa0 = bf16x8{}; pa1 = bf16x8{}; pa2 = bf16x8{}; pa3 = bf16x8{}; al = 1.f; }
    ATB_DMA(0, 0); __syncthreads();
    if (!(pm_ & 64)) ATB_DMA(t_lo, 1); ATT_SBAR(); ATB_TILE(true, 0, 0); __syncthreads();
    int buf = 1;
    for (int t = t_lo; t <= t_hi; ++t) {
        if (t < t_hi && !(pm_ & 64)) ATB_DMA(t + 1, buf ^ 1);
        ATT_SBAR(); ATB_TILE(false, t, buf); __syncthreads(); buf ^= 1;
    }
    asm volatile("s_waitcnt vmcnt(0)" ::: "memory");
    if (hi == 0) li_l[r32] = l_reg; asm volatile("s_waitcnt lgkmcnt(0)" ::: "memory");
    float rli[16];
#pragma unroll
    for (int r = 0; r < 16; ++r) rli[r] = __builtin_amdgcn_rcpf(li_l[crow(r, hi)]);
    bf16* Ow = Ob + (long)(wid * QBLK) * ldo;
#pragma unroll
    for (int r = 0; r < 16; ++r) { const int orow = crow(r, hi);
#pragma unroll
        for (int d0 = 0; d0 < 8; ++d0) { const unsigned w = cvtpk(o[d0][r] * rli[r], 0.f); if (pm_ & 4) asm volatile("" :: "v"(w)); else Ow[(long)orow * ldo + d0 * 32 + r32] = (bf16)(w & 0xffffu); } }
    __syncthreads();
#undef ATB_DMA
#undef ATB_TILE
}

#ifndef MLA_STAGGER
#define MLA_STAGGER 1
#endif
constexpr int MLA_NVB = MLA_STAGGER ? 3 : 2;
constexpr int SHMM_K = shm_k<192>(), SHMM_TOTAL = MLA_NVB * SHM_V + 2 * SHMM_K + NW * 64 * 4;
__device__ __forceinline__ void attn_unit_m(const bf16* __restrict__ Qb, const int ldq, const bf16* __restrict__ K0, const int ldk0, const bf16* __restrict__ K1, const int ldk1,
                                            const bf16* __restrict__ Vg, const int ldv, bf16* __restrict__ Ob, const int ldo, const int kbase, char* lds, const int tid) {
    const int wid = tid >> 6, lane = tid & 63, r32 = lane & 31, hi = lane >> 5;
    char* V_lds = lds; char* K_lds = lds + MLA_NVB * SHM_V;
    float* ws = (float*)(lds + MLA_NVB * SHM_V + 2 * SHMM_K) + wid * 64; float* li_l = ws; float* al_l = ws + 32;
    float m_reg = 0.f, l_reg = 0; f32x16 o[4] = {}; bf16x8 qr[12];
    const bf16* Qw = Qb + (long)(wid * QBLK + r32) * ldq + hi * 8;
#pragma unroll
    for (int d0 = 0; d0 < 12; ++d0) qr[d0] = *reinterpret_cast<const bf16x8*>(Qw + d0 * 16);
    const int vb0 = (int)(uintptr_t)V_lds + v_rd_base(lane);
    typedef __attribute__((address_space(3))) unsigned las_u32;
    const unsigned wv_ = (unsigned)__builtin_amdgcn_readfirstlane(wid);
#define ATM_DMA(t, b, vbf) do { const int t_ = (t); int ln_ = lane; asm volatile("" : "+v"(ln_)); \
        _Pragma("unroll") for (int i_ = 0; i_ < 3; ++i_) { const int p_ = (3 * wid + i_) * 1024 + ln_ * 16, kr_ = p_ / 384, sl_ = (p_ - kr_ * 384) >> 4, ch_ = sl_ ^ ((kr_ >> 1) & 7); \
            const long gk = t_ == 0 ? (long)(MR + (kr_ & 15)) : (long)(kbase + (t_ - 1) * KVBLK + kr_); \
            const bf16* src_ = ch_ < 16 ? K0 + gk * ldk0 + ch_ * 8 : K1 + gk * ldk1 + (ch_ - 16) * 8; \
            __builtin_amdgcn_global_load_lds((const unsigned*)src_, (las_u32*)(K_lds + (b) * SHMM_K + (3 * wv_ + i_) * 1024), 16, 0, 0); } \
        _Pragma("unroll") for (int i_ = 0; i_ < 2; ++i_) { const int p_ = (2 * wid + i_) * 1024 + ln_ * 16; \
            const int st_ = p_ >> 9, q_ = p_ & 511, kk_ = (st_ >> 2) * 8 + (q_ >> 6), vr_ = (kk_ & ~0xC) | ((kk_ & 4) << 1) | ((kk_ & 8) >> 1), vc_ = (st_ & 3) * 32 + ((q_ & 63) >> 1); \
            const long gv = t_ == 0 ? (long)(MR + (vr_ & 15)) : (long)(kbase + (t_ - 1) * KVBLK + vr_); \
            __builtin_amdgcn_global_load_lds((const unsigned*)(Vg + gv * ldv + vc_), (las_u32*)(V_lds + (vbf) * SHM_V + (2 * wv_ + i_) * 1024), 16, 0, 0); } } while (0)
    f32x16 p0, p1; float al; bf16x8 pa0, pa1, pa2, pa3;
    constexpr int pm_ = probe_mode();
    if (pm_) { pa0 = bf16x8{}; pa1 = bf16x8{}; pa2 = bf16x8{}; pa3 = bf16x8{}; al = 1.f; }
#define ATM_QKSM(FIRST, bufi) do { \
        if (FIRST) init_meta(p0, p1); else { const float nm_ = -m_reg; _Pragma("unroll") for (int r = 0; r < 16; ++r) { p0[r] = nm_; p1[r] = nm_; } } \
        if (!(pm_ & 8)) { const int kb_ = (int)(uintptr_t)(K_lds + (bufi) * SHMM_K); int rr_ = r32; asm volatile("" : "+v"(rr_)); bf16x8 ka0, ka1, kc0, kc1;     \
            ka0 = lds_rd128(kb_ + kswz<192>(rr_, hi * 16)); ka1 = lds_rd128(kb_ + kswz<192>(32 + rr_, hi * 16)); \
            _Pragma("unroll") for (int d0 = 0; d0 < 12; d0 += 2) { \
                kc0 = lds_rd128(kb_ + kswz<192>(rr_, (d0 + 1) * 32 + hi * 16)); kc1 = lds_rd128(kb_ + kswz<192>(32 + rr_, (d0 + 1) * 32 + hi * 16)); asm volatile("s_waitcnt lgkmcnt(2)" ::: "memory"); ATT_SBAR(); \
                p0 = __builtin_amdgcn_mfma_f32_32x32x16_bf16(ka0, qr[d0], p0, 0, 0, 0); p1 = __builtin_amdgcn_mfma_f32_32x32x16_bf16(ka1, qr[d0], p1, 0, 0, 0); ATT_SBAR(); \
                if (d0 + 2 < 12) { ka0 = lds_rd128(kb_ + kswz<192>(rr_, (d0 + 2) * 32 + hi * 16)); ka1 = lds_rd128(kb_ + kswz<192>(32 + rr_, (d0 + 2) * 32 + hi * 16)); asm volatile("s_waitcnt lgkmcnt(2)" ::: "memory"); } \
                else asm volatile("s_waitcnt lgkmcnt(0)" ::: "memory"); ATT_SBAR(); \
                p0 = __builtin_amdgcn_mfma_f32_32x32x16_bf16(kc0, qr[d0 + 1], p0, 0, 0, 0); p1 = __builtin_amdgcn_mfma_f32_32x32x16_bf16(kc1, qr[d0 + 1], p1, 0, 0, 0); ATT_SBAR(); } } \
        if (!(pm_ & 16)) { if (FIRST) partialSM_rel<true>(p0, p1, m_reg, al); else partialSM_rel<false>(p0, p1, m_reg, al); \
        if (!(FIRST)) { if (__any(al < 1.f)) { if (hi == 0) al_l[r32] = al; asm volatile("s_waitcnt lgkmcnt(0)" ::: "memory"); \
            _Pragma("unroll") for (int d = 0; d < 4; ++d) _Pragma("unroll") for (int r = 0; r < 16; ++r) o[d][r] *= al_l[crow(r, hi)]; } } \
        finishSM(p0, p1, al, l_reg, pa0, pa1, pa2, pa3); } else { asm volatile("" : "+v"(p0), "+v"(p1)); } ATT_SBAR(); } while (0)
#define ATM_PV(vbi) do { ATT_SBAR(); if (!(pm_ & 32)) pv_pipe(o, vb0 + (vbi) * SHM_V, pa0, pa1, pa2, pa3); ATT_SBAR(); } while (0)
    ATM_DMA(0, 0, 0); __syncthreads();
#if MLA_STAGGER
    const bool halfA = __builtin_amdgcn_readfirstlane(wid) < 4;
    if (!(pm_ & 64)) ATM_DMA(1, 1, 1); ATT_SBAR(); ATM_QKSM(true, 0); if (halfA) ATM_PV(0); __syncthreads();
    int vcur = 1, vprev = 0;
    for (int t = 1; t <= 64; ++t) { const int vnext = vcur == 2 ? 0 : vcur + 1;
        if (t < 64 && !(pm_ & 64)) ATM_DMA(t + 1, (t + 1) & 1, vnext);
        if (!halfA) ATM_PV(vprev);
        ATT_SBAR(); ATM_QKSM(false, t & 1);
        if (halfA) ATM_PV(vcur);
        __syncthreads(); vprev = vcur; vcur = vnext;
    }
    if (!halfA) ATM_PV(vprev);
#else
    if (!(pm_ & 64)) ATM_DMA(1, 1, 1); ATT_SBAR(); ATM_QKSM(true, 0); ATM_PV(0); __syncthreads();
    int buf = 1;
    for (int t = 1; t <= 64; ++t) {
        if (t < 64 && !(pm_ & 64)) ATM_DMA(t + 1, buf ^ 1, buf ^ 1);
        ATT_SBAR(); ATM_QKSM(false, buf); ATM_PV(buf); __syncthreads(); buf ^= 1;
    }
#endif
    asm volatile("s_waitcnt vmcnt(0)" ::: "memory");
    if (hi == 0) li_l[r32] = l_reg; asm volatile("s_waitcnt lgkmcnt(0)" ::: "memory");
    float rli[16];
#pragma unroll
    for (int r = 0; r < 16; ++r) rli[r] = __builtin_amdgcn_rcpf(li_l[crow(r, hi)]);
    bf16* Ow = Ob + (long)(wid * QBLK) * ldo;
#pragma unroll
    for (int r = 0; r < 16; ++r) { const int orow = crow(r, hi);
#pragma unroll
        for (int d0 = 0; d0 < 4; ++d0) { const unsigned w = cvtpk(o[d0][r] * rli[r], 0.f); if (pm_ & 4) asm volatile("" :: "v"(w)); else Ow[(long)orow * ldo + d0 * 32 + r32] = (bf16)(w & 0xffffu); } }
    __syncthreads();
#undef ATM_DMA
#undef ATM_QKSM
#undef ATM_PV
}
#undef ATT_SBAR
}

constexpr int NWAVES = 8;
constexpr int NPH = 16;
#ifndef MK_N_LAUNCHES
#define MK_N_LAUNCHES 1
#endif
constexpr int N_LAUNCHES = MK_N_LAUNCHES;
#ifndef DIFF_SDEPTH
#define DIFF_SDEPTH 1
#endif
#ifndef MLA_SDEPTH
#define MLA_SDEPTH 1
#endif

constexpr size_t MiB = 1u << 20;
constexpr size_t WS_CTL = 0, CTL_ZERO_BYTES = 1 * MiB;
constexpr size_t WS_ROPE = 1 * MiB;
constexpr size_t WS_SLAB = 4 * MiB;
constexpr size_t WS_PART = 8 * MiB;
constexpr size_t WS_MX0 = WS_SLAB, WS_MX1 = WS_PART;
constexpr size_t WS_W1GU = 16 * MiB, WS_W1D = 188 * MiB, WS_W2GU = 275 * MiB, WS_W2D = 447 * MiB;
constexpr size_t WS_WIN = 534 * MiB, WS_WG = 596 * MiB, WS_WUQ = 660 * MiB, WS_WUKV = 666 * MiB, WS_WBD = 670 * MiB, WS_WBM = 686 * MiB, WS_WO = 702 * MiB;
constexpr size_t WS_XN = 734 * MiB;
constexpr size_t WS_H = 864 * MiB;
constexpr size_t WS_P = 864 * MiB;
constexpr size_t WS_CQN = 1116 * MiB, WS_CKVN = 1149 * MiB;
constexpr size_t WS_QM = 1166 * MiB;
constexpr size_t WS_KV = 1264 * MiB;
constexpr size_t WS_ORAW = 1394 * MiB;
constexpr size_t WS_OM = 1522 * MiB, WS_OD = 1586 * MiB;
constexpr size_t WS_GATES = 864 * MiB;
constexpr size_t WS_T1 = 1166 * MiB;
constexpr size_t WS_MERGED = 1294 * MiB;
constexpr size_t WS_END = 1650 * MiB;
static_assert(WS_W1GU + (size_t)2 * DFF * DM * 2 <= WS_W1D && WS_W1D + (size_t)DM * LDH * 2 <= WS_W2GU && WS_W2GU + (size_t)2 * DFF * DM * 2 <= WS_W2D && WS_W2D + (size_t)DM * LDH * 2 <= WS_WIN, "ws map 1");
static_assert(WS_WIN + (size_t)INWP * DM * 2 <= WS_WG && WS_WG + (size_t)2 * DM * DM * 2 <= WS_WUQ && WS_WUQ + (size_t)3072 * 1024 * 2 <= WS_WUKV && WS_WUKV + (size_t)4096 * 512 * 2 <= WS_WBD, "ws map 2");
static_assert(WS_WBD + (size_t)DM * 2048 * 2 <= WS_WBM && WS_WBM + (size_t)DM * 2048 * 2 <= WS_WO && WS_WO + (size_t)DM * DM * 2 <= WS_XN && WS_XN + (size_t)MP * DM * 2 <= WS_H, "ws map 3");
static_assert(WS_H + (size_t)MP * LDH * 2 <= WS_END && WS_P + (size_t)MP * INWP * 2 <= WS_CQN && WS_CQN + (size_t)MP * 1024 * 2 <= WS_CKVN && WS_CKVN + (size_t)MP * 512 * 2 <= WS_QM, "ws map 4");
static_assert(WS_QM + (size_t)MP * 3072 * 2 <= WS_KV && WS_KV + (size_t)MP * 4096 * 2 <= WS_ORAW && WS_ORAW + (size_t)MR * 4096 * 2 <= WS_OM && WS_OM + (size_t)MR * 2048 * 2 <= WS_OD && WS_OD + (size_t)MR * 2048 * 2 <= WS_END, "ws map 5");
static_assert(WS_GATES + (size_t)MR * 2 * DM * 2 <= WS_QM && WS_T1 + (size_t)MR * DM * 2 <= WS_MERGED && WS_MERGED + (size_t)MR * DM * 2 <= WS_OM, "ws map 6");
static_assert(WS_ROPE + (size_t)(SEQ + NMETA) * 32 * 8 <= WS_SLAB && WS_SLAB + (size_t)16 * NMETA * DM * 4 <= WS_PART && WS_PART + (size_t)MP * 64 * 4 <= WS_W1GU, "ws map 7");
constexpr int CW_BAR = 4096;
constexpr int CW_SSQ1 = 65536, CW_SSQ2 = 98304, CW_SSQ3 = 131072;
constexpr int CW_QMAX = 163840, CW_KMAX = CW_QMAX + BATCH * 16 * 16, CW_KMETA = CW_KMAX + BATCH * 16;
static_assert((size_t)(CW_KMETA + 16) * 4 <= CTL_ZERO_BYTES, "CTL map 2");
static_assert(CW_BAR + 16 * 3456 <= CW_SSQ1 && CW_SSQ1 + MP <= CW_SSQ2 && CW_SSQ2 + MP <= CW_SSQ3 && (size_t)(CW_SSQ3 + MP) * 4 <= CTL_ZERO_BYTES, "CTL map");

constexpr int RING_OFF = 0, RING_BYTES = 161792;
constexpr int LDSCTL_OFF = RING_BYTES, MISC_OFF = LDSCTL_OFF + 320;
constexpr int LDS_BYTES = 162816;
static_assert(att::SHMB_TOTAL <= RING_BYTES && att::shm_total<128>() <= RING_BYTES && att::shm_total<192>() <= RING_BYTES && pg8::STAGE_BYTES <= RING_BYTES && LDS_BYTES <= 163840, "LDS map");
static_assert(MISC_OFF + 128 <= LDS_BYTES, "LDS map");

#define GAS __attribute__((address_space(1)))
#define LAS __attribute__((address_space(3)))
typedef unsigned short bf16;
typedef unsigned v4u __attribute__((ext_vector_type(4)));
typedef unsigned v2u __attribute__((ext_vector_type(2)));
typedef float f32x4 __attribute__((ext_vector_type(4)));
typedef GAS unsigned gu32;
#define RLX_AGENT __ATOMIC_RELAXED, __HIP_MEMORY_SCOPE_AGENT
#define LDS_WAIT() asm volatile("s_waitcnt lgkmcnt(0)" ::: "memory")
#define VM_WAIT() asm volatile("s_waitcnt vmcnt(0)" ::: "memory")
__device__ __forceinline__ unsigned f2bf(float f) { unsigned u = __builtin_bit_cast(unsigned, f); return (u + 0x7fffu + ((u >> 16) & 1u)) >> 16; }
__device__ __forceinline__ unsigned pk2(float lo, float hi) { return f2bf(lo) | (f2bf(hi) << 16); }
__device__ __forceinline__ float bflo(unsigned w) { return __uint_as_float(w << 16); }
__device__ __forceinline__ float bfhi(unsigned w) { return __uint_as_float(w & 0xffff0000u); }
__device__ __forceinline__ float wave_sum(float v) {
#pragma unroll
    for (int o = 1; o < 64; o <<= 1) v += __shfl_xor(v, o);
    return v;
}

#define XB_TMO      128
#define XB_XCNT(j)  (256  + 64 * (j))
#define XB_XSUB(j)  (1280 + 64 * (j))
#define XB_XGEN(j)  (2304 + 64 * (j))
#define XB_TOP      3328
#define XB_TOPGEN   3392
#define XCD_BAR_WORDS 3456
#define XB_SPIN_CAP (1u << 18)

__device__ __forceinline__ unsigned xb_ld(unsigned* p)              { return __hip_atomic_load(p, __ATOMIC_RELAXED, __HIP_MEMORY_SCOPE_AGENT); }
__device__ __forceinline__ unsigned xb_add(unsigned* p, unsigned v) { return __hip_atomic_fetch_add(p, v, __ATOMIC_RELAXED, __HIP_MEMORY_SCOPE_AGENT); }
__device__ __forceinline__ unsigned xb_xcc_id() { return (unsigned)__builtin_amdgcn_s_getreg((3 << 11) | 20) & 0xFu; }
#define XB_SPIN(cond, bar) do { unsigned _sp = 0; while (cond) { __builtin_amdgcn_s_sleep(1); \
    if ((++_sp & 255u) == 0u) { if (xb_ld(&(bar)[XB_TMO])) break; if (_sp > XB_SPIN_CAP) { atomicAdd(&(bar)[XB_TMO], 1u); break; } } } } while (0)

struct XcdBarrier {
    unsigned* bar; unsigned x;
    volatile LAS unsigned* st;
};

__device__ __forceinline__ XcdBarrier xcd_barrier_post(unsigned* bar, volatile LAS unsigned* st) {
    XcdBarrier b; b.bar = bar; b.x = xb_xcc_id(); b.st = st;
    if (threadIdx.x == 0) (void)xb_add(&bar[XB_XCNT(b.x)], 1u);
    return b;
}
__device__ __forceinline__ void xcd_barrier_complete(unsigned* bar, unsigned x, unsigned& nloc, unsigned& nx) {
    const unsigned G = gridDim.x * gridDim.y * gridDim.z;
    unsigned sum, cnt, mine, sp = 0u;
    for (;;) {
        sum = 0u; cnt = 0u; mine = 0u;
#pragma unroll
        for (unsigned j = 0; j < 16; ++j) { const unsigned c = xb_ld(&bar[XB_XCNT(j)]); sum += c; cnt += (c > 0u) ? 1u : 0u; mine = (j == x) ? c : mine; }
        if (sum == G) break;
        __builtin_amdgcn_s_sleep(1);
        if ((++sp & 255u) == 0u) { if (xb_ld(&bar[XB_TMO])) break; if (sp > XB_SPIN_CAP) { atomicAdd(&bar[XB_TMO], 1u); break; } }
    }
    nloc = mine > 0u ? mine : 1u; nx = cnt > 0u ? cnt : 1u;
}

__device__ __forceinline__ void xcd_barrier(const XcdBarrier& b) {
    asm volatile("s_waitcnt vmcnt(0)" ::: "memory");
    __syncthreads();
    if (threadIdx.x == 0) {
        unsigned* bar = b.bar;
        __builtin_amdgcn_s_waitcnt(0);
        unsigned nloc = b.st[0], nx = b.st[1];
        if (nloc == 0u) { xcd_barrier_complete(bar, b.x, nloc, nx); b.st[0] = nloc; b.st[1] = nx; }
        const unsigned old = xb_add(&bar[XB_XSUB(b.x)], 1u);
        const unsigned gen = old / nloc;
        if (old + 1u == (gen + 1u) * nloc) {
            __builtin_amdgcn_fence(__ATOMIC_RELEASE, "agent");
            asm volatile("s_waitcnt vmcnt(0)" ::: "memory");
            const unsigned og = xb_add(&bar[XB_TOP], 1u);
            const unsigned tg = og / nx;
            if (og + 1u == (tg + 1u) * nx) xb_add(&bar[XB_TOPGEN], 1u);
            else XB_SPIN(xb_ld(&bar[XB_TOPGEN]) == tg, bar);
            __builtin_amdgcn_fence(__ATOMIC_ACQUIRE, "agent");
            xb_add(&bar[XB_XGEN(b.x)], 1u);
            asm volatile("s_waitcnt vmcnt(0)" ::: "memory");
        } else {
            XB_SPIN(xb_ld(&bar[XB_XGEN(b.x)]) == gen, bar);
            __builtin_amdgcn_fence(__ATOMIC_ACQUIRE, "agent");
            asm volatile("s_waitcnt vmcnt(0)" ::: "memory");
        }
    }
    __syncthreads();
}

template <int MAP> __device__ __forceinline__ int map_row(int n) {
    if (MAP == 1) return 256 * (n >> 7) + (n & 127);
    if (MAP == 2) return 256 * (n >> 7) + 128 + (n & 127);
    if (MAP == 3) { if (n < PC_KR) return n; const int j = n - PC_KR; return PC_KR + (j < 32 ? 2 * j : 2 * (j - 32) + 1); }
    if (MAP == 4) { const int h = n / 192, d = n % 192; if (d < 128) return n; const int j = d - 128; return h * 192 + 128 + (j < 32 ? 2 * j : 2 * (j - 32) + 1); }
    return n;
}
template <int MAP> __device__ __forceinline__ void p0_transpose_item(const float* W, int K, int N, bf16* WT, LAS float* scr, int item, int lane, const float* gain = nullptr, int ldw = 0) {
    const int nblk = N / 32, kb = item / nblk, nb = item % nblk, k0 = 64 * kb, n0 = 32 * nb;
    float wv[32];
#pragma unroll
    for (int i = 0; i < 32; ++i) { const int kk = 2 * i + (lane >> 5); wv[i] = __builtin_nontemporal_load(W + (size_t)(k0 + kk) * N + n0 + (lane & 31)); }
#pragma unroll
    for (int i = 0; i < 32; ++i) { const int kk = 2 * i + (lane >> 5); scr[kk * 33 + (lane & 31)] = wv[i]; }
    LDS_WAIT(); asm volatile("" ::: "memory");
    const int c = lane & 7;
    f32x4 g0 = (f32x4){1.f, 1.f, 1.f, 1.f}, g1 = g0;
    if (gain) { g0 = *(const GAS f32x4*)(gain + k0 + 8 * c); g1 = *(const GAS f32x4*)(gain + k0 + 8 * c + 4); }
#pragma unroll
    for (int j = 0; j < 4; ++j) { const int n = (lane >> 3) + 8 * j; const LAS float* s = scr + (8 * c) * 33 + n;
        v4u o; o.x = pk2(s[0 * 33] * g0.x, s[1 * 33] * g0.y); o.y = pk2(s[2 * 33] * g0.z, s[3 * 33] * g0.w); o.z = pk2(s[4 * 33] * g1.x, s[5 * 33] * g1.y); o.w = pk2(s[6 * 33] * g1.z, s[7 * 33] * g1.w);
        const int nr = map_row<MAP>(n0 + n);
        if (ldw >= 0) *(GAS v4u*)(WT + (size_t)nr * (ldw ? ldw : K) + k0 + 8 * c) = o;
        else *(GAS v4u*)(WT + (((size_t)(nr >> 8) * (K / 64) + (k0 >> 6)) * 256 + (nr & 255)) * 64 + 8 * c) = o; }
    LDS_WAIT(); asm volatile("" ::: "memory");
}
struct CvtDesc { const float* W; bf16* WT; const float* gain; int K, N, ldw, map, r; };
__device__ __forceinline__ int map_row_rt(int map, int n) {
    if (map == 1) return map_row<1>(n); if (map == 2) return map_row<2>(n); if (map == 3) return map_row<3>(n); if (map == 4) return map_row<4>(n); return n; }
#ifndef CVT_WIDE
#define CVT_WIDE 0
#endif
#if CVT_WIDE
__device__ __forceinline__ void cvt_load(const CvtDesc& d, float (&wv)[32], int lane) {
    const int nblk = d.N / 64, kb = d.r / nblk, nb = d.r % nblk; const float* src = d.W + (size_t)(32 * kb) * d.N + 64 * nb + lane;
#pragma unroll
    for (int i = 0; i < 32; ++i) wv[i] = __builtin_nontemporal_load(src + (size_t)i * d.N);
}
__device__ __forceinline__ void cvt_finish(const CvtDesc& d, const float (&wv)[32], LAS float* scr, int lane) {
    const int nblk = d.N / 64, kb = d.r / nblk, nb = d.r % nblk, k0 = 32 * kb, n0 = 64 * nb;
#pragma unroll
    for (int i = 0; i < 32; ++i) scr[i * 65 + lane] = wv[i];
    LDS_WAIT(); asm volatile("" ::: "memory");
    const int c = lane & 3;
    f32x4 g0 = (f32x4){1.f, 1.f, 1.f, 1.f}, g1 = g0;
    if (d.gain) { g0 = *(const GAS f32x4*)(d.gain + k0 + 8 * c); g1 = *(const GAS f32x4*)(d.gain + k0 + 8 * c + 4); }
#pragma unroll
    for (int j = 0; j < 4; ++j) { const int n = (lane >> 2) + 16 * j; const LAS float* s = scr + (8 * c) * 65 + n;
        v4u o; o.x = pk2(s[0 * 65] * g0.x, s[1 * 65] * g0.y); o.y = pk2(s[2 * 65] * g0.z, s[3 * 65] * g0.w); o.z = pk2(s[4 * 65] * g1.x, s[5 * 65] * g1.y); o.w = pk2(s[6 * 65] * g1.z, s[7 * 65] * g1.w);
        const int nr = map_row_rt(d.map, n0 + n);
        if (d.ldw >= 0) *(GAS v4u*)(d.WT + (size_t)nr * (d.ldw ? d.ldw : d.K) + k0 + 8 * c) = o;
        else *(GAS v4u*)(d.WT + (((size_t)(nr >> 8) * (d.K / 64) + (k0 >> 6)) * 256 + (nr & 255)) * 64 + (k0 & 63) + 8 * c) = o; }
    LDS_WAIT(); asm volatile("" ::: "memory");
}
#else
__device__ __forceinline__ void cvt_load(const CvtDesc& d, float (&wv)[32], int lane) {
    const int nblk = d.N / 32, kb = d.r / nblk, nb = d.r % nblk; const float* src = d.W + (size_t)(64 * kb + (lane >> 5)) * d.N + 32 * nb + (lane & 31);
#pragma unroll
    for (int i = 0; i < 32; ++i) wv[i] = __builtin_nontemporal_load(src + (size_t)(2 * i) * d.N);
}
__device__ __forceinline__ void cvt_finish(const CvtDesc& d, const float (&wv)[32], LAS float* scr, int lane) {
    const int nblk = d.N / 32, kb = d.r / nblk, nb = d.r % nblk, k0 = 64 * kb, n0 = 32 * nb;
#pragma unroll
    for (int i = 0; i < 32; ++i) { const int kk = 2 * i + (lane >> 5); scr[kk * 33 + (lane & 31)] = wv[i]; }
    LDS_WAIT(); asm volatile("" ::: "memory");
    const int c = lane & 7;
    f32x4 g0 = (f32x4){1.f, 1.f, 1.f, 1.f}, g1 = g0;
    if (d.gain) { g0 = *(const GAS f32x4*)(d.gain + k0 + 8 * c); g1 = *(const GAS f32x4*)(d.gain + k0 + 8 * c + 4); }
#pragma unroll
    for (int j = 0; j < 4; ++j) { const int n = (lane >> 3) + 8 * j; const LAS float* s = scr + (8 * c) * 33 + n;
        v4u o; o.x = pk2(s[0 * 33] * g0.x, s[1 * 33] * g0.y); o.y = pk2(s[2 * 33] * g0.z, s[3 * 33] * g0.w); o.z = pk2(s[4 * 33] * g1.x, s[5 * 33] * g1.y); o.w = pk2(s[6 * 33] * g1.z, s[7 * 33] * g1.w);
        const int nr = map_row_rt(d.map, n0 + n);
        if (probe_mode() & 256) asm volatile("" :: "v"(o)); else
        if (d.ldw >= 0) *(GAS v4u*)(d.WT + (size_t)nr * (d.ldw ? d.ldw : d.K) + k0 + 8 * c) = o;
        else *(GAS v4u*)(d.WT + (((size_t)(nr >> 8) * (d.K / 64) + (k0 >> 6)) * 256 + (nr & 255)) * 64 + 8 * c) = o; }
    LDS_WAIT(); asm volatile("" ::: "memory");
}
#endif
__device__ __forceinline__ void rms_row_to_bf16(const float* xrow, const float* g, bf16* orow, int lane) {
    const GAS f32x4* xr = (const GAS f32x4*)xrow + lane; const GAS f32x4* gr = (const GAS f32x4*)g + lane;
    f32x4 v[16]; float s = 0.f;
#pragma unroll
    for (int j = 0; j < 16; ++j) { v[j] = xr[64 * j]; s += (v[j].x * v[j].x + v[j].y * v[j].y) + (v[j].z * v[j].z + v[j].w * v[j].w); }
    const float rstd = 1.f / sqrtf(wave_sum(s) * (1.f / DM) + EPS);
    GAS v2u* o8 = (GAS v2u*)orow + lane;
#pragma unroll
    for (int j = 0; j < 16; ++j) { const f32x4 gg = gr[64 * j]; v2u w; w.x = pk2(v[j].x * rstd * gg.x, v[j].y * rstd * gg.y); w.y = pk2(v[j].z * rstd * gg.z, v[j].w * rstd * gg.w); o8[64 * j] = w; }
}
__device__ __forceinline__ void zero_row_bf16(bf16* orow, int nelem, int lane) {
    GAS v4u* o = (GAS v4u*)orow + lane;
    for (int j = 0; j < nelem / 512; ++j) o[64 * j] = (v4u){0u, 0u, 0u, 0u};
}
__device__ __forceinline__ void rms_row_inplace(float* xrow, const float* g, int lane) {
    GAS f32x4* xr = (GAS f32x4*)xrow + lane; const GAS f32x4* gr = (const GAS f32x4*)g + lane;
    f32x4 v[16]; float s = 0.f;
#pragma unroll
    for (int j = 0; j < 16; ++j) { v[j] = xr[64 * j]; s += (v[j].x * v[j].x + v[j].y * v[j].y) + (v[j].z * v[j].z + v[j].w * v[j].w); }
    const float rstd = 1.f / sqrtf(wave_sum(s) * (1.f / DM) + EPS);
#pragma unroll
    for (int j = 0; j < 16; ++j) { const f32x4 gg = gr[64 * j]; xr[64 * j] = v[j] * rstd * gg; }
}

struct Args { const float* in[27]; float* out; unsigned char* ws; int ph_lo, ph_hi, att_mask, pad; };
static_assert(sizeof(Args) == 27 * 8 + 8 + 8 + 16, "Args has no padding");
enum { I_X = 0, I_META, I_N1, I_W1G, I_W1U, I_W1D, I_NMIX, I_WIN, I_LQ1, I_LK1, I_LQ2, I_LK2, I_SUBLN, I_QNORM, I_WUQ, I_KVNORM, I_WUKV, I_WG, I_BG, I_WBD, I_WBM, I_WO, I_N2, I_W2G, I_W2U, I_W2D, I_NF };

__global__ void __launch_bounds__(NWAVES * 64, 2) fwd(Args  ) {
    extern __shared__ __attribute__((aligned(16))) unsigned char lds[];
    LAS unsigned char* const L = (LAS unsigned char*)lds;
    volatile LAS unsigned* const MISC = (volatile LAS unsigned*)(L + MISC_OFF);
    const int tid = threadIdx.x;
typedef const __attribute__((address_space(4))) Args* CArgsP;
#define KARGS() ({ CArgsP p_ = (CArgsP)__builtin_amdgcn_kernarg_segment_ptr(); asm volatile("" : "+s"(p_)); p_; })
    int lo, hi; { CArgsP A0 = KARGS(); lo = A0->ph_lo; hi = A0->ph_hi; }
    for (int u = tid; u < (LDS_BYTES - LDSCTL_OFF) / 4; u += NWAVES * 64) ((LAS unsigned*)(L + LDSCTL_OFF))[u] = 0u;
    __syncthreads();
    (void)xcd_barrier_post((unsigned*)(KARGS()->ws + WS_CTL) + CW_BAR + lo * XCD_BAR_WORDS, MISC + 8);
#define GRID_BAR() do { XcdBarrier b_; b_.bar = (unsigned*)(KARGS()->ws + WS_CTL) + CW_BAR + lo * XCD_BAR_WORDS; b_.x = xb_xcc_id(); b_.st = MISC + 8; xcd_barrier(b_); } while (0)
#ifndef PH_MASK
#define PH_MASK 0xFFFF
#endif
#define IN(k) ((((PH_MASK) >> (k)) & 1) && lo <= (k) && (k) < hi)
#define BOTH(k) (IN(k) && IN((k) + 1))
#define PHASE_PTRS() const int tidp_ = threadIdx.x, lane = tidp_ & 63, wave = __builtin_amdgcn_readfirstlane(tidp_ >> 6); (void)lane; (void)wave; \
    const int G = gridDim.x, bx = blockIdx.x, vcu = (G % 8 == 0) ? (bx % 8) * (G / 8) + bx / 8 : bx, gw = vcu * NWAVES + wave, NGW = G * NWAVES; (void)gw; (void)NGW; (void)vcu;     \
    CArgsP const A = KARGS(); unsigned char* const ws = A->ws; float* const out = A->out; (void)out; gu32* const ctl = (gu32*)(ws + WS_CTL); (void)ctl; \
    bf16* const XN = (bf16*)(ws + WS_XN); bf16* const HB = (bf16*)(ws + WS_H); bf16* const PB = (bf16*)(ws + WS_P); (void)XN; (void)HB; (void)PB; \
    bf16* const CQN = (bf16*)(ws + WS_CQN); bf16* const CKVN = (bf16*)(ws + WS_CKVN); bf16* const QM = (bf16*)(ws + WS_QM); bf16* const KV = (bf16*)(ws + WS_KV); (void)CQN; (void)CKVN; (void)QM; (void)KV; \
    bf16* const ORAW = (bf16*)(ws + WS_ORAW); bf16* const OM = (bf16*)(ws + WS_OM); bf16* const OD = (bf16*)(ws + WS_OD); (void)ORAW; (void)OM; (void)OD; \
    bf16* const GATES = (bf16*)(ws + WS_GATES); bf16* const T1 = (bf16*)(ws + WS_T1); bf16* const MERGED = (bf16*)(ws + WS_MERGED); (void)GATES; (void)T1; (void)MERGED; \
    float* const SLAB = (float*)(ws + WS_SLAB); float* const PART = (float*)(ws + WS_PART); float* const ROPE = (float*)(ws + WS_ROPE); (void)SLAB; (void)PART; (void)ROPE
    typedef pg8::bf16_t pbf;
#define GEMM_PHASE(EPI_T, Aptr, Btptr, Mr, Nr, Kr, LDA, LDB, EPI) GEMM_PHASE_S(EPI_T, Aptr, Btptr, Mr, Nr, Kr, LDA, LDB, EPI, 0, 8)
#define GEMM_PHASE_BLK(EPI_T, Aptr, Btptr, Mr, Nr, Kr, EPI, NSPLIT, WGM_) do { pg8::Gemm g_{(const pbf*)(Aptr), (const pbf*)(Btptr), (Mr), (Nr), (Kr), 64, 64, 1}; \
        pg8::StaticOrder S_; S_.init((Mr), (Nr), (Kr), G, bx, (NSPLIT), (WGM_)); pg8::gemm_phase<EPI_T, pg8::StaticOrder, PG8_ALIGNV, PG8_SP2V>(L + RING_OFF, g_, S_, EPI); } while (0)
#ifndef NCONV
#define NCONV 0
#endif
#ifndef PG8_ALIGNV
#define PG8_ALIGNV true
#endif
#ifndef PG8_SP2V
#define PG8_SP2V true
#endif
#ifndef WGM_DOWN
#define WGM_DOWN 2
#endif
#ifndef STAGGER_TICKS
#define STAGGER_TICKS 0
#endif
#define STAGGER() do { if (STAGGER_TICKS > 0) { const unsigned long long te_ = __builtin_amdgcn_s_memrealtime() + (unsigned long long)(((bx >> 7) & 1) * (STAGGER_TICKS)); while (__builtin_amdgcn_s_memrealtime() < te_) __builtin_amdgcn_s_sleep(16); } } while (0)
#define GEMM_PHASE_S(EPI_T, Aptr, Btptr, Mr, Nr, Kr, LDA, LDB, EPI, NSPLIT, WGM_) do { pg8::Gemm g_{(const pbf*)(Aptr), (const pbf*)(Btptr), (Mr), (Nr), (Kr), (LDA), (LDB), 0}; \
        pg8::StaticOrder S_; S_.init((Mr), (Nr), (Kr), G, bx, (NSPLIT), (WGM_)); pg8::gemm_phase<EPI_T, pg8::StaticOrder, PG8_ALIGNV, PG8_SP2V>(L + RING_OFF, g_, S_, EPI); } while (0)

    constexpr int IT_FG = (DM / 64) * (DFF / 32), IT_FD = (DFF / 64) * (DM / 32), IT_WIN = (DM / 64) * (INW / 32), IT_WG = (DM / 64) * (2 * DM / 32),
                  IT_UQ = (1024 / 64) * (3072 / 32), IT_UKV = (512 / 64) * (4096 / 32), IT_BR = (2048 / 64) * (DM / 32), IT_WO = (DM / 64) * (DM / 32);
    constexpr int NITEMS = 4 * IT_FG + 2 * IT_FD + IT_WIN + IT_WG + IT_UQ + IT_UKV + 2 * IT_BR + IT_WO, NEARLY = 2 * IT_FG;
    if (IN(0)) { PHASE_PTRS();
        LAS float* scr = (LAS float*)(L + RING_OFF + wave * 16384);
#define CVT_DECODE(d_, it_) do { int r = (it_); \
            if (r < IT_FG) { d_ = CvtDesc{A->in[I_W1G], (bf16*)(ws + WS_W1GU), nullptr, DM, DFF, 0, 1, r}; break; } r -= IT_FG; \
            if (r < IT_FG) { d_ = CvtDesc{A->in[I_W1U], (bf16*)(ws + WS_W1GU), nullptr, DM, DFF, 0, 2, r}; break; } r -= IT_FG; \
            if (r < IT_FD) { d_ = CvtDesc{A->in[I_W1D], (bf16*)(ws + WS_W1D), nullptr, DFF, DM, -1, 0, r}; break; } r -= IT_FD; \
            if (r < IT_WIN) { d_ = CvtDesc{A->in[I_WIN], (bf16*)(ws + WS_WIN), A->in[I_NMIX], DM, INW, 0, 3, r}; break; } r -= IT_WIN; \
            if (r < IT_WG) { d_ = CvtDesc{A->in[I_WG], (bf16*)(ws + WS_WG), A->in[I_NMIX], DM, 2 * DM, 0, 0, r}; break; } r -= IT_WG; \
            if (r < IT_UQ) { d_ = CvtDesc{A->in[I_WUQ], (bf16*)(ws + WS_WUQ), nullptr, 1024, 3072, 0, 4, r}; break; } r -= IT_UQ; \
            if (r < IT_UKV) { d_ = CvtDesc{A->in[I_WUKV], (bf16*)(ws + WS_WUKV), nullptr, 512, 4096, 0, 0, r}; break; } r -= IT_UKV; \
            if (r < IT_BR) { d_ = CvtDesc{A->in[I_WBD], (bf16*)(ws + WS_WBD), nullptr, 2048, DM, 0, 0, r}; break; } r -= IT_BR; \
            if (r < IT_BR) { d_ = CvtDesc{A->in[I_WBM], (bf16*)(ws + WS_WBM), nullptr, 2048, DM, 0, 0, r}; break; } r -= IT_BR; \
            if (r < IT_WO) { d_ = CvtDesc{A->in[I_WO], (bf16*)(ws + WS_WO), nullptr, DM, DM, 0, 0, r}; break; } r -= IT_WO; \
            if (r < IT_FG) { d_ = CvtDesc{A->in[I_W2G], (bf16*)(ws + WS_W2GU), A->in[I_N2], DM, DFF, 0, 1, r}; break; } r -= IT_FG; \
            if (r < IT_FG) { d_ = CvtDesc{A->in[I_W2U], (bf16*)(ws + WS_W2GU), A->in[I_N2], DM, DFF, 0, 2, r}; break; } r -= IT_FG; \
            d_ = CvtDesc{A->in[I_W2D], (bf16*)(ws + WS_W2D), nullptr, DFF, DM, -1, 0, r}; } while (0)
#define CVT_RUN(first_, last_, stride_) do { int it_ = (first_); if (it_ < (last_)) { CvtDesc dA, dB; float wA[32], wB[32]; CVT_DECODE(dA, it_); cvt_load(dA, wA, lane); \
            for (;;) { const int i1_ = it_ + (stride_); const bool h1_ = i1_ < (last_); if (h1_) { CVT_DECODE(dB, i1_); cvt_load(dB, wB, lane); } cvt_finish(dA, wA, scr, lane); if (!h1_) break; \
                       const int i2_ = i1_ + (stride_); const bool h2_ = i2_ < (last_); if (h2_) { CVT_DECODE(dA, i2_); cvt_load(dA, wA, lane); } cvt_finish(dB, wB, scr, lane); if (!h2_) break; it_ = i2_; } } } while (0)
        if (!(probe_mode() & 1024)) CVT_RUN(gw, (NCONV > 0 ? NEARLY : NITEMS), NGW);
        for (int m = gw; m < INWP - INW; m += NGW) zero_row_bf16((bf16*)(ws + WS_WIN) + (size_t)(INW + m) * DM, DM, lane);
        if (!(probe_mode() & 512)) {
            f32x4 gv[16];
#pragma unroll
            for (int j = 0; j < 16; ++j) gv[j] = ((const GAS f32x4*)A->in[I_N1] + lane)[64 * j];
            for (int m = gw; m < MR; m += 2 * NGW) { const int m2 = m + NGW; const bool has2 = m2 < MR;
                const GAS f32x4* x0 = (const GAS f32x4*)(A->in[I_X] + (size_t)m * DM) + lane; const GAS f32x4* x1 = (const GAS f32x4*)(A->in[I_X] + (size_t)(has2 ? m2 : m) * DM) + lane;
                f32x4 v0[16], v1[16]; float s0 = 0.f, s1 = 0.f;
#pragma unroll
                for (int j = 0; j < 16; ++j) v0[j] = __builtin_nontemporal_load(x0 + 64 * j);
#pragma unroll
                for (int j = 0; j < 16; ++j) v1[j] = __builtin_nontemporal_load(x1 + 64 * j);
#pragma unroll
                for (int j = 0; j < 16; ++j) { s0 += (v0[j].x * v0[j].x + v0[j].y * v0[j].y) + (v0[j].z * v0[j].z + v0[j].w * v0[j].w); s1 += (v1[j].x * v1[j].x + v1[j].y * v1[j].y) + (v1[j].z * v1[j].z + v1[j].w * v1[j].w); }
                const float r0 = 1.f / sqrtf(wave_sum(s0) * (1.f / DM) + EPS), r1 = 1.f / sqrtf(wave_sum(s1) * (1.f / DM) + EPS);
                GAS v2u* o0 = (GAS v2u*)(XN + (size_t)m * DM) + lane; GAS v2u* o1 = (GAS v2u*)(XN + (size_t)m2 * DM) + lane;
#pragma unroll
                for (int j = 0; j < 16; ++j) { v2u w; w.x = pk2(v0[j].x * r0 * gv[j].x, v0[j].y * r0 * gv[j].y); w.y = pk2(v0[j].z * r0 * gv[j].z, v0[j].w * r0 * gv[j].w); o0[64 * j] = w; }
                if (has2) {
#pragma unroll
                    for (int j = 0; j < 16; ++j) { v2u w; w.x = pk2(v1[j].x * r1 * gv[j].x, v1[j].y * r1 * gv[j].y); w.y = pk2(v1[j].z * r1 * gv[j].z, v1[j].w * r1 * gv[j].w); o1[64 * j] = w; } }
            }
            for (int m = MR + gw; m < MP; m += NGW) {
                if (m < MR + NMETA) rms_row_to_bf16(A->in[I_META] + (size_t)(m - MR) * DM, A->in[I_N1], XN + (size_t)m * DM, lane);
                else zero_row_bf16(XN + (size_t)m * DM, DM, lane);
            }
        }
        {
            static constexpr double INVF[32] = {1.0, 0.7498942093324559, 0.5623413251903491, 0.4216965034285822, 0.31622776601683794, 0.23713737056616552, 0.1778279410038923, 0.1333521432163324,
                0.1, 0.07498942093324558, 0.05623413251903491, 0.042169650342858224, 0.03162277660168379, 0.023713737056616554, 0.01778279410038923, 0.01333521432163324,
                0.01, 0.007498942093324558, 0.005623413251903491, 0.004216965034285823, 0.0031622776601683794, 0.0023713737056616554, 0.0017782794100389228, 0.001333521432163324,
                0.001, 0.0007498942093324559, 0.0005623413251903491, 0.00042169650342858224, 0.00031622776601683794, 0.00023713737056616554, 0.00017782794100389227, 0.0001333521432163324};
            for (int idx = (vcu * NWAVES + wave) * 64 + lane; idx < (SEQ + NMETA) * 32; idx += NGW * 64) {
                const int pos = idx >> 5, i = idx & 31; double rev = (double)pos * INVF[i] * 0.15915494309189535; rev -= __builtin_floor(rev);
                const float fr = (float)rev; ROPE[2 * idx] = __builtin_amdgcn_cosf(fr); ROPE[2 * idx + 1] = __builtin_amdgcn_sinf(fr);
            }
        }
        if (BOTH(0)) GRID_BAR();
    }

    if (IN(1)) { PHASE_PTRS();
        if (NCONV > 0 && G > 2 * NCONV && bx >= G - NCONV) {
            LAS float* scr = (LAS float*)(L + RING_OFF + wave * 16384);
            CVT_RUN(NEARLY + (bx - (G - NCONV)) * NWAVES + wave, NITEMS, NCONV * NWAVES);
        } else {
            const int Gg = (NCONV > 0 && G > 2 * NCONV) ? G - NCONV : G;
            pg8::EpiSwiglu E{(pbf*)HB, 0, nullptr}; pg8::Gemm g_{(const pbf*)XN, (const pbf*)(ws + WS_W1GU), MP, 2 * DFF, DM, DM, DM, 0};
            pg8::StaticOrder S_; S_.init(MP, 2 * DFF, DM, Gg, bx, 0, 8); pg8::gemm_phase<pg8::EpiSwiglu, pg8::StaticOrder, PG8_ALIGNV, PG8_SP2V>(L + RING_OFF, g_, S_, E);
        }
        if (BOTH(1)) GRID_BAR(); }
#undef CVT_RUN
#undef CVT_DECODE
    if (IN(2)) { PHASE_PTRS(); pg8::EpiResid E{A->in[I_X], out, SLAB, (pbf*)XN, PART, 0.5f}; STAGGER(); GEMM_PHASE_BLK(pg8::EpiResid, HB, ws + WS_W1D, MR, DM, DFF, E, 16, WGM_DOWN); if (BOTH(2)) GRID_BAR(); }
    if (IN(3)) { PHASE_PTRS(); float* const ssq = (float*)(ctl + CW_SSQ1);
        for (int m = gw; m < MR; m += NGW) { const float q = wave_sum(PART[(size_t)m * 64 + lane]); if (lane == 0) ssq[m] = q; }
        if (gw >= NGW - NMETA) { const int r = gw - (NGW - NMETA); const GAS f32x4* xr = (const GAS f32x4*)(A->in[I_META] + (size_t)r * DM) + lane; GAS v2u* o8 = (GAS v2u*)(XN + (size_t)(MR + r) * DM) + lane; float q = 0.f;
            for (int j = 0; j < 16; ++j) { f32x4 v = xr[64 * j];
                for (int sp = 0; sp < 16; ++sp) v = v + ((const GAS f32x4*)(SLAB + ((size_t)sp * NMETA + r) * DM) + lane)[64 * j];
                q += (v.x * v.x + v.y * v.y) + (v.z * v.z + v.w * v.w); v2u w; w.x = pk2(v.x, v.y); w.y = pk2(v.z, v.w); o8[64 * j] = w; }
            q = wave_sum(q); if (lane == 0) ssq[MR + r] = q; }
        if (BOTH(3)) GRID_BAR();
    }
    if (IN(4)) { PHASE_PTRS(); pg8::EpiB<pg8::MB_WIN> E{(pbf*)PB, INWP, nullptr, nullptr, nullptr, ROPE, (const float*)(ctl + CW_SSQ1)}; GEMM_PHASE(pg8::EpiB<pg8::MB_WIN>, XN, ws + WS_WIN, MP, INWP, DM, DM, DM, E); if (BOTH(4)) GRID_BAR(); }
    if (IN(5)) { PHASE_PTRS();
        for (int w = gw; w < MR / 8 + 256; w += NGW) {
        float qmx[4] = {0.f, 0.f, 0.f, 0.f}, kmx[4] = {0.f, 0.f, 0.f, 0.f};
        const bool meta = w >= MR / 8; const int nrows = meta ? 1 : 8;
        for (int it = 0; it < nrows; ++it) {
            const int m = meta ? MR + (w - MR / 8) : w * 8 + it;
            const bf16* prow = PB + (size_t)m * INWP;
            {   const v4u a = *(const GAS v4u*)(prow + PC_CQ + 8 * lane), b = *(const GAS v4u*)(prow + PC_CQ + 512 + 8 * lane);
                float x[16] = {bflo(a.x), bfhi(a.x), bflo(a.y), bfhi(a.y), bflo(a.z), bfhi(a.z), bflo(a.w), bfhi(a.w), bflo(b.x), bfhi(b.x), bflo(b.y), bfhi(b.y), bflo(b.z), bfhi(b.z), bflo(b.w), bfhi(b.w)};
                float s = 0.f;
#pragma unroll
                for (int j = 0; j < 16; ++j) s += x[j] * x[j];
                const float rstd = 1.f / sqrtf(wave_sum(s) * (1.f / 1024.f) + EPS);
                const float* g = A->in[I_QNORM];
#pragma unroll
                for (int hseg = 0; hseg < 2; ++hseg) { const f32x4 g0 = *(const GAS f32x4*)(g + hseg * 512 + 8 * lane), g1 = *(const GAS f32x4*)(g + hseg * 512 + 8 * lane + 4); const float* xx = x + 8 * hseg;
                    v4u o; o.x = pk2(xx[0] * rstd * g0.x, xx[1] * rstd * g0.y); o.y = pk2(xx[2] * rstd * g0.z, xx[3] * rstd * g0.w); o.z = pk2(xx[4] * rstd * g1.x, xx[5] * rstd * g1.y); o.w = pk2(xx[6] * rstd * g1.z, xx[7] * rstd * g1.w);
                    *(GAS v4u*)(CQN + (size_t)m * 1024 + hseg * 512 + 8 * lane) = o; } }
            {   const v4u a = *(const GAS v4u*)(prow + PC_CKV + 8 * lane);
                float x[8] = {bflo(a.x), bfhi(a.x), bflo(a.y), bfhi(a.y), bflo(a.z), bfhi(a.z), bflo(a.w), bfhi(a.w)};
                float s = 0.f;
#pragma unroll
                for (int j = 0; j < 8; ++j) s += x[j] * x[j];
                const float rstd = 1.f / sqrtf(wave_sum(s) * (1.f / 512.f) + EPS);
                const float* g = A->in[I_KVNORM];
                const f32x4 g0 = *(const GAS f32x4*)(g + 8 * lane), g1 = *(const GAS f32x4*)(g + 8 * lane + 4);
                v4u o; o.x = pk2(x[0] * rstd * g0.x, x[1] * rstd * g0.y); o.y = pk2(x[2] * rstd * g0.z, x[3] * rstd * g0.w); o.z = pk2(x[4] * rstd * g1.x, x[5] * rstd * g1.y); o.w = pk2(x[6] * rstd * g1.z, x[7] * rstd * g1.w);
                *(GAS v4u*)(CKVN + (size_t)m * 512 + 8 * lane) = o; }
            if (m < MR + NMETA) {
#pragma unroll
                for (int j = 0; j < 4; ++j) {
                    const v4u a = *(const GAS v4u*)(prow + PC_DQ + 512 * j + 8 * lane), b = *(const GAS v4u*)(prow + PC_DK + 512 * j + 8 * lane);
                    float sq = (bflo(a.x) * bflo(a.x) + bfhi(a.x) * bfhi(a.x)) + (bflo(a.y) * bflo(a.y) + bfhi(a.y) * bfhi(a.y)) + (bflo(a.z) * bflo(a.z) + bfhi(a.z) * bfhi(a.z)) + (bflo(a.w) * bflo(a.w) + bfhi(a.w) * bfhi(a.w));
                    float sk = (bflo(b.x) * bflo(b.x) + bfhi(b.x) * bfhi(b.x)) + (bflo(b.y) * bflo(b.y) + bfhi(b.y) * bfhi(b.y)) + (bflo(b.z) * bflo(b.z) + bfhi(b.z) * bfhi(b.z)) + (bflo(b.w) * bflo(b.w) + bfhi(b.w) * bfhi(b.w));
#pragma unroll
                    for (int o = 1; o < 16; o <<= 1) { sq += __shfl_xor(sq, o); sk += __shfl_xor(sk, o); }
                    if (!meta) { qmx[j] = fmaxf(qmx[j], sq); kmx[j] = fmaxf(kmx[j], sk); }
                    else if ((lane & 15) == 0) atomicMax((unsigned*)(ctl + CW_KMETA) + (lane >> 4) + 4 * j, __float_as_uint(sk));
                }
            }
        }
        if (!meta && (lane & 15) == 0) { const int r0 = w * 8, b = r0 >> 12, qb = (r0 & (SEQ - 1)) >> 8;
#pragma unroll
            for (int j = 0; j < 4; ++j) { const int g = (lane >> 4) + 4 * j;
                atomicMax((unsigned*)(ctl + CW_QMAX) + (b * 16 + qb) * 16 + g, __float_as_uint(qmx[j])); atomicMax((unsigned*)(ctl + CW_KMAX) + b * 16 + g, __float_as_uint(kmx[j])); } }
        }
        if (BOTH(5)) GRID_BAR();
    }
    if (IN(6)) { PHASE_PTRS();
        { pg8::EpiB<pg8::MB_QUP> E{(pbf*)QM, 3072, nullptr, nullptr, nullptr, ROPE, nullptr}; GEMM_PHASE(pg8::EpiB<pg8::MB_QUP>, CQN, ws + WS_WUQ, MR, 3072, 1024, 1024, 1024, E); }
        { pg8::EpiB<pg8::MB_PLAIN> E{(pbf*)KV, 4096, nullptr, nullptr, nullptr, nullptr, nullptr}; GEMM_PHASE(pg8::EpiB<pg8::MB_PLAIN>, CKVN, ws + WS_WUKV, MP, 4096, 512, 512, 512, E); }
        if (BOTH(6)) GRID_BAR();
    }
    if (IN(7)) { PHASE_PTRS();
        char* const al = (char*)lds + RING_OFF; int atid = threadIdx.x; asm volatile("" : "+v"(atid));
#ifndef ATT_NO_DIFF
#ifndef DIFF_B
#define DIFF_B 1
#endif
#if DIFF_B
        if (A->att_mask & 1) for (int Lu = vcu; Lu < 1024; Lu += G) {
            const int i = Lu >> 8, x = (Lu >> 5) & 7, j = Lu & 31, b = x >> 1, h = ((0x4370 >> (4 * i)) & 15) ^ (x & 1), c = j >> 4, qb = ((j & 15) + 4 * i) & 15;
#else
        if (A->att_mask & 1) for (int Lu = vcu; Lu < 2048; Lu += G) {
            const int i = Lu >> 8, x = (Lu >> 5) & 7, j = Lu & 31, b = x >> 1, h = ((0x4370 >> (4 * (i >> 1))) & 15) ^ (x & 1), c = i & 1, vh = j >> 4, qb = ((j & 15) + 2 * i) & 15;
#endif
            const size_t qrow = (size_t)b * SEQ + (size_t)qb * 256;
            const float sl2 = __builtin_amdgcn_exp2f(-(float)(h + 1)) * 1.4426950408889634f;
            const int g = 2 * h + c; const float qm = __uint_as_float(ctl[CW_QMAX + (b * 16 + qb) * 16 + g]), km = __uint_as_float(ctl[CW_KMAX + b * 16 + g]), kmt = __uint_as_float(ctl[CW_KMETA + g]);
            const float Wf = ((sqrtf(qm * km) + sqrtf(qm * kmt)) * 1.01f + 163.f) / sl2;
            int t_lo = 1, t_hi = 64;
            if (Wf < 8192.f) { const int W = (int)Wf + 1, klo = qb * 256 - W, khi = qb * 256 + 255 + W; t_lo = klo <= 0 ? 1 : (klo >> 6) + 1; t_hi = khi >= SEQ ? 64 : (khi >> 6) + 1;
                if (((t_hi - t_lo) & 1) == 0) { if (t_lo > 1) --t_lo; else ++t_hi; } }
#if DIFF_B
            att::attn_unit_b(PB + qrow * INWP + PC_DQ + h * 256 + c * 128, INWP, PB + PC_DK + h * 256 + c * 128, INWP, PB + PC_DV + h * 256, INWP,
                             ORAW + qrow * 4096 + c * 2048 + h * 256, 4096, b * SEQ, qb * 256, sl2, t_lo, t_hi, al, atid);
#else
            att::attn_unit<128, true, DIFF_SDEPTH>(PB + qrow * INWP + PC_DQ + h * 256 + c * 128, INWP, PB + PC_DK + h * 256 + c * 128, INWP, nullptr, 0, PB + PC_DV + h * 256 + vh * 128, INWP,
                                         ORAW + qrow * 4096 + c * 2048 + h * 256 + vh * 128, 4096, b * SEQ, qb * 256, sl2, t_lo, t_hi, al, atid);
#endif
        }
#endif
    }
    if (IN(7)) { PHASE_PTRS();
        char* const al = (char*)lds + RING_OFF; int atid = threadIdx.x; asm volatile("" : "+v"(atid));
#ifndef ATT_NO_MLA
        if (A->att_mask & 2) for (int Lu = vcu; Lu < 1024; Lu += G) {
            const int i = Lu >> 8, x = (Lu >> 5) & 7, j = Lu & 31, bh = 8 * x + 2 * i + (j >> 4), b = bh >> 4, h = bh & 15, qb = j & 15;
            const size_t qrow = (size_t)b * SEQ + (size_t)qb * 256;
#if MLA_B
            att::attn_unit_m(QM + qrow * 3072 + h * 192, 3072, KV + h * 256, 4096, PB + PC_KR, INWP, KV + h * 256 + 128, 4096, OM + qrow * 2048 + h * 128, 2048, b * SEQ, al, atid);
#else
            att::attn_unit<192, false, MLA_SDEPTH>(QM + qrow * 3072 + h * 192, 3072, KV + h * 256, 4096, PB + PC_KR, INWP, KV + h * 256 + 128, 4096,
                                                   OM + qrow * 2048 + h * 128, 2048, b * SEQ, qb * 256, 0.f, 1, 64, al, atid);
#endif
        }
#endif
        if (BOTH(7)) GRID_BAR();
    }
    if (IN(8)) { PHASE_PTRS();
        float lam;
        {   const float* q1 = A->in[I_LQ1]; const float* k1 = A->in[I_LK1]; const float* q2 = A->in[I_LQ2]; const float* k2 = A->in[I_LK2];
            const float s1 = wave_sum(q1[lane] * k1[lane] + q1[lane + 64] * k1[lane + 64]), s2 = wave_sum(q2[lane] * k2[lane] + q2[lane + 64] * k2[lane + 64]);
            lam = __builtin_amdgcn_exp2f(s1 * 1.4426950408889634f) - __builtin_amdgcn_exp2f(s2 * 1.4426950408889634f) + 0.2f; }
        const f32x4 sg = *(const GAS f32x4*)(A->in[I_SUBLN] + 4 * lane);
        for (int m = gw; m < MR; m += NGW) {
            const bf16* o1 = ORAW + (size_t)m * 4096; const bf16* o2 = o1 + 2048;
#pragma unroll 2
            for (int h = 0; h < 8; ++h) {
                const v2u a = *(const GAS v2u*)(o1 + h * 256 + 4 * lane), b = *(const GAS v2u*)(o2 + h * 256 + 4 * lane);
                const float f0 = bflo(a.x) - lam * bflo(b.x), f1 = bfhi(a.x) - lam * bfhi(b.x), f2 = bflo(a.y) - lam * bflo(b.y), f3 = bfhi(a.y) - lam * bfhi(b.y);
                const float rstd = 1.f / sqrtf(wave_sum((f0 * f0 + f1 * f1) + (f2 * f2 + f3 * f3)) * (1.f / 256.f) + EPS);
                v2u o; o.x = pk2(f0 * rstd * sg.x * 0.8f, f1 * rstd * sg.y * 0.8f); o.y = pk2(f2 * rstd * sg.z * 0.8f, f3 * rstd * sg.w * 0.8f);
                *(GAS v2u*)(OD + (size_t)m * 2048 + h * 256 + 4 * lane) = o;
            }
        }
        { pg8::EpiB<pg8::MB_GATE> E{(pbf*)GATES, 2 * DM, A->in[I_BG], nullptr, nullptr, nullptr, (const float*)(ctl + CW_SSQ1)}; GEMM_PHASE(pg8::EpiB<pg8::MB_GATE>, XN, ws + WS_WG, MR, 2 * DM, DM, DM, DM, E); }
        if (BOTH(8)) GRID_BAR();
    }
    if (IN(9)) { PHASE_PTRS(); pg8::EpiB<pg8::MB_BR1> E{(pbf*)T1, DM, nullptr, (const pbf*)GATES, nullptr, nullptr, nullptr}; GEMM_PHASE(pg8::EpiB<pg8::MB_BR1>, OD, ws + WS_WBD, MR, DM, 2048, 2048, 2048, E); }
    if (IN(10)) { PHASE_PTRS(); pg8::EpiB<pg8::MB_BR2> E{(pbf*)MERGED, DM, nullptr, (const pbf*)GATES, (const pbf*)T1, nullptr, nullptr}; GEMM_PHASE(pg8::EpiB<pg8::MB_BR2>, OM, ws + WS_WBM, MR, DM, 2048, 2048, 2048, E); if (BOTH(10)) GRID_BAR(); }
    if (IN(11)) { PHASE_PTRS(); pg8::EpiResid E{out, out, SLAB, (pbf*)XN, PART, 1.0f}; STAGGER(); GEMM_PHASE(pg8::EpiResid, MERGED, ws + WS_WO, MR, DM, DM, DM, DM, E); if (BOTH(11)) GRID_BAR(); }
    if (IN(12)) { PHASE_PTRS(); float* const ssq = (float*)(ctl + CW_SSQ2);
        for (int m = gw; m < MR; m += NGW) { const float q = wave_sum(PART[(size_t)m * 64 + lane]); if (lane == 0) ssq[m] = q; }
        if (BOTH(12)) GRID_BAR();
    }
    if (IN(13)) { PHASE_PTRS(); pg8::EpiSwiglu E{(pbf*)HB, 0, (const float*)(ctl + CW_SSQ2)}; GEMM_PHASE(pg8::EpiSwiglu, XN, ws + WS_W2GU, MR, 2 * DFF, DM, DM, DM, E); if (BOTH(13)) GRID_BAR(); }
    if (IN(14)) { PHASE_PTRS(); pg8::EpiResid E{out, out, SLAB, nullptr, PART, 0.5f}; STAGGER(); GEMM_PHASE_BLK(pg8::EpiResid, HB, ws + WS_W2D, MR, DM, DFF, E, 0, WGM_DOWN); if (BOTH(14)) GRID_BAR(); }
    if (IN(15)) { PHASE_PTRS();
        for (int m = gw; m < MR; m += NGW) { GAS f32x4* xr = (GAS f32x4*)(out + (size_t)m * DM) + lane; const GAS f32x4* gr = (const GAS f32x4*)A->in[I_NF] + lane;
            const float rstd = 1.0f / sqrtf(wave_sum(PART[(size_t)m * 64 + lane]) * (1.0f / DM) + EPS);
#pragma unroll
            for (int j = 0; j < 16; ++j) xr[64 * j] = xr[64 * j] * rstd * gr[64 * j]; }
    }
#undef IN
#undef BOTH
#undef GRID_BAR
#undef GEMM_PHASE
}

#define FWD_MAIN fwd
#define FWD_PROBE fwd
#define FWD_IS_PROBE(li) false
extern "C" void kernel_launch(void* const* d_in, const int* in_sizes, int n_in, void* d_out, int out_size, void* d_ws, size_t ws_size, hipStream_t stream) {
    static int grid = 0;
    if (grid == 0) {
        if (n_in != 27 || in_sizes[0] != MR * DM || out_size != MR * DM || ws_size < WS_END) {
            fprintf(stderr, "kernel_launch: built for 27 inputs, x/out of %d floats, >= %zu bytes of workspace; got n_in %d, in0 %d, out %d, ws %zu; nothing launched\n", MR * DM, (size_t)WS_END, n_in, n_in > 0 ? in_sizes[0] : -1, out_size, ws_size);
            grid = -1; return; }
        int dev = 0, cus = 0, per_cu = 0;
        if (hipGetDevice(&dev) != hipSuccess || hipDeviceGetAttribute(&cus, hipDeviceAttributeMultiprocessorCount, dev) != hipSuccess) { fprintf(stderr, "kernel_launch: device query failed\n"); grid = -1; return; }
        if (hipFuncSetAttribute((const void*)FWD_MAIN, hipFuncAttributeMaxDynamicSharedMemorySize, LDS_BYTES) != hipSuccess || hipFuncSetAttribute((const void*)FWD_PROBE, hipFuncAttributeMaxDynamicSharedMemorySize, LDS_BYTES) != hipSuccess) { fprintf(stderr, "kernel_launch: hipFuncSetAttribute failed\n"); grid = -1; return; }
        if (hipOccupancyMaxActiveBlocksPerMultiprocessor(&per_cu, (const void*)FWD_MAIN, NWAVES * 64, LDS_BYTES) != hipSuccess || per_cu < 1)
            fprintf(stderr, "kernel_launch: note: occupancy query reports %d workgroups per CU\n", per_cu);
        (void)hipGetLastError();
        grid = cus;
    }
    if (grid < 0) return;
    if (hipMemsetAsync((char*)d_ws + WS_CTL, 0, CTL_ZERO_BYTES, stream) != hipSuccess) { fprintf(stderr, "kernel_launch: memset failed\n"); return; }
    Args a{};
    for (int i = 0; i < 27; ++i) a.in[i] = (const float*)d_in[i];
    a.out = (float*)d_out; a.ws = (unsigned char*)d_ws; a.att_mask = 3; a.pad = 0;
#ifdef PROBE_DUP
    const int cuts[4] = {0, PROBE_DUP + 1, PROBE_DUP + 1, NPH}; const int nl = (PROBE_DUP + 1 < NPH) ? 3 : 2;
    for (int li = 0; li < nl; ++li) {
        a.ph_lo = li == 1 ? PROBE_DUP : cuts[li]; a.ph_hi = cuts[li + 1];
#ifdef PROBE_ATT_MASK
        a.att_mask = li == 1 ? PROBE_ATT_MASK : 3;
#endif
#else
    for (int li = 0; li < N_LAUNCHES; ++li) {
        a.ph_lo = (N_LAUNCHES == 1) ? 0 : li * NPH / N_LAUNCHES; a.ph_hi = (N_LAUNCHES == 1) ? NPH : (li + 1) * NPH / N_LAUNCHES;
#endif
        { void* kargs_[] = {(void*)&a}; (void)hipLaunchKernel(FWD_IS_PROBE(li) ? (const void*)FWD_PROBE : (const void*)FWD_MAIN, dim3(grid), dim3(NWAVES * 64), kargs_, LDS_BYTES, stream); }
        const hipError_t le = hipPeekAtLastError();
        if (le != hipSuccess) { fprintf(stderr, "kernel_launch: launch %d failed: %s\n", li, hipGetErrorName(le)); break; }
    }
}
```

```cpp
#include <hip/hip_runtime.h>
#include <cstdio>
#include <cstdint>

constexpr int DM = 4096, BATCH = 4, SEQ = 4096, NMETA = 16, DFF = 11008;
#ifndef LDH_PAD
#define LDH_PAD 64
#endif
constexpr int LDH = DFF + LDH_PAD;
constexpr int MR = BATCH * SEQ;
constexpr int MP = MR + 256;
constexpr int INW = 7744, INWP = 7936;
constexpr int PC_DQ = 0, PC_DK = 2048, PC_DV = 4096, PC_CQ = 6144, PC_CKV = 7168, PC_KR = 7680;
constexpr float EPS = 1e-6f;
constexpr float QSCALE_DIFF = 0.12751743082459868f;
constexpr float QSCALE_MLA = 0.10411754627697264f;
#ifndef MLA_B
#define MLA_B 1
#endif
constexpr bool QUP_PRESCALE = MLA_B != 0;

#ifndef PROBE_MODE_CONST
#define PROBE_MODE_CONST 0
#endif
__device__ __forceinline__ constexpr int probe_mode() { return PROBE_MODE_CONST; }
namespace pg8 {
#define PG8_LAS __attribute__((address_space(3)))
typedef unsigned short bf16_t;
typedef short bf16x8 __attribute__((ext_vector_type(8)));
typedef float f32x4 __attribute__((ext_vector_type(4)));
typedef unsigned u32x4 __attribute__((ext_vector_type(4)));
constexpr int BM = 256, BK = 64, HALF = 128, HTB = HALF * BK * 2  , STAGE_BYTES = 8 * HTB, NXCD = 8;

__host__ __device__ __forceinline__ int lds_byte(int r, int c) { const int st = (r >> 4) * 2 + (c >> 5), rr = r & 15, cc = c & 31, ob = rr * 64 + cc * 2; return st * 1024 + (ob ^ (((ob >> 9) & 1) << 5)); }
__host__ __device__ __forceinline__ void stage_rc(int b, int& R, int& C) { const int st = b / 1024, sb = b % 1024, swz = sb ^ (((sb >> 9) & 1) << 5); R = (st >> 1) * 16 + swz / 64; C = (st & 1) * 32 + (swz % 64) / 2; }
__host__ __device__ __forceinline__ int perm32(int rho) { const int n = rho >> 4, i = rho & 15; return 8 * (i >> 2) + 4 * n + (i & 3); }

struct Unit { int pm, pn, kt0, nkt, sp; };
struct Gemm { const bf16_t* A; const bf16_t* Bt; int M, N, K, lda, ldb, blk; };

#ifndef SPLIT_FIRST_ODD
#define SPLIT_FIRST_ODD 0
#endif
struct StaticOrder {
    int nM, nN, nwg, G, c, nkt, nsplit, WGM;
    __host__ __device__ void init(int M, int N, int K, int G_, int c_, int nsplit_ = 0, int wgm_ = 8) { nM = M / BM; nN = N / BM; nwg = nM * nN; G = G_; c = c_; nkt = K / BK; nsplit = nsplit_; WGM = wgm_; }
    __host__ __device__ bool next(int i, Unit& u) const {
        const bool sfirst = SPLIT_FIRST_ODD && nsplit * nN == G && (c & 1);
        long L = (long)(sfirst ? i - 1 : i) * G + c;
        if (sfirst && i == 0) L = (long)nwg + c;
        else if (sfirst && L >= nwg) return false;
        if (L >= nwg) { const int e = (int)(L - nwg); if (e >= nsplit * nN) return false;
            const int s = e / nN, trips = nkt / 2, qd = trips / nsplit, rm = trips % nsplit;
            u.pm = nM; u.pn = e % nN; u.kt0 = 2 * (s * qd + (s < rm ? s : rm)); u.nkt = 2 * (qd + (s < rm ? 1 : 0)); u.sp = s; return true; }
        int wgid = (int)L; { const int q = nwg / NXCD, r = nwg % NXCD, xcd = wgid % NXCD, off = wgid / NXCD; wgid = (xcd < r ? xcd * (q + 1) : r * (q + 1) + (xcd - r) * q) + off; }
        const int nig = WGM * nN, gid = wgid / nig, fm = gid * WGM, gsz = (nM - fm) < WGM ? (nM - fm) : WGM;
        u.pm = fm + ((wgid % nig) % gsz); u.pn = (wgid % nig) / gsz; u.kt0 = 0; u.nkt = nkt; u.sp = 0; return true;
    }
    __device__ __forceinline__ void a_ready(const Unit&) const {}
    __device__ __forceinline__ void done(const Unit&) const {}
};

__device__ __forceinline__ unsigned cvt_pk_bf16(float lo, float hi) { unsigned r; asm volatile("v_cvt_pk_bf16_f32 %0, %1, %2" : "=v"(r) : "v"(lo), "v"(hi)); return r; }
__device__ __forceinline__ u32x4 pack8(const f32x4& a, const f32x4& b) { u32x4 w; w.x = cvt_pk_bf16(a[0], a[1]); w.y = cvt_pk_bf16(a[2], a[3]); w.z = cvt_pk_bf16(b[0], b[1]); w.w = cvt_pk_bf16(b[2], b[3]); return w; }
__device__ __forceinline__ void unpack8(const u32x4& w, f32x4& a, f32x4& b) {
    a[0] = __uint_as_float(w.x << 16); a[1] = __uint_as_float(w.x & 0xffff0000u); a[2] = __uint_as_float(w.y << 16); a[3] = __uint_as_float(w.y & 0xffff0000u);
    b[0] = __uint_as_float(w.z << 16); b[1] = __uint_as_float(w.z & 0xffff0000u); b[2] = __uint_as_float(w.w << 16); b[3] = __uint_as_float(w.w & 0xffff0000u); }
__device__ __forceinline__ float row_rstd(const float* ssq, int row) { return 1.0f / sqrtf(ssq[row] * (1.0f / DM) + EPS); }
__device__ __forceinline__ float sigmoidf_fast(float x) { return __builtin_amdgcn_rcpf(1.0f + __builtin_amdgcn_exp2f(-1.4426950408889634f * x)); }

__device__ __forceinline__ void touch_line(unsigned& d, const void* p) { asm volatile("global_load_dword %0, %1, off" : "=v"(d) : "v"(p) : "memory"); }
struct EpiSwiglu {
    static constexpr bool PERM = true, AFTER_DRAIN = false;
    __device__ __forceinline__ void init(f32x4 (&acc)[2][2][4][2], const Unit&, int, int, int, int) const {
#pragma unroll
        for (int a = 0; a < 2; ++a)
#pragma unroll
            for (int b = 0; b < 2; ++b)
#pragma unroll
                for (int m = 0; m < 4; ++m)
#pragma unroll
                    for (int n = 0; n < 2; ++n) acc[a][b][m][n] = (f32x4){0.f, 0.f, 0.f, 0.f};
    }
    __device__ __forceinline__ unsigned prefetch(const Unit&, int) const { return 0u; }
    __device__ __forceinline__ unsigned prefetch_next(const Unit&, int) const { return 0u; }
    bf16_t* H; int ldh; const float* ssq;
    __device__ __forceinline__ void operator()(const f32x4 (&acc)[2][2][4][2], const Unit& u, int wr, int wc, int fr, int fq) const {
        const int row0 = u.pm * BM + wr * 64 + fr, col0 = u.pn * HALF + wc * 32 + 8 * fq;
#pragma unroll
        for (int ai = 0; ai < 2; ++ai)
#pragma unroll
            for (int m = 0; m < 4; ++m) {
                const float rs = ssq ? row_rstd(ssq, row0 + ai * HALF + m * 16) : 1.f;
                f32x4 h[2];
#pragma unroll
                for (int n = 0; n < 2; ++n) { const f32x4 g = acc[ai][0][m][n] * rs, up = acc[ai][1][m][n] * rs;
#pragma unroll
                    for (int j = 0; j < 4; ++j) h[n][j] = g[j] * sigmoidf_fast(g[j]) * up[j]; }
                if (probe_mode() & 1) { asm volatile("" :: "v"(h[0]), "v"(h[1])); }
                else if (ldh) *(u32x4*)(H + (size_t)(row0 + ai * HALF + m * 16) * ldh + col0) = pack8(h[0], h[1]);
                else { const int rt = wr * 64 + fr + ai * HALF + m * 16;
                    *(u32x4*)(H + (((size_t)u.pm * (DFF / 64) + 2 * u.pn + (wc >> 1)) * 256 + rt) * 64 + (wc & 1) * 32 + 8 * fq) = pack8(h[0], h[1]); }
            }
    }
};
#ifndef EPI_NT
#define EPI_NT 0
#endif
#if EPI_NT
#define EPI_ST(p, v) __builtin_nontemporal_store((v), (p))
#else
#define EPI_ST(p, v) (*(p) = (v))
#endif
#ifndef RES_PREFETCH
#define RES_PREFETCH 0
#endif
struct EpiResid {
    static constexpr bool PERM = false, AFTER_DRAIN = false;
    __device__ __forceinline__ unsigned prefetch(const Unit&, int) const { return 0u; }
    __device__ __forceinline__ unsigned prefetch_next(const Unit& u, int tid) const {
        unsigned v = 0u;
        if (RES_PREFETCH && u.pm < MR / BM) {
#pragma unroll
            for (int i = 0; i < 4; ++i) { const int ln = tid + 512 * i, r = ln >> 3, c = (ln & 7) * 32; touch_line(v, res + ((size_t)u.pm * BM + r) * DM + u.pn * BM + c); } }
        return v;
    }
    const float* res; float* out; float* slab; bf16_t* xn; float* part; float alpha;
    __device__ __forceinline__ void init(f32x4 (&acc)[2][2][4][2], const Unit& u, int wr, int wc, int fr, int fq) const {
        const float ia = 1.0f / alpha;
        if (u.pm < MR / BM && !(probe_mode() & 2)) {
            const float* rb = res + ((size_t)u.pm * BM + wr * 64 + fr) * DM + u.pn * BM + wc * 32 + 4 * fq;
#pragma unroll
            for (int ai = 0; ai < 2; ++ai)
#pragma unroll
                for (int m = 0; m < 4; ++m)
#pragma unroll
                    for (int bj = 0; bj < 2; ++bj)
#pragma unroll
                        for (int n = 0; n < 2; ++n) acc[ai][bj][m][n] = *(const f32x4*)(rb + (size_t)(ai * HALF + m * 16) * DM + bj * HALF + n * 16) * ia;
        } else {
#pragma unroll
            for (int ai = 0; ai < 2; ++ai)
#pragma unroll
                for (int m = 0; m < 4; ++m)
#pragma unroll
                    for (int bj = 0; bj < 2; ++bj)
#pragma unroll
                        for (int n = 0; n < 2; ++n) acc[ai][bj][m][n] = (f32x4){0.f, 0.f, 0.f, 0.f};
        }
    }
    __device__ __forceinline__ void operator()(const f32x4 (&acc)[2][2][4][2], const Unit& u, int wr, int wc, int fr, int fq) const {
        const int col0 = u.pn * BM + wc * 32 + 4 * fq;
        if (probe_mode() & 1) { _Pragma("unroll") for (int a = 0; a < 2; ++a) _Pragma("unroll") for (int b = 0; b < 2; ++b) _Pragma("unroll") for (int m = 0; m < 4; ++m) _Pragma("unroll") for (int n = 0; n < 2; ++n) asm volatile("" :: "v"(acc[a][b][m][n])); return; }
        if (u.pm >= MR / BM) {
            if (wr == 0) { float* ob = slab + ((size_t)u.sp * NMETA + fr) * DM + col0;
#pragma unroll
                for (int bj = 0; bj < 2; ++bj)
#pragma unroll
                    for (int n = 0; n < 2; ++n) *(f32x4*)(ob + bj * HALF + n * 16) = alpha * acc[0][bj][0][n]; }
            return; }
        float* ob = out + (size_t)u.pm * BM * DM;
#pragma unroll
        for (int ai = 0; ai < 2; ++ai)
#pragma unroll
            for (int m = 0; m < 4; ++m) { const int rowt = ai * HALF + wr * 64 + m * 16 + fr; const size_t off = (size_t)rowt * DM + col0; float q = 0.f;
#pragma unroll
                for (int bj = 0; bj < 2; ++bj)
#pragma unroll
                    for (int n = 0; n < 2; ++n) { const f32x4 v = alpha * acc[ai][bj][m][n]; EPI_ST((f32x4*)(ob + off + bj * HALF + n * 16), v);
                        q += (v[0] * v[0] + v[1] * v[1]) + (v[2] * v[2] + v[3] * v[3]);
                        if (xn) { typedef unsigned u32x2 __attribute__((ext_vector_type(2))); u32x2 w; w.x = cvt_pk_bf16(v[0], v[1]); w.y = cvt_pk_bf16(v[2], v[3]); EPI_ST((u32x2*)(xn + (size_t)u.pm * BM * DM + off + bj * HALF + n * 16), w); } }
                if (part) { q += __shfl_xor(q, 16); q += __shfl_xor(q, 32); if (fq == 0) part[(size_t)(u.pm * BM + rowt) * 64 + u.pn * 4 + wc] = q; }
                if (m & 1) asm volatile("" ::: "memory"); }
    }
};
enum { MB_PLAIN = 0, MB_WIN = 1, MB_QUP = 2, MB_GATE = 3, MB_BR1 = 4, MB_BR2 = 5 };
__device__ __forceinline__ void rope8(f32x4& v0, f32x4& v1, const float* cs) {
    const f32x4 c01 = *(const f32x4*)cs, c23 = *(const f32x4*)(cs + 4);
    const f32x4 a = v0, b = v1;
    v0[0] = a[0] * c01[0] - a[1] * c01[1]; v0[1] = a[0] * c01[1] + a[1] * c01[0]; v0[2] = a[2] * c01[2] - a[3] * c01[3]; v0[3] = a[2] * c01[3] + a[3] * c01[2];
    v1[0] = b[0] * c23[0] - b[1] * c23[1]; v1[1] = b[0] * c23[1] + b[1] * c23[0]; v1[2] = b[2] * c23[2] - b[3] * c23[3]; v1[3] = b[2] * c23[3] + b[3] * c23[2];
}
template <int MODE> struct EpiB {
    static constexpr bool PERM = true, AFTER_DRAIN = false;
    __device__ __forceinline__ void init(f32x4 (&acc)[2][2][4][2], const Unit&, int, int, int, int) const {
#pragma unroll
        for (int a = 0; a < 2; ++a)
#pragma unroll
            for (int b = 0; b < 2; ++b)
#pragma unroll
                for (int m = 0; m < 4; ++m)
#pragma unroll
                    for (int n = 0; n < 2; ++n) acc[a][b][m][n] = (f32x4){0.f, 0.f, 0.f, 0.f};
    }
    __device__ __forceinline__ unsigned prefetch_next(const Unit&, int) const { return 0u; }
    __device__ __forceinline__ unsigned prefetch(const Unit& u, int tid) const {
        unsigned v = 0u;
        if (MODE == MB_BR1 || MODE == MB_BR2) {
#pragma unroll
            for (int i = 0; i < 2; ++i) { const int ln = tid + 512 * i, r = ln >> 2, c = (ln & 3) * 64; const size_t row = (size_t)u.pm * BM + r; const int col = u.pn * BM + c;
                touch_line(v, G + row * (2 * DM) + (MODE == MB_BR2 ? DM : 0) + col);
                if (MODE == MB_BR2) touch_line(v, T1 + row * DM + col); } }
        return v;
    }
    bf16_t* O; int ldc; const float* bias; const bf16_t* G; const bf16_t* T1; const float* rope; const float* ssq;
    __device__ __forceinline__ void operator()(const f32x4 (&acc)[2][2][4][2], const Unit& u, int wr, int wc, int fr, int fq) const {
        const int row0 = u.pm * BM + wr * 64 + fr, colt = u.pn * BM + wc * 32 + 8 * fq;
#pragma unroll
        for (int ai = 0; ai < 2; ++ai)
#pragma unroll
            for (int m = 0; m < 4; ++m) { const int row = row0 + ai * HALF + m * 16;
                const int pos = row < MR ? NMETA + (row & (SEQ - 1)) : (row - MR);
                const float rs = ssq ? row_rstd(ssq, row) : 1.f;
#pragma unroll
                for (int bj = 0; bj < 2; ++bj) { const int col0 = colt + bj * HALF; f32x4 v0 = acc[ai][bj][m][0] * rs, v1 = acc[ai][bj][m][1] * rs;
                    if (MODE == MB_WIN) { if (col0 < PC_DK) { v0 = v0 * QSCALE_DIFF; v1 = v1 * QSCALE_DIFF; }
                        if (col0 >= PC_KR && col0 < INW) rope8(v0, v1, rope + ((size_t)pos * 32 + ((col0 - PC_KR) >> 1)) * 2); }
                    if (MODE == MB_QUP) { if (QUP_PRESCALE) { v0 = v0 * QSCALE_MLA; v1 = v1 * QSCALE_MLA; }
                        const int d0 = col0 % 192; if (d0 >= 128) rope8(v0, v1, rope + ((size_t)pos * 32 + ((d0 - 128) >> 1)) * 2); }
                    if (MODE == MB_GATE) { const f32x4 b0 = *(const f32x4*)(bias + col0), b1 = *(const f32x4*)(bias + col0 + 4);
#pragma unroll
                        for (int j = 0; j < 4; ++j) { v0[j] = sigmoidf_fast(v0[j] + b0[j]); v1[j] = sigmoidf_fast(v1[j] + b1[j]); } }
                    if (MODE == MB_BR1) { f32x4 g0, g1; unpack8(*(const u32x4*)(G + (size_t)row * (2 * DM) + col0), g0, g1); v0 = v0 * g0; v1 = v1 * g1; }
                    if (MODE == MB_BR2) { f32x4 g0, g1, t0, t1; unpack8(*(const u32x4*)(G + (size_t)row * (2 * DM) + DM + col0), g0, g1); unpack8(*(const u32x4*)(T1 + (size_t)row * DM + col0), t0, t1);
                        v0 = t0 + v0 * g0; v1 = t1 + v1 * g1; }
                    if (probe_mode() & 1) asm volatile("" :: "v"(v0), "v"(v1)); else *(u32x4*)(O + (size_t)row * ldc + col0) = pack8(v0, v1); } }
    }
};

template <class Epi, class Sched, bool ALIGN_EPI = false, bool SP2 = false>
__device__ __forceinline__ void gemm_phase(PG8_LAS unsigned char* lds, const Gemm g, const Sched& S, const Epi& E) {
    const int tid = threadIdx.x, wid = __builtin_amdgcn_readfirstlane(tid >> 6), lane = tid & 63, wr = wid >> 2, wc = wid & 3, fr = lane & 15, fq = lane >> 4;

    unsigned voffA[2], voffB[2];
#pragma unroll
    for (int i = 0; i < 2; ++i) { int R, C; stage_rc(tid * 16 + i * 8192, R, C); const int Rb = Epi::PERM ? ((R & ~31) + perm32(R & 31)) : R;
        voffA[i] = (unsigned)(R * g.lda + C) * 2u; voffB[i] = (unsigned)(Rb * g.ldb + C) * 2u; }
    const size_t kstep = g.blk ? (size_t)(BM * BK * 2) : (size_t)(BK * 2);
    const size_t hstepA = (size_t)HALF * g.lda * 2, hstepB = (size_t)HALF * g.ldb * 2;
    const size_t tstepA = g.blk ? (size_t)(g.K / BK) * (BM * BK * 2) : 2 * hstepA, tstepB = g.blk ? (size_t)(g.K / BK) * (BM * BK * 2) : 2 * hstepB;
    const unsigned ldsw = (unsigned)wid * 1024u;
    const int aoff = lds_byte(wr * 64 + fr, fq * 8), boff = lds_byte(wc * 32 + fr, fq * 8);
#define PG8_SA(b, h) (((b) * 2 + (h)) * HTB)
#define PG8_SB(b, h) ((4 + (b) * 2 + (h)) * HTB)
#ifndef PG8_PF_TRIPS
#define PG8_PF_TRIPS 2
#endif
#ifndef PG8_B_AUX
#define PG8_B_AUX 0
#endif
#define PG8_STAGE(bufoff, gbase, voff) do { _Pragma("unroll") for (int _i = 0; _i < 2; ++_i) { \
        if ((bufoff) >= 4 * HTB) __builtin_amdgcn_global_load_lds((const unsigned*)((const char*)(gbase) + (voff)[_i]), (PG8_LAS unsigned*)(lds + (bufoff) + ldsw + _i * 8192), 16, 0, PG8_B_AUX);     \
        else __builtin_amdgcn_global_load_lds((const unsigned*)((const char*)(gbase) + (voff)[_i]), (PG8_LAS unsigned*)(lds + (bufoff) + ldsw + _i * 8192), 16, 0, 0); } } while (0)
#define PG8_LDA(dst, b, h) do { _Pragma("unroll") for (int m = 0; m < 4; ++m) _Pragma("unroll") for (int k = 0; k < 2; ++k) dst[m][k] = *(const PG8_LAS bf16x8*)(lds + PG8_SA(b, h) + aoff + m * 2048 + k * 1024); } while (0)
#define PG8_LDB(dst, b, h) do { _Pragma("unroll") for (int n = 0; n < 2; ++n) _Pragma("unroll") for (int k = 0; k < 2; ++k) dst[n][k] = *(const PG8_LAS bf16x8*)(lds + PG8_SB(b, h) + boff + n * 2048 + k * 1024); } while (0)
#define PG8_MMA(ai, bj, At, Bt) do { __builtin_amdgcn_s_setprio(1); _Pragma("unroll") for (int m = 0; m < 4; ++m) _Pragma("unroll") for (int n = 0; n < 2; ++n) _Pragma("unroll") for (int k = 0; k < 2; ++k) \
        acc[ai][bj][m][n] = __builtin_amdgcn_mfma_f32_16x16x32_bf16(Bt[n][k], At[m][k], acc[ai][bj][m][n], 0, 0, 0); __builtin_amdgcn_s_setprio(0); } while (0)
#define PG8_WAIT_V(n) asm volatile("s_waitcnt vmcnt(" #n ")" ::: "memory")
#define PG8_WAIT_L(n) asm volatile("s_waitcnt lgkmcnt(" #n ")" ::: "memory")
#define PG8_BAR __builtin_amdgcn_s_barrier()
#define PG8_SCHED __builtin_amdgcn_sched_barrier(0)
    Unit cur, nxt; int ui = 0;
    if (!S.next(0, cur)) return;
    f32x4 acc[2][2][4][2];
    E.init(acc, cur, wr, wc, fr, fq);
    bf16x8 At[4][2], B0[2][2], B1[2][2];
    const char* cA = (const char*)g.A + (size_t)cur.pm * tstepA + (size_t)cur.kt0 * kstep; const char* cB = (const char*)g.Bt + (size_t)cur.pn * tstepB + (size_t)cur.kt0 * kstep;
    S.a_ready(cur);
    if constexpr (SP2) {
        PG8_STAGE(PG8_SB(0, 0), cB, voffB); PG8_STAGE(PG8_SB(0, 1), cB + hstepB, voffB); PG8_STAGE(PG8_SA(0, 0), cA, voffA); PG8_STAGE(PG8_SA(0, 1), cA + hstepA, voffA);
        if (wr == 1) PG8_BAR;
        PG8_WAIT_V(2); PG8_BAR;
        PG8_STAGE(PG8_SB(1, 0), cB + kstep, voffB); PG8_STAGE(PG8_SA(1, 0), cA + kstep, voffA); PG8_STAGE(PG8_SB(1, 1), cB + hstepB + kstep, voffB);
        PG8_WAIT_V(6); PG8_BAR;
    } else {
        PG8_STAGE(PG8_SB(0, 0), cB, voffB); PG8_STAGE(PG8_SA(0, 0), cA, voffA); PG8_STAGE(PG8_SB(0, 1), cB + hstepB, voffB); PG8_STAGE(PG8_SA(0, 1), cA + hstepA, voffA);
        if (wr == 1) PG8_BAR;
        PG8_WAIT_V(4); PG8_BAR;
        PG8_STAGE(PG8_SB(1, 0), cB + kstep, voffB); PG8_STAGE(PG8_SA(1, 0), cA + kstep, voffA); PG8_STAGE(PG8_SB(1, 1), cB + hstepB + kstep, voffB);
        PG8_WAIT_V(6); PG8_BAR;
    }
    for (;;) {
        const bool has_next = S.next(ui + 1, nxt);
        const char* nA = has_next ? (const char*)g.A + (size_t)nxt.pm * tstepA + (size_t)nxt.kt0 * kstep : cA; const char* nB = has_next ? (const char*)g.Bt + (size_t)nxt.pn * tstepB + (size_t)nxt.kt0 * kstep : cB;
        const int nt = cur.nkt;
        const int pf_trip = nt - 2 * PG8_PF_TRIPS >= 0 ? nt - 2 * PG8_PF_TRIPS : 0; unsigned pfv = 0u, pfv2 = 0u;
        for (int t = 0; t < nt; t += 2) {
            const bool last = (t == nt - 2);
            const char* a1 = cA + (size_t)(t + 1) * kstep;
            const char* a2 = last ? nA : cA + (size_t)(t + 2) * kstep; const char* b2 = last ? nB : cB + (size_t)(t + 2) * kstep;
            const char* a3 = a2 + kstep; const char* b3 = b2 + kstep;
            if (last && has_next) S.a_ready(nxt);
            if (t == pf_trip) { pfv = E.prefetch(cur, tid); if (has_next) pfv2 = E.prefetch_next(nxt, tid); }
            if constexpr (SP2) {
            PG8_LDB(B0, 0, 0); PG8_LDB(B1, 0, 1); PG8_SCHED; PG8_LDA(At, 0, 0); PG8_STAGE(PG8_SA(1, 1), a1 + hstepA, voffA);
            PG8_WAIT_V(8); PG8_WAIT_L(0); PG8_BAR; PG8_MMA(0, 0, At, B0); PG8_MMA(0, 1, At, B1); PG8_BAR; PG8_SCHED;
            PG8_LDA(At, 0, 1); PG8_STAGE(PG8_SB(0, 0), b2, voffB); PG8_STAGE(PG8_SB(0, 1), b2 + hstepB, voffB); PG8_STAGE(PG8_SA(0, 0), a2, voffA);
            PG8_WAIT_V(8); PG8_WAIT_L(0); PG8_BAR; PG8_MMA(1, 0, At, B0); PG8_MMA(1, 1, At, B1); PG8_BAR; PG8_SCHED;
            PG8_LDB(B0, 1, 0); PG8_LDB(B1, 1, 1); PG8_SCHED; PG8_LDA(At, 1, 0); PG8_STAGE(PG8_SA(0, 1), a2 + hstepA, voffA);
            PG8_WAIT_V(8); PG8_WAIT_L(0); PG8_BAR; PG8_MMA(0, 0, At, B0); PG8_MMA(0, 1, At, B1); PG8_BAR; PG8_SCHED;
            PG8_LDA(At, 1, 1); PG8_STAGE(PG8_SB(1, 0), b3, voffB); PG8_STAGE(PG8_SB(1, 1), b3 + hstepB, voffB); PG8_STAGE(PG8_SA(1, 0), a3, voffA);
            PG8_WAIT_V(8); PG8_WAIT_L(0); PG8_BAR; PG8_MMA(1, 0, At, B0); PG8_MMA(1, 1, At, B1); PG8_BAR; PG8_SCHED;
            } else {
            PG8_LDB(B0, 0, 0); PG8_SCHED; PG8_LDA(At, 0, 0); PG8_STAGE(PG8_SA(1, 1), a1 + hstepA, voffA);
            PG8_WAIT_L(8); PG8_BAR; PG8_WAIT_L(0); PG8_MMA(0, 0, At, B0); PG8_BAR; PG8_SCHED;
            PG8_LDB(B1, 0, 1); PG8_STAGE(PG8_SB(0, 0), b2, voffB);
            PG8_BAR; PG8_WAIT_L(0); PG8_MMA(0, 1, At, B1); PG8_BAR;
            PG8_LDA(At, 0, 1); PG8_STAGE(PG8_SA(0, 0), a2, voffA);
            PG8_BAR; PG8_WAIT_L(0); PG8_MMA(1, 0, At, B0); PG8_BAR; PG8_SCHED;
            PG8_STAGE(PG8_SB(0, 1), b2 + hstepB, voffB);
            PG8_WAIT_V(6); PG8_BAR; PG8_MMA(1, 1, At, B1); PG8_BAR;
            PG8_LDB(B0, 1, 0); PG8_SCHED; PG8_LDA(At, 1, 0); PG8_STAGE(PG8_SA(0, 1), a2 + hstepA, voffA);
            PG8_WAIT_L(8); PG8_BAR; PG8_WAIT_L(0); PG8_MMA(0, 0, At, B0); PG8_BAR; PG8_SCHED;
            PG8_LDB(B1, 1, 1); PG8_STAGE(PG8_SB(1, 0), b3, voffB);
            PG8_BAR; PG8_WAIT_L(0); PG8_MMA(0, 1, At, B1); PG8_BAR;
            PG8_LDA(At, 1, 1); PG8_STAGE(PG8_SA(1, 0), a3, voffA);
            PG8_BAR; PG8_WAIT_L(0); PG8_MMA(1, 0, At, B0); PG8_BAR; PG8_SCHED;
            PG8_STAGE(PG8_SB(1, 1), b3 + hstepB, voffB);
            PG8_WAIT_V(6); PG8_BAR; PG8_MMA(1, 1, At, B1); PG8_BAR;
            }
        }
        asm volatile("" :: "v"(pfv), "v"(pfv2));
        if constexpr (ALIGN_EPI) { if (wr == 0) PG8_BAR; }
        if constexpr (!Epi::AFTER_DRAIN) { E(acc, cur, wr, wc, fr, fq); S.done(cur); }
        if (!has_next) break;
        cur = nxt; cA = nA; cB = nB; ++ui;
        E.init(acc, cur, wr, wc, fr, fq);
        if constexpr (ALIGN_EPI) { if (wr == 1) PG8_BAR; }
    }
    PG8_WAIT_V(0);
    if constexpr (!ALIGN_EPI) { if (wr == 0) PG8_BAR; }
    PG8_BAR;
    if constexpr (Epi::AFTER_DRAIN) { E.fused(acc, cur, wr, wc, fr, fq, lds, wid, lane); S.done(cur); }
#undef PG8_SA
#undef PG8_SB
#undef PG8_STAGE
#undef PG8_LDA
#undef PG8_LDB
#undef PG8_MMA
#undef PG8_WAIT_V
#undef PG8_WAIT_L
#undef PG8_BAR
#undef PG8_SCHED
}
}

namespace att {
typedef unsigned short bf16;
using bf16x8 = __attribute__((ext_vector_type(8))) short;
using s16x4  = __attribute__((ext_vector_type(4))) short;
using f32x16 = __attribute__((ext_vector_type(16))) float;
using u32x4  = __attribute__((ext_vector_type(4))) unsigned;
constexpr int NW = 8, QBLK = 32, KVBLK = 64, NT = SEQ / KVBLK + 1;
constexpr float THR = 8.f;
constexpr int SHM_V = KVBLK * 128 * 2;
template <int DQK> constexpr int shm_k() { return KVBLK * DQK * 2; }
template <int DQK> constexpr int nqreg() { return DQK == 192 ? 6 : 8; }
template <int DQK> constexpr int shm_total() { return 2 * SHM_V + 2 * shm_k<DQK>() + NW * 64 * 4 + NW * 1024 * (DQK / 16 - nqreg<DQK>()); }
#define ATT_SBAR() __builtin_amdgcn_sched_barrier(0)
#ifndef ATT_PRIO
#define ATT_PRIO 1
#endif
#define ATT_PRIO_HI() do { if (ATT_PRIO == 1) __builtin_amdgcn_s_setprio(1); } while (0)
#define ATT_PRIO_LO() do { if (ATT_PRIO == 1) __builtin_amdgcn_s_setprio(0); } while (0)
__device__ __forceinline__ int crow(int r, int hi) { return (r & 3) + 8 * (r >> 2) + 4 * hi; }
__device__ __forceinline__ unsigned cvtpk(float lo, float hi) { unsigned r; asm volatile("v_cvt_pk_bf16_f32 %0, %1, %2" : "=v"(r) : "v"(lo), "v"(hi)); return r; }
template <int DQK> __device__ __forceinline__ int kswz(int row, int colB) {
    if constexpr (DQK == 128) return row * 256 + (colB ^ ((row & 15) << 4));
    else return row * 384 + (colB ^ (((row >> 1) & 7) << 4));
}
template <int DQK> __device__ __forceinline__ void partialSM(f32x16& p0, f32x16& p1, float& m_reg, float& mn, float& alpha) {
    constexpr float SCALE = DQK == 128 ? 0.08838834764831845f : 0.07216878364870322f;
    constexpr float C = SCALE * 1.4426950408889634f;
    float pmax = p0[0];
#pragma unroll
    for (int r = 1; r < 16; ++r) pmax = fmaxf(pmax, p0[r]);
#pragma unroll
    for (int r = 0; r < 16; ++r) pmax = fmaxf(pmax, p1[r]);
    { auto rr = __builtin_amdgcn_permlane32_swap(__float_as_uint(pmax), __float_as_uint(pmax), false, false);
      pmax = fmaxf(__uint_as_float(rr[0]), __uint_as_float(rr[1])); }
    if (__builtin_expect(__all(pmax - m_reg <= THR / SCALE), 1)) { mn = m_reg; alpha = 1.f; }
    else { mn = fmaxf(m_reg, pmax); alpha = __builtin_amdgcn_exp2f((m_reg - mn) * C); m_reg = mn; }
    const float mnC = -mn * C;
#pragma unroll
    for (int r = 0; r < 16; ++r) p0[r] = fmaf(p0[r], C, mnC);
#pragma unroll
    for (int r = 0; r < 16; ++r) p1[r] = fmaf(p1[r], C, mnC);
#pragma unroll
    for (int r = 0; r < 16; ++r) p0[r] = __builtin_amdgcn_exp2f(p0[r]);
}
__device__ __forceinline__ void finishSM(f32x16& p0, f32x16& p1, float alpha, float& l_reg, bf16x8& pa0, bf16x8& pa1, bf16x8& pa2, bf16x8& pa3) {
#pragma unroll
    for (int r = 0; r < 16; ++r) p1[r] = __builtin_amdgcn_exp2f(p1[r]);
    float ps = 0;
#pragma unroll
    for (int r = 0; r < 16; ++r) ps += p0[r];
#pragma unroll
    for (int r = 0; r < 16; ++r) ps += p1[r];
    { auto rr = __builtin_amdgcn_permlane32_swap(__float_as_uint(ps), __float_as_uint(ps), false, false);
      ps = __uint_as_float(rr[0]) + __uint_as_float(rr[1]); }
    l_reg = l_reg * alpha + ps;
#define ATT_PK4(P, BASE, OUT) do { unsigned a0 = cvtpk(P[BASE + 0], P[BASE + 1]), a1 = cvtpk(P[BASE + 2], P[BASE + 3]);   \
    unsigned b0 = cvtpk(P[BASE + 4], P[BASE + 5]), b1 = cvtpk(P[BASE + 6], P[BASE + 7]);                              \
    auto r0 = __builtin_amdgcn_permlane32_swap(a0, b0, false, false); auto r1 = __builtin_amdgcn_permlane32_swap(a1, b1, false, false); \
    u32x4 w = {r0[0], r1[0], r0[1], r1[1]}; OUT = *reinterpret_cast<bf16x8*>(&w); } while (0)
    ATT_PK4(p0, 0, pa0); ATT_PK4(p0, 8, pa1); ATT_PK4(p1, 0, pa2); ATT_PK4(p1, 8, pa3);
#undef ATT_PK4
}
template <int DQK> __device__ __forceinline__ void qkt(f32x16& p0, f32x16& p1, const char* Ks, const bf16x8* qr, const char* qp, int r32, int hi) {
#pragma unroll
    for (int d0 = 0; d0 < DQK / 16; ++d0) { const int cb = (d0 * 16 + hi * 8) * 2;
        const bf16x8 b0 = *reinterpret_cast<const bf16x8*>(Ks + kswz<DQK>(r32, cb));
        const bf16x8 b1 = *reinterpret_cast<const bf16x8*>(Ks + kswz<DQK>(32 + r32, cb));
        bf16x8 qv; if (d0 < nqreg<DQK>()) qv = qr[d0]; else qv = *reinterpret_cast<const bf16x8*>(qp + (d0 - nqreg<DQK>()) * 1024);
        p0 = __builtin_amdgcn_mfma_f32_32x32x16_bf16(b0, qv, p0, 0, 0, 0);
        p1 = __builtin_amdgcn_mfma_f32_32x32x16_bf16(b1, qv, p1, 0, 0, 0); }
}
__device__ __forceinline__ bf16x8 lds_rd128(int addr) { bf16x8 r; asm volatile("ds_read_b128 %0, %1" : "=&v"(r) : "v"(addr) : "memory"); return r; }
template <int NQ, int D0> __device__ __forceinline__ void qk_rd(int kb, int qpb, int r32, int hi, bf16x8& b0, bf16x8& b1, bf16x8& qv, const bf16x8* qr) {
    constexpr int cb0 = D0 * 32; const int cb = cb0 + hi * 16;
    b0 = lds_rd128(kb + kswz<128>(r32, cb)); b1 = lds_rd128(kb + kswz<128>(32 + r32, cb));
    if (D0 < NQ) qv = qr[D0 < NQ ? D0 : 0]; else qv = lds_rd128(qpb + (D0 - NQ) * 1024);
}
template <int NQ> __device__ __forceinline__ void qkt_pipe(f32x16& p0, f32x16& p1, const char* Ks, const bf16x8* qr, const char* qp, int r32_, int hi) {
    int r32 = r32_; asm volatile("" : "+v"(r32));
    const int kb = (int)(uintptr_t)Ks, qpb = (int)(uintptr_t)qp;
    bf16x8 a0, a1, aq, c0, c1, cq;
    qk_rd<NQ, 0>(kb, qpb, r32, hi, a0, a1, aq, qr);
#define ATT_QKSTEP(D, N0, N1, NQV, C0, C1, CQV) do { qk_rd<NQ, (D) + 1>(kb, qpb, r32, hi, N0, N1, NQV, qr); \
        if ((D) + 1 < NQ) asm volatile("s_waitcnt lgkmcnt(2)" ::: "memory"); else asm volatile("s_waitcnt lgkmcnt(3)" ::: "memory"); ATT_SBAR(); \
        p0 = __builtin_amdgcn_mfma_f32_32x32x16_bf16(C0, CQV, p0, 0, 0, 0); p1 = __builtin_amdgcn_mfma_f32_32x32x16_bf16(C1, CQV, p1, 0, 0, 0); ATT_SBAR(); } while (0)
    ATT_QKSTEP(0, c0, c1, cq, a0, a1, aq); ATT_QKSTEP(1, a0, a1, aq, c0, c1, cq); ATT_QKSTEP(2, c0, c1, cq, a0, a1, aq); ATT_QKSTEP(3, a0, a1, aq, c0, c1, cq);
    ATT_QKSTEP(4, c0, c1, cq, a0, a1, aq); ATT_QKSTEP(5, a0, a1, aq, c0, c1, cq); ATT_QKSTEP(6, c0, c1, cq, a0, a1, aq);
    asm volatile("s_waitcnt lgkmcnt(0)" ::: "memory"); ATT_SBAR();
    p0 = __builtin_amdgcn_mfma_f32_32x32x16_bf16(c0, cq, p0, 0, 0, 0); p1 = __builtin_amdgcn_mfma_f32_32x32x16_bf16(c1, cq, p1, 0, 0, 0);
#undef ATT_QKSTEP
}
#ifndef QKT_GRP
#define QKT_GRP 2
#endif
template <int NQ> __device__ __forceinline__ void qkt_b(f32x16& p0, f32x16& p1, const char* Ks, const bf16x8* qr, const char* qp, int r32_, int hi) {
    int r32 = r32_; asm volatile("" : "+v"(r32));
#pragma unroll
    for (int d0 = 0; d0 < 8; ++d0) { const int cb = (d0 * 16 + hi * 8) * 2;
        const bf16x8 b0 = *reinterpret_cast<const bf16x8*>(Ks + kswz<128>(r32, cb));
        const bf16x8 b1 = *reinterpret_cast<const bf16x8*>(Ks + kswz<128>(32 + r32, cb));
        bf16x8 qv; if (d0 < NQ) qv = qr[d0 < NQ ? d0 : 0]; else qv = *reinterpret_cast<const bf16x8*>(qp + (d0 - NQ) * 1024);
        p0 = __builtin_amdgcn_mfma_f32_32x32x16_bf16(b0, qv, p0, 0, 0, 0);
        p1 = __builtin_amdgcn_mfma_f32_32x32x16_bf16(b1, qv, p1, 0, 0, 0);
        if ((d0 % QKT_GRP) == QKT_GRP - 1) ATT_SBAR(); }
}
__device__ __forceinline__ int v_st(int k, int c) { const int kk = (k & ~0xC) | ((k & 4) << 1) | ((k & 8) >> 1); return ((kk >> 3) * 4 + (c >> 5)) * 512 + ((kk & 7) * 32 + (c & 31)) * 2; }
__device__ __forceinline__ int v_rd_base(int lane) { return ((lane & 3) << 3) | (((lane >> 2) & 3) << 6) | (((lane >> 4) & 1) << 5) | (((lane >> 5) & 1) << 8); }
constexpr int v_rd_off(int d0, int ks, int half) { return d0 * 512 + ks * 4096 + half * 2048; }
template <int OFF> __device__ __forceinline__ s16x4 tr_read(int vb) { s16x4 r; asm volatile("ds_read_b64_tr_b16 %0, %1 offset:%2" : "=&v"(r) : "v"(vb), "i"(OFF) : "memory"); return r; }
template <int D0> __device__ __forceinline__ void pv_one(f32x16& od, int vb, bf16x8 pa0, bf16x8 pa1, bf16x8 pa2, bf16x8 pa3) {
    const s16x4 l0 = tr_read<v_rd_off(D0, 0, 0)>(vb), h0 = tr_read<v_rd_off(D0, 0, 1)>(vb), l1 = tr_read<v_rd_off(D0, 1, 0)>(vb), h1 = tr_read<v_rd_off(D0, 1, 1)>(vb);
    const s16x4 l2 = tr_read<v_rd_off(D0, 2, 0)>(vb), h2 = tr_read<v_rd_off(D0, 2, 1)>(vb), l3 = tr_read<v_rd_off(D0, 3, 0)>(vb), h3 = tr_read<v_rd_off(D0, 3, 1)>(vb);
    asm volatile("s_waitcnt lgkmcnt(0)" ::: "memory"); ATT_SBAR();
#define ATT_PK(L, H) (bf16x8){L[0], L[1], L[2], L[3], H[0], H[1], H[2], H[3]}
    od = __builtin_amdgcn_mfma_f32_32x32x16_bf16(pa0, ATT_PK(l0, h0), od, 0, 0, 0);
    od = __builtin_amdgcn_mfma_f32_32x32x16_bf16(pa1, ATT_PK(l1, h1), od, 0, 0, 0);
    od = __builtin_amdgcn_mfma_f32_32x32x16_bf16(pa2, ATT_PK(l2, h2), od, 0, 0, 0);
    od = __builtin_amdgcn_mfma_f32_32x32x16_bf16(pa3, ATT_PK(l3, h3), od, 0, 0, 0);
#undef ATT_PK
}
template <int D0> __device__ __forceinline__ void pv_one_h(f32x16& od, int vb, bf16x8 pa0, bf16x8 pa1, bf16x8 pa2, bf16x8 pa3) {
#define ATT_PK(L, H) (bf16x8){L[0], L[1], L[2], L[3], H[0], H[1], H[2], H[3]}
    { const s16x4 l0 = tr_read<v_rd_off(D0, 0, 0)>(vb), h0 = tr_read<v_rd_off(D0, 0, 1)>(vb), l1 = tr_read<v_rd_off(D0, 1, 0)>(vb), h1 = tr_read<v_rd_off(D0, 1, 1)>(vb);
      asm volatile("s_waitcnt lgkmcnt(0)" ::: "memory"); ATT_SBAR();
      od = __builtin_amdgcn_mfma_f32_32x32x16_bf16(pa0, ATT_PK(l0, h0), od, 0, 0, 0); od = __builtin_amdgcn_mfma_f32_32x32x16_bf16(pa1, ATT_PK(l1, h1), od, 0, 0, 0); }
    ATT_SBAR();
    { const s16x4 l2 = tr_read<v_rd_off(D0, 2, 0)>(vb), h2 = tr_read<v_rd_off(D0, 2, 1)>(vb), l3 = tr_read<v_rd_off(D0, 3, 0)>(vb), h3 = tr_read<v_rd_off(D0, 3, 1)>(vb);
      asm volatile("s_waitcnt lgkmcnt(0)" ::: "memory"); ATT_SBAR();
      od = __builtin_amdgcn_mfma_f32_32x32x16_bf16(pa2, ATT_PK(l2, h2), od, 0, 0, 0); od = __builtin_amdgcn_mfma_f32_32x32x16_bf16(pa3, ATT_PK(l3, h3), od, 0, 0, 0); }
#undef ATT_PK
}
__device__ __forceinline__ void pv_d0_h(f32x16* o, int vb, bf16x8 pa0, bf16x8 pa1, bf16x8 pa2, bf16x8 pa3) {
    pv_one_h<0>(o[0], vb, pa0, pa1, pa2, pa3); pv_one_h<1>(o[1], vb, pa0, pa1, pa2, pa3); pv_one_h<2>(o[2], vb, pa0, pa1, pa2, pa3); pv_one_h<3>(o[3], vb, pa0, pa1, pa2, pa3);
}
template <int H> __device__ __forceinline__ void pv_rd(int vb, s16x4& la, s16x4& ha, s16x4& lb, s16x4& hb) {
    constexpr int D0 = H >> 1, KS = 2 * (H & 1);
    la = tr_read<v_rd_off(D0, KS, 0)>(vb); ha = tr_read<v_rd_off(D0, KS, 1)>(vb); lb = tr_read<v_rd_off(D0, KS + 1, 0)>(vb); hb = tr_read<v_rd_off(D0, KS + 1, 1)>(vb);
}
#define ATT_PK2(L, Hh) (bf16x8){L[0], L[1], L[2], L[3], Hh[0], Hh[1], Hh[2], Hh[3]}
template <int H> __device__ __forceinline__ void pv_mm(f32x16* o, const s16x4& la, const s16x4& ha, const s16x4& lb, const s16x4& hb, bf16x8 pa0, bf16x8 pa1, bf16x8 pa2, bf16x8 pa3) {
    constexpr int D0 = H >> 1;
    o[D0] = __builtin_amdgcn_mfma_f32_32x32x16_bf16((H & 1) ? pa2 : pa0, ATT_PK2(la, ha), o[D0], 0, 0, 0);
    o[D0] = __builtin_amdgcn_mfma_f32_32x32x16_bf16((H & 1) ? pa3 : pa1, ATT_PK2(lb, hb), o[D0], 0, 0, 0);
}
__device__ __forceinline__ void pv_pipe(f32x16* o, int vb, bf16x8 pa0, bf16x8 pa1, bf16x8 pa2, bf16x8 pa3) {
    s16x4 a0, a1, a2, a3, b0, b1, b2, b3;
    pv_rd<0>(vb, a0, a1, a2, a3);
#define ATT_PVSTEP(H, RN0, RN1, RN2, RN3, RC0, RC1, RC2, RC3) do { pv_rd<(H) + 1>(vb, RN0, RN1, RN2, RN3); asm volatile("s_waitcnt lgkmcnt(4)" ::: "memory"); ATT_SBAR(); \
        pv_mm<(H)>(o, RC0, RC1, RC2, RC3, pa0, pa1, pa2, pa3); ATT_SBAR(); } while (0)
    ATT_PVSTEP(0, b0, b1, b2, b3, a0, a1, a2, a3); ATT_PVSTEP(1, a0, a1, a2, a3, b0, b1, b2, b3); ATT_PVSTEP(2, b0, b1, b2, b3, a0, a1, a2, a3); ATT_PVSTEP(3, a0, a1, a2, a3, b0, b1, b2, b3);
    ATT_PVSTEP(4, b0, b1, b2, b3, a0, a1, a2, a3); ATT_PVSTEP(5, a0, a1, a2, a3, b0, b1, b2, b3); ATT_PVSTEP(6, b0, b1, b2, b3, a0, a1, a2, a3);
    asm volatile("s_waitcnt lgkmcnt(0)" ::: "memory"); ATT_SBAR(); pv_mm<7>(o, b0, b1, b2, b3, pa0, pa1, pa2, pa3);
#undef ATT_PVSTEP
}
#undef ATT_PK2
__device__ __forceinline__ void pv_d0(f32x16* o, int vb, bf16x8 pa0, bf16x8 pa1, bf16x8 pa2, bf16x8 pa3) {
    pv_one<0>(o[0], vb, pa0, pa1, pa2, pa3); pv_one<1>(o[1], vb, pa0, pa1, pa2, pa3); pv_one<2>(o[2], vb, pa0, pa1, pa2, pa3); pv_one<3>(o[3], vb, pa0, pa1, pa2, pa3);
}
template <bool ALIBI> __device__ __forceinline__ void init_real(f32x16& p0, f32x16& p1, float dq, float nslope) {
    if constexpr (ALIBI) {
#pragma unroll
        for (int r = 0; r < 16; ++r) { const float cr = (float)((r & 3) + 8 * (r >> 2)); p0[r] = nslope * fabsf(dq - cr); p1[r] = nslope * fabsf(dq - (cr + 32.f)); }
    } else { p0 = f32x16{}; p1 = f32x16{}; }
}
__device__ __forceinline__ void init_meta(f32x16& p0, f32x16& p1) {
#pragma unroll
    for (int r = 0; r < 16; ++r) { p0[r] = (r < 8) ? 0.f : -1e30f; p1[r] = -1e30f; }
}


constexpr float THR2 = 11.5f;
template <bool FIRST> __device__ __forceinline__ void partialSM_rel(f32x16& p0, f32x16& p1, float& m_ref, float& alpha) {
    float pmax = fmaxf(fmaxf(p0[0], p0[1]), p1[0]);
#pragma unroll
    for (int r = 2; r < 16; r += 2) pmax = fmaxf(fmaxf(pmax, p0[r]), p0[r + 1]);
#pragma unroll
    for (int r = 1; r < 15; r += 2) pmax = fmaxf(fmaxf(pmax, p1[r]), p1[r + 1]);
    pmax = fmaxf(pmax, p1[15]);
    { auto rr = __builtin_amdgcn_permlane32_swap(__float_as_uint(pmax), __float_as_uint(pmax), false, false);
      pmax = fmaxf(__uint_as_float(rr[0]), __uint_as_float(rr[1])); }
    if (!FIRST && __builtin_expect(__all(pmax <= THR2), 1)) { alpha = 1.f; }
    else { const float dl = FIRST ? pmax : fmaxf(pmax, 0.f); m_ref += dl; alpha = FIRST ? 1.f : __builtin_amdgcn_exp2f(-dl);
#pragma unroll
        for (int r = 0; r < 16; ++r) { p0[r] -= dl; p1[r] -= dl; } }
#pragma unroll
    for (int r = 0; r < 16; ++r) p0[r] = __builtin_amdgcn_exp2f(p0[r]);
}
__device__ __forceinline__ void init_real_rel(f32x16& p0, f32x16& p1, float dq, float sl2, float m, int mode) {
    if (mode != 2) { const float S = mode == 0 ? sl2 : -sl2, S2 = 2.f * S, S3 = 3.f * S; const float base = -S * dq - m, base32 = fmaf(S, 32.f, base);
#pragma unroll
        for (int jj = 0; jj < 4; ++jj) { const float t0 = fmaf(S, 8.f * jj, base), t1 = fmaf(S, 8.f * jj, base32);
            p0[4 * jj] = t0; p0[4 * jj + 1] = t0 + S; p0[4 * jj + 2] = t0 + S2; p0[4 * jj + 3] = t0 + S3;
            p1[4 * jj] = t1; p1[4 * jj + 1] = t1 + S; p1[4 * jj + 2] = t1 + S2; p1[4 * jj + 3] = t1 + S3; }
    } else {
#pragma unroll
        for (int r = 0; r < 16; ++r) { const float cr = (float)((r & 3) + 8 * (r >> 2)); p0[r] = -sl2 * fabsf(dq - cr) - m; p1[r] = -sl2 * fabsf(dq - (cr + 32.f)) - m; }
    }
}

#ifndef ATT_PVA
#define ATT_PVA pv_d0
#endif
template <int DQK, bool ALIBI, int SDEPTH>
__device__ __forceinline__ void attn_unit(const bf16* __restrict__ Qb, const int ldq,
                                          const bf16* __restrict__ K0, const int ldk0, const bf16* __restrict__ K1, const int ldk1,
                                          const bf16* __restrict__ Vg, const int ldv, bf16* __restrict__ Ob, const int ldo,
                                          const int kbase, const int q0, const float nslope, const int t_lo, const int t_hi, char* lds, const int tid) {
    constexpr int SHM_K = shm_k<DQK>(), ND0 = DQK / 16, NLD = (DQK == 192) ? 5 : 4;
    const int wid = tid >> 6, lane = tid & 63, r32 = lane & 31, hi = lane >> 5;
    char* V_lds = lds; char* K_lds = lds + 2 * SHM_V;
    float* ws = (float*)(lds + 2 * SHM_V + 2 * SHM_K) + wid * 64; float* li_l = ws; float* al_l = ws + 32;
    constexpr int NQR = nqreg<DQK>();
    float m_reg = ALIBI ? 0.f : -1e30f, l_reg = 0; f32x16 o[4] = {}; bf16x8 qr[NQR];
    const bf16* Qw = Qb + (long)(wid * QBLK + r32) * ldq + hi * 8;
    char* const qp = lds + 2 * SHM_V + 2 * SHM_K + NW * 64 * 4 + wid * (1024 * (ND0 - NQR)) + hi * 512 + r32 * 16;
#pragma unroll
    for (int d0 = 0; d0 < NQR; ++d0) qr[d0] = *reinterpret_cast<const bf16x8*>(Qw + d0 * 16);
#pragma unroll
    for (int d0 = NQR; d0 < ND0; ++d0) *reinterpret_cast<bf16x8*>(qp + (d0 - NQR) * 1024) = *reinterpret_cast<const bf16x8*>(Qw + d0 * 16);
    const int sr = tid >> 4, sc = (tid & 15) * 8, vst0 = v_st(sr, sc), vst1 = v_st(32 + sr, sc);
    const int kr2 = tid >> 3, sc2 = (tid & 7) * 8;
    const int vb0 = (int)(uintptr_t)V_lds + v_rd_base(lane);
    struct { bf16x8 vs0, vs1, ks0, ks1, ks2; } sr_[SDEPTH];
    const float qs = (float)(q0 + wid * QBLK + r32 - 4 * hi);
    const int qw0 = q0 + wid * QBLK;
#define ATT_SLOAD(i, t) do { const int t_ = (t); const long g0 = t_ == 0 ? (long)(MR + (sr & 15)) : (long)(kbase + (t_ - 1) * KVBLK + sr); const long g1 = t_ == 0 ? g0 : g0 + 32; \
        sr_[i].vs0 = *reinterpret_cast<const bf16x8*>(Vg + g0 * ldv + sc); sr_[i].vs1 = *reinterpret_cast<const bf16x8*>(Vg + g1 * ldv + sc); \
        sr_[i].ks0 = *reinterpret_cast<const bf16x8*>(K0 + g0 * ldk0 + sc); sr_[i].ks1 = *reinterpret_cast<const bf16x8*>(K0 + g1 * ldk0 + sc); \
        if constexpr (DQK == 192) { const long g2 = t_ == 0 ? (long)(MR + (kr2 & 15)) : (long)(kbase + (t_ - 1) * KVBLK + kr2); sr_[i].ks2 = *reinterpret_cast<const bf16x8*>(K1 + g2 * ldk1 + sc2); } } while (0)
#define ATT_SWRITE(b, i) do { *(bf16x8*)(V_lds + (b) * SHM_V + vst0) = sr_[i].vs0; *(bf16x8*)(V_lds + (b) * SHM_V + vst1) = sr_[i].vs1; \
        *(bf16x8*)(K_lds + (b) * SHM_K + kswz<DQK>(sr, sc * 2)) = sr_[i].ks0; *(bf16x8*)(K_lds + (b) * SHM_K + kswz<DQK>(32 + sr, sc * 2)) = sr_[i].ks1; \
        if constexpr (DQK == 192) *(bf16x8*)(K_lds + (b) * SHM_K + kswz<DQK>(kr2, (128 + sc2) * 2)) = sr_[i].ks2; } while (0)
#define ATT_SWAIT() do { if constexpr (SDEPTH == 2) { if constexpr (NLD == 5) asm volatile("s_waitcnt vmcnt(5)" ::: "memory"); else asm volatile("s_waitcnt vmcnt(4)" ::: "memory"); } \
        else asm volatile("s_waitcnt vmcnt(0)" ::: "memory"); } while (0)
#define ATT_RESC(a) do { if (__any((a) < 1.f)) { if (hi == 0) al_l[r32] = (a); asm volatile("s_waitcnt lgkmcnt(0)" ::: "memory"); \
        _Pragma("unroll") for (int d = 0; d < 4; ++d) _Pragma("unroll") for (int r = 0; r < 16; ++r) o[d][r] *= al_l[crow(r, hi)]; } } while (0)
    f32x16 pA0, pA1, pB0, pB1; float mnA, mnB, alA, alB; bf16x8 pa0, pa1, pa2, pa3;
    constexpr int SE = 0, SO = SDEPTH - 1;
    constexpr int pm_ = probe_mode();
    if (pm_) { pa0 = bf16x8{}; pa1 = bf16x8{}; pa2 = bf16x8{}; pa3 = bf16x8{}; alA = alB = 1.f; mnA = mnB = 0.f; }
    ATT_SLOAD(SE, 0); asm volatile("s_waitcnt vmcnt(0)" ::: "memory"); ATT_SWRITE(0, SE); __syncthreads();
#define ATT_QK(P0, P1, KS) do { if (!(pm_ & 8)) qkt<DQK>(P0, P1, KS, qr, qp, r32, hi); } while (0)
#define ATT_FSM(P0, P1, AL) do { if (!(pm_ & 16)) finishSM(P0, P1, AL, l_reg, pa0, pa1, pa2, pa3); else asm volatile("" : "+v"(P0), "+v"(P1)); } while (0)
#define ATT_PVX(VB) do { if (!(pm_ & 32)) ATT_PVA(o, VB, pa0, pa1, pa2, pa3); } while (0)
#define ATT_INIT(P0, P1, t) do { if constexpr (ALIBI) { const int k0_ = ((t) - 1) * KVBLK; init_real_rel(P0, P1, qs - (float)k0_, nslope, m_reg, (k0_ + KVBLK - 1 <= qw0) ? 0 : (k0_ >= qw0 + QBLK - 1) ? 1 : 2); } \
        else init_real<false>(P0, P1, 0.f, 0.f); } while (0)
#define ATT_PSM(P0, P1, MN, AL) do { if (!(pm_ & 16)) { if constexpr (ALIBI) partialSM_rel<false>(P0, P1, m_reg, AL); else partialSM<DQK>(P0, P1, m_reg, MN, AL); } } while (0)
    init_meta(pA0, pA1); ATT_QK(pA0, pA1, K_lds);
    if (!(pm_ & 16)) { if constexpr (ALIBI) partialSM_rel<true>(pA0, pA1, m_reg, alA); else partialSM<DQK>(pA0, pA1, m_reg, mnA, alA); }
    ATT_SLOAD(SO, t_lo); if constexpr (SDEPTH == 2) ATT_SLOAD(SE, t_lo + 1);
    ATT_SWAIT(); ATT_SWRITE(1, SO); __syncthreads();
    for (int j = t_lo; j < t_hi; j += 2) {
        ATT_SBAR(); ATT_INIT(pB0, pB1, j); ATT_QK(pB0, pB1, K_lds + SHM_K);
        ATT_FSM(pA0, pA1, alA); ATT_SBAR();
        if (!(pm_ & 64)) { const int tn = j + SDEPTH; ATT_SLOAD(SO, tn < t_hi ? tn : t_hi); } ATT_SBAR();
        ATT_PVX(vb0); ATT_PSM(pB0, pB1, mnB, alB);
        __syncthreads(); if (!(pm_ & 64)) { ATT_SWAIT(); ATT_SWRITE(0, SE); }
        ATT_RESC(alB); __syncthreads();
        ATT_SBAR(); ATT_INIT(pA0, pA1, j + 1); ATT_QK(pA0, pA1, K_lds);
        ATT_FSM(pB0, pB1, alB); ATT_SBAR();
        if (!(pm_ & 64)) { const int tn = j + 1 + SDEPTH; ATT_SLOAD(SE, tn < t_hi ? tn : t_hi); } ATT_SBAR();
        ATT_PVX(vb0 + SHM_V); ATT_PSM(pA0, pA1, mnA, alA);
        __syncthreads(); if (!(pm_ & 64)) { ATT_SWAIT(); ATT_SWRITE(1, SO); }
        ATT_RESC(alA); __syncthreads();
    }
    ATT_FSM(pA0, pA1, alA); ATT_SBAR();
    ATT_PVX(vb0);
    asm volatile("s_waitcnt vmcnt(0)" ::: "memory");
    if (hi == 0) li_l[r32] = l_reg; asm volatile("s_waitcnt lgkmcnt(0)" ::: "memory");
    float rli[16];
#pragma unroll
    for (int r = 0; r < 16; ++r) rli[r] = __builtin_amdgcn_rcpf(li_l[crow(r, hi)]);
    bf16* Ow = Ob + (long)(wid * QBLK) * ldo;
#pragma unroll
    for (int r = 0; r < 16; ++r) { const int orow = crow(r, hi);
#pragma unroll
        for (int d0 = 0; d0 < 4; d0 += 1) { const unsigned w = cvtpk(o[d0][r] * rli[r], 0.f); if (pm_ & 4) asm volatile("" :: "v"(w)); else Ow[(long)orow * ldo + d0 * 32 + r32] = (bf16)(w & 0xffffu); } }
    __syncthreads();
#undef ATT_QK
#undef ATT_FSM
#undef ATT_PVX
#undef ATT_INIT
#undef ATT_PSM
#undef ATT_SLOAD
#undef ATT_SWRITE
#undef ATT_SWAIT
#undef ATT_RESC
}

#ifndef NQRB
#define NQRB 2
#endif
constexpr int SHMB_V = 2 * SHM_V, SHMB_K = shm_k<128>(), SHMB_TOTAL = 2 * SHMB_V + 2 * SHMB_K + NW * 64 * 4 + NW * 1024 * (8 - NQRB);
__device__ __forceinline__ void attn_unit_b(const bf16* __restrict__ Qb, const int ldq, const bf16* __restrict__ K0, const int ldk0, const bf16* __restrict__ Vg, const int ldv,
                                            bf16* __restrict__ Ob, const int ldo, const int kbase, const int q0, const float sl2, const int t_lo, const int t_hi, char* lds, const int tid) {
    const int wid = tid >> 6, lane = tid & 63, r32 = lane & 31, hi = lane >> 5;
    char* V_lds = lds; char* K_lds = lds + 2 * SHMB_V;
    float* ws = (float*)(lds + 2 * SHMB_V + 2 * SHMB_K) + wid * 64; float* li_l = ws; float* al_l = ws + 32;
    char* const qp = lds + 2 * SHMB_V + 2 * SHMB_K + NW * 64 * 4 + wid * (1024 * (8 - NQRB)) + hi * 512 + r32 * 16;
    float m_reg = 0.f, l_reg = 0; f32x16 o[8] = {}; bf16x8 qr[NQRB > 0 ? NQRB : 1];
    const bf16* Qw = Qb + (long)(wid * QBLK + r32) * ldq + hi * 8;
#pragma unroll
    for (int d0 = 0; d0 < NQRB; ++d0) qr[d0] = *reinterpret_cast<const bf16x8*>(Qw + d0 * 16);
#pragma unroll
    for (int d0 = NQRB; d0 < 8; ++d0) *reinterpret_cast<bf16x8*>(qp + (d0 - NQRB) * 1024) = *reinterpret_cast<const bf16x8*>(Qw + d0 * 16);
    const int vb0 = (int)(uintptr_t)V_lds + v_rd_base(lane);
    const float qs = (float)(q0 + wid * QBLK + r32 - 4 * hi); const int qw0 = q0 + wid * QBLK;
    if (ATT_PRIO == 2) { if (__builtin_amdgcn_readfirstlane(wid) >= 4) __builtin_amdgcn_s_setprio(1); }
    typedef __attribute__((address_space(3))) unsigned las_u32;
    const unsigned ldsw = (unsigned)__builtin_amdgcn_readfirstlane(wid) * 2048u;
#define ATB_DMA(t, b) do { const int t_ = (t); int ln_ = lane; asm volatile("" : "+v"(ln_));     \
        _Pragma("unroll") for (int i_ = 0; i_ < 2; ++i_) { \
        const int p_ = (2 * wid + i_) * 1024 + ln_ * 16, kr_ = p_ >> 8, kc_ = ((((p_ >> 4) & 15) ^ (kr_ & 15)) << 3);            \
        const int st_ = p_ >> 9, q_ = p_ & 511, kk_ = (st_ >> 2) * 8 + (q_ >> 6), vr_ = (kk_ & ~0xC) | ((kk_ & 4) << 1) | ((kk_ & 8) >> 1), vc_ = (st_ & 3) * 32 + ((q_ & 63) >> 1);     \
        const long gk = t_ == 0 ? (long)(MR + (kr_ & 15)) : (long)(kbase + (t_ - 1) * KVBLK + kr_); const long gv = t_ == 0 ? (long)(MR + (vr_ & 15)) : (long)(kbase + (t_ - 1) * KVBLK + vr_); \
        __builtin_amdgcn_global_load_lds((const unsigned*)(K0 + gk * ldk0 + kc_), (las_u32*)(K_lds + (b) * SHMB_K + ldsw + i_ * 1024), 16, 0, 0); \
        __builtin_amdgcn_global_load_lds((const unsigned*)(Vg + gv * ldv + vc_), (las_u32*)(V_lds + (b) * SHMB_V + ldsw + i_ * 1024), 16, 0, 0); \
        __builtin_amdgcn_global_load_lds((const unsigned*)(Vg + gv * ldv + 128 + vc_), (las_u32*)(V_lds + (b) * SHMB_V + SHM_V + ldsw + i_ * 1024), 16, 0, 0); } } while (0)
#ifndef ATB_PV
#define ATB_PV pv_pipe
#endif
#ifndef ATB_QK
#define ATB_QK qkt_b
#endif
    f32x16 p0, p1; float al; bf16x8 pa0, pa1, pa2, pa3;
#define ATB_TILE(FIRST, t, bufi) do { \
        if (FIRST) init_meta(p0, p1); else { const int k0_ = ((t) - 1) * KVBLK; init_real_rel(p0, p1, qs - (float)k0_, sl2, m_reg, (k0_ + KVBLK - 1 <= qw0) ? 0 : (k0_ >= qw0 + QBLK - 1) ? 1 : 2); } \
        ATT_PRIO_HI(); if (!(pm_ & 8)) ATB_QK<NQRB>(p0, p1, K_lds + (bufi) * SHMB_K, qr, qp, r32, hi); ATT_PRIO_LO(); \
        if (!(pm_ & 16)) { if (FIRST) partialSM_rel<true>(p0, p1, m_reg, al); else partialSM_rel<false>(p0, p1, m_reg, al); \
        if (!(FIRST)) { if (__any(al < 1.f)) { if (hi == 0) al_l[r32] = al; asm volatile("s_waitcnt lgkmcnt(0)" ::: "memory"); \
            _Pragma("unroll") for (int d = 0; d < 8; ++d) _Pragma("unroll") for (int r = 0; r < 16; ++r) o[d][r] *= al_l[crow(r, hi)]; } } \
        finishSM(p0, p1, al, l_reg, pa0, pa1, pa2, pa3); } else { asm volatile("" : "+v"(p0), "+v"(p1)); } ATT_SBAR(); \
        ATT_PRIO_HI(); if (!(pm_ & 32)) { ATB_PV(o, vb0 + (bufi) * SHMB_V, pa0, pa1, pa2, pa3); ATB_PV(o + 4, vb0 + (bufi) * SHMB_V + SHM_V, pa0, pa1, pa2, pa3); } ATT_PRIO_LO(); } while (0)
    const int pm_ = probe_mode();
    if (pm_) { pa0 = bf16x8{}; pa1 = bf16x8{}; pa2 = bf16x8{}; pa3 = bf16x8{}; al = 1.f; }
    ATB_DMA(0, 0); __syncthreads();
    if (!(pm_ & 64)) ATB_DMA(t_lo, 1); ATT_SBAR(); ATB_TILE(true, 0, 0); __syncthreads();
    int buf = 1;
    for (int t = t_lo; t <= t_hi; ++t) {
        if (t < t_hi && !(pm_ & 64)) ATB_DMA(t + 1, buf ^ 1);
        ATT_SBAR(); ATB_TILE(false, t, buf); __syncthreads(); buf ^= 1;
    }
    asm volatile("s_waitcnt vmcnt(0)" ::: "memory");
    if (hi == 0) li_l[r32] = l_reg; asm volatile("s_waitcnt lgkmcnt(0)" ::: "memory");
    float rli[16];
#pragma unroll
    for (int r = 0; r < 16; ++r) rli[r] = __builtin_amdgcn_rcpf(li_l[crow(r, hi)]);
    bf16* Ow = Ob + (long)(wid * QBLK) * ldo;
#pragma unroll
    for (int r = 0; r < 16; ++r) { const int orow = crow(r, hi);
#pragma unroll
        for (int d0 = 0; d0 < 8; ++d0) { const unsigned w = cvtpk(o[d0][r] * rli[r], 0.f); if (pm_ & 4) asm volatile("" :: "v"(w)); else Ow[(long)orow * ldo + d0 * 32 + r32] = (bf16)(w & 0xffffu); } }
    if (ATT_PRIO == 2) __builtin_amdgcn_s_setprio(0);
    __syncthreads();
#undef ATB_DMA
#undef ATB_TILE
}

#ifndef MLA_STAGGER
#define MLA_STAGGER 0
#endif
constexpr int MLA_NVB = MLA_STAGGER ? 3 : 2;
constexpr int SHMM_K = shm_k<192>(), SHMM_TOTAL = MLA_NVB * SHM_V + 2 * SHMM_K + NW * 64 * 4;
__device__ __forceinline__ void attn_unit_m(const bf16* __restrict__ Qb, const int ldq, const bf16* __restrict__ K0, const int ldk0, const bf16* __restrict__ K1, const int ldk1,
                                            const bf16* __restrict__ Vg, const int ldv, bf16* __restrict__ Ob, const int ldo, const int kbase, char* lds, const int tid) {
    const int wid = tid >> 6, lane = tid & 63, r32 = lane & 31, hi = lane >> 5;
    char* V_lds = lds; char* K_lds = lds + MLA_NVB * SHM_V;
    float* ws = (float*)(lds + MLA_NVB * SHM_V + 2 * SHMM_K) + wid * 64; float* li_l = ws; float* al_l = ws + 32;
    float m_reg = 0.f, l_reg = 0; f32x16 o[4] = {}; bf16x8 qr[12];
    const bf16* Qw = Qb + (long)(wid * QBLK + r32) * ldq + hi * 8;
#pragma unroll
    for (int d0 = 0; d0 < 12; ++d0) qr[d0] = *reinterpret_cast<const bf16x8*>(Qw + d0 * 16);
    const int vb0 = (int)(uintptr_t)V_lds + v_rd_base(lane);
    typedef __attribute__((address_space(3))) unsigned las_u32;
    const unsigned wv_ = (unsigned)__builtin_amdgcn_readfirstlane(wid);
    if (ATT_PRIO == 2) { if (wv_ >= 4) __builtin_amdgcn_s_setprio(1); }
#define ATM_DMA(t, b, vbf) do { const int t_ = (t); int ln_ = lane; asm volatile("" : "+v"(ln_)); \
        _Pragma("unroll") for (int i_ = 0; i_ < 3; ++i_) { const int p_ = (3 * wid + i_) * 1024 + ln_ * 16, kr_ = p_ / 384, sl_ = (p_ - kr_ * 384) >> 4, ch_ = sl_ ^ ((kr_ >> 1) & 7); \
            const long gk = t_ == 0 ? (long)(MR + (kr_ & 15)) : (long)(kbase + (t_ - 1) * KVBLK + kr_); \
            const bf16* src_ = ch_ < 16 ? K0 + gk * ldk0 + ch_ * 8 : K1 + gk * ldk1 + (ch_ - 16) * 8; \
            __builtin_amdgcn_global_load_lds((const unsigned*)src_, (las_u32*)(K_lds + (b) * SHMM_K + (3 * wv_ + i_) * 1024), 16, 0, 0); } \
        _Pragma("unroll") for (int i_ = 0; i_ < 2; ++i_) { const int p_ = (2 * wid + i_) * 1024 + ln_ * 16; \
            const int st_ = p_ >> 9, q_ = p_ & 511, kk_ = (st_ >> 2) * 8 + (q_ >> 6), vr_ = (kk_ & ~0xC) | ((kk_ & 4) << 1) | ((kk_ & 8) >> 1), vc_ = (st_ & 3) * 32 + ((q_ & 63) >> 1); \
            const long gv = t_ == 0 ? (long)(MR + (vr_ & 15)) : (long)(kbase + (t_ - 1) * KVBLK + vr_); \
            __builtin_amdgcn_global_load_lds((const unsigned*)(Vg + gv * ldv + vc_), (las_u32*)(V_lds + (vbf) * SHM_V + (2 * wv_ + i_) * 1024), 16, 0, 0); } } while (0)
    f32x16 p0, p1; float al; bf16x8 pa0, pa1, pa2, pa3;
    constexpr int pm_ = probe_mode();
    if (pm_) { pa0 = bf16x8{}; pa1 = bf16x8{}; pa2 = bf16x8{}; pa3 = bf16x8{}; al = 1.f; }
#define ATM_QKSM(FIRST, bufi) do { \
        if (FIRST) init_meta(p0, p1); else { const float nm_ = -m_reg; _Pragma("unroll") for (int r = 0; r < 16; ++r) { p0[r] = nm_; p1[r] = nm_; } } \
        ATT_PRIO_HI(); if (!(pm_ & 8)) { const int kb_ = (int)(uintptr_t)(K_lds + (bufi) * SHMM_K); int rr_ = r32; asm volatile("" : "+v"(rr_)); bf16x8 ka0, ka1, kc0, kc1;     \
            ka0 = lds_rd128(kb_ + kswz<192>(rr_, hi * 16)); ka1 = lds_rd128(kb_ + kswz<192>(32 + rr_, hi * 16)); \
            _Pragma("unroll") for (int d0 = 0; d0 < 12; d0 += 2) { \
                kc0 = lds_rd128(kb_ + kswz<192>(rr_, (d0 + 1) * 32 + hi * 16)); kc1 = lds_rd128(kb_ + kswz<192>(32 + rr_, (d0 + 1) * 32 + hi * 16)); asm volatile("s_waitcnt lgkmcnt(2)" ::: "memory"); ATT_SBAR(); \
                p0 = __builtin_amdgcn_mfma_f32_32x32x16_bf16(ka0, qr[d0], p0, 0, 0, 0); p1 = __builtin_amdgcn_mfma_f32_32x32x16_bf16(ka1, qr[d0], p1, 0, 0, 0); ATT_SBAR(); \
                if (d0 + 2 < 12) { ka0 = lds_rd128(kb_ + kswz<192>(rr_, (d0 + 2) * 32 + hi * 16)); ka1 = lds_rd128(kb_ + kswz<192>(32 + rr_, (d0 + 2) * 32 + hi * 16)); asm volatile("s_waitcnt lgkmcnt(2)" ::: "memory"); } \
                else asm volatile("s_waitcnt lgkmcnt(0)" ::: "memory"); ATT_SBAR(); \
                p0 = __builtin_amdgcn_mfma_f32_32x32x16_bf16(kc0, qr[d0 + 1], p0, 0, 0, 0); p1 = __builtin_amdgcn_mfma_f32_32x32x16_bf16(kc1, qr[d0 + 1], p1, 0, 0, 0); ATT_SBAR(); } } ATT_PRIO_LO(); \
        if (!(pm_ & 16)) { if (FIRST) partialSM_rel<true>(p0, p1, m_reg, al); else partialSM_rel<false>(p0, p1, m_reg, al); \
        if (!(FIRST)) { if (__any(al < 1.f)) { if (hi == 0) al_l[r32] = al; asm volatile("s_waitcnt lgkmcnt(0)" ::: "memory"); \
            _Pragma("unroll") for (int d = 0; d < 4; ++d) _Pragma("unroll") for (int r = 0; r < 16; ++r) o[d][r] *= al_l[crow(r, hi)]; } } \
        finishSM(p0, p1, al, l_reg, pa0, pa1, pa2, pa3); } else { asm volatile("" : "+v"(p0), "+v"(p1)); } ATT_SBAR(); } while (0)
#define ATM_PV(vbi) do { ATT_SBAR(); ATT_PRIO_HI(); if (!(pm_ & 32)) pv_pipe(o, vb0 + (vbi) * SHM_V, pa0, pa1, pa2, pa3); ATT_PRIO_LO(); ATT_SBAR(); } while (0)
    ATM_DMA(0, 0, 0); __syncthreads();
#if MLA_STAGGER
    const bool halfA = __builtin_amdgcn_readfirstlane(wid) < 4;
    if (!(pm_ & 64)) ATM_DMA(1, 1, 1); ATT_SBAR(); ATM_QKSM(true, 0); if (halfA) ATM_PV(0); __syncthreads();
    int vcur = 1, vprev = 0;
    for (int t = 1; t <= 64; ++t) { const int vnext = vcur == 2 ? 0 : vcur + 1;
        if (t < 64 && !(pm_ & 64)) ATM_DMA(t + 1, (t + 1) & 1, vnext);
        if (!halfA) ATM_PV(vprev);
        ATT_SBAR(); ATM_QKSM(false, t & 1);
        if (halfA) ATM_PV(vcur);
        __syncthreads(); vprev = vcur; vcur = vnext;
    }
    if (!halfA) ATM_PV(vprev);
#else
    if (!(pm_ & 64)) ATM_DMA(1, 1, 1); ATT_SBAR(); ATM_QKSM(true, 0); ATM_PV(0); __syncthreads();
    int buf = 1;
    for (int t = 1; t <= 64; ++t) {
        if (t < 64 && !(pm_ & 64)) ATM_DMA(t + 1, buf ^ 1, buf ^ 1);
        ATT_SBAR(); ATM_QKSM(false, buf); ATM_PV(buf); __syncthreads(); buf ^= 1;
    }
#endif
    asm volatile("s_waitcnt vmcnt(0)" ::: "memory");
    if (hi == 0) li_l[r32] = l_reg; asm volatile("s_waitcnt lgkmcnt(0)" ::: "memory");
    float rli[16];
#pragma unroll
    for (int r = 0; r < 16; ++r) rli[r] = __builtin_amdgcn_rcpf(li_l[crow(r, hi)]);
    bf16* Ow = Ob + (long)(wid * QBLK) * ldo;
#pragma unroll
    for (int r = 0; r < 16; ++r) { const int orow = crow(r, hi);
#pragma unroll
        for (int d0 = 0; d0 < 4; ++d0) { const unsigned w = cvtpk(o[d0][r] * rli[r], 0.f); if (pm_ & 4) asm volatile("" :: "v"(w)); else Ow[(long)orow * ldo + d0 * 32 + r32] = (bf16)(w & 0xffffu); } }
    if (ATT_PRIO == 2) __builtin_amdgcn_s_setprio(0);
    __syncthreads();
#undef ATM_DMA
#undef ATM_QKSM
#undef ATM_PV
}
#undef ATT_SBAR
}

constexpr int NWAVES = 8;
constexpr int NPH = 16;
#ifndef MK_N_LAUNCHES
#define MK_N_LAUNCHES 1
#endif
constexpr int N_LAUNCHES = MK_N_LAUNCHES;
#ifndef DIFF_SDEPTH
#define DIFF_SDEPTH 1
#endif
#ifndef MLA_SDEPTH
#define MLA_SDEPTH 1
#endif

constexpr size_t MiB = 1u << 20;
constexpr size_t WS_CTL = 0, CTL_ZERO_BYTES = 1 * MiB;
constexpr size_t WS_ROPE = 1 * MiB;
constexpr size_t WS_SLAB = 4 * MiB;
constexpr size_t WS_PART = 8 * MiB;
constexpr size_t WS_MX0 = WS_SLAB, WS_MX1 = WS_PART;
constexpr size_t WS_W1GU = 16 * MiB, WS_W1D = 188 * MiB, WS_W2GU = 275 * MiB, WS_W2D = 447 * MiB;
constexpr size_t WS_WIN = 534 * MiB, WS_WG = 596 * MiB, WS_WUQ = 660 * MiB, WS_WUKV = 666 * MiB, WS_WBD = 670 * MiB, WS_WBM = 686 * MiB, WS_WO = 702 * MiB;
constexpr size_t WS_XN = 734 * MiB;
constexpr size_t WS_H = 864 * MiB;
constexpr size_t WS_P = 864 * MiB;
constexpr size_t WS_CQN = 1116 * MiB, WS_CKVN = 1149 * MiB;
constexpr size_t WS_QM = 1166 * MiB;
constexpr size_t WS_KV = 1264 * MiB;
constexpr size_t WS_ORAW = 1394 * MiB;
constexpr size_t WS_OM = 1522 * MiB, WS_OD = 1586 * MiB;
constexpr size_t WS_GATES = 864 * MiB;
constexpr size_t WS_T1 = 1166 * MiB;
constexpr size_t WS_MERGED = 1294 * MiB;
constexpr size_t WS_END = 1650 * MiB;
static_assert(WS_W1GU + (size_t)2 * DFF * DM * 2 <= WS_W1D && WS_W1D + (size_t)DM * LDH * 2 <= WS_W2GU && WS_W2GU + (size_t)2 * DFF * DM * 2 <= WS_W2D && WS_W2D + (size_t)DM * LDH * 2 <= WS_WIN, "ws map 1");
static_assert(WS_WIN + (size_t)INWP * DM * 2 <= WS_WG && WS_WG + (size_t)2 * DM * DM * 2 <= WS_WUQ && WS_WUQ + (size_t)3072 * 1024 * 2 <= WS_WUKV && WS_WUKV + (size_t)4096 * 512 * 2 <= WS_WBD, "ws map 2");
static_assert(WS_WBD + (size_t)DM * 2048 * 2 <= WS_WBM && WS_WBM + (size_t)DM * 2048 * 2 <= WS_WO && WS_WO + (size_t)DM * DM * 2 <= WS_XN && WS_XN + (size_t)MP * DM * 2 <= WS_H, "ws map 3");
static_assert(WS_H + (size_t)MP * LDH * 2 <= WS_END && WS_P + (size_t)MP * INWP * 2 <= WS_CQN && WS_CQN + (size_t)MP * 1024 * 2 <= WS_CKVN && WS_CKVN + (size_t)MP * 512 * 2 <= WS_QM, "ws map 4");
static_assert(WS_QM + (size_t)MP * 3072 * 2 <= WS_KV && WS_KV + (size_t)MP * 4096 * 2 <= WS_ORAW && WS_ORAW + (size_t)MR * 4096 * 2 <= WS_OM && WS_OM + (size_t)MR * 2048 * 2 <= WS_OD && WS_OD + (size_t)MR * 2048 * 2 <= WS_END, "ws map 5");
static_assert(WS_GATES + (size_t)MR * 2 * DM * 2 <= WS_QM && WS_T1 + (size_t)MR * DM * 2 <= WS_MERGED && WS_MERGED + (size_t)MR * DM * 2 <= WS_OM, "ws map 6");
static_assert(WS_ROPE + (size_t)(SEQ + NMETA) * 32 * 8 <= WS_SLAB && WS_SLAB + (size_t)16 * NMETA * DM * 4 <= WS_PART && WS_PART + (size_t)MP * 64 * 4 <= WS_W1GU, "ws map 7");
constexpr int CW_BAR = 4096;
constexpr int CW_SSQ1 = 65536, CW_SSQ2 = 98304, CW_SSQ3 = 131072;
constexpr int CW_QMAX = 163840, CW_KMAX = CW_QMAX + BATCH * 16 * 16, CW_KMETA = CW_KMAX + BATCH * 16;
static_assert((size_t)(CW_KMETA + 16) * 4 <= CTL_ZERO_BYTES, "CTL map 2");
static_assert(CW_BAR + 16 * 3456 <= CW_SSQ1 && CW_SSQ1 + MP <= CW_SSQ2 && CW_SSQ2 + MP <= CW_SSQ3 && (size_t)(CW_SSQ3 + MP) * 4 <= CTL_ZERO_BYTES, "CTL map");

constexpr int RING_OFF = 0, RING_BYTES = 161792;
constexpr int LDSCTL_OFF = RING_BYTES, MISC_OFF = LDSCTL_OFF + 320;
constexpr int LDS_BYTES = 162816;
static_assert(att::SHMB_TOTAL <= RING_BYTES && att::shm_total<128>() <= RING_BYTES && att::shm_total<192>() <= RING_BYTES && pg8::STAGE_BYTES <= RING_BYTES && LDS_BYTES <= 163840, "LDS map");
static_assert(MISC_OFF + 128 <= LDS_BYTES, "LDS map");

#define GAS __attribute__((address_space(1)))
#define LAS __attribute__((address_space(3)))
typedef unsigned short bf16;
typedef unsigned v4u __attribute__((ext_vector_type(4)));
typedef unsigned v2u __attribute__((ext_vector_type(2)));
typedef float f32x4 __attribute__((ext_vector_type(4)));
typedef GAS unsigned gu32;
#define RLX_AGENT __ATOMIC_RELAXED, __HIP_MEMORY_SCOPE_AGENT
#define LDS_WAIT() asm volatile("s_waitcnt lgkmcnt(0)" ::: "memory")
#define VM_WAIT() asm volatile("s_waitcnt vmcnt(0)" ::: "memory")
__device__ __forceinline__ unsigned f2bf(float f) { unsigned u = __builtin_bit_cast(unsigned, f); return (u + 0x7fffu + ((u >> 16) & 1u)) >> 16; }
__device__ __forceinline__ unsigned pk2(float lo, float hi) { return f2bf(lo) | (f2bf(hi) << 16); }
__device__ __forceinline__ float bflo(unsigned w) { return __uint_as_float(w << 16); }
__device__ __forceinline__ float bfhi(unsigned w) { return __uint_as_float(w & 0xffff0000u); }
__device__ __forceinline__ float wave_sum(float v) {
#pragma unroll
    for (int o = 1; o < 64; o <<= 1) v += __shfl_xor(v, o);
    return v;
}

#define XB_TMO      128
#define XB_XCNT(j)  (256  + 64 * (j))
#define XB_XSUB(j)  (1280 + 64 * (j))
#define XB_XGEN(j)  (2304 + 64 * (j))
#define XB_TOP      3328
#define XB_TOPGEN   3392
#define XCD_BAR_WORDS 3456
#define XB_SPIN_CAP (1u << 18)

__device__ __forceinline__ unsigned xb_ld(unsigned* p)              { return __hip_atomic_load(p, __ATOMIC_RELAXED, __HIP_MEMORY_SCOPE_AGENT); }
__device__ __forceinline__ unsigned xb_add(unsigned* p, unsigned v) { return __hip_atomic_fetch_add(p, v, __ATOMIC_RELAXED, __HIP_MEMORY_SCOPE_AGENT); }
__device__ __forceinline__ unsigned xb_xcc_id() { return (unsigned)__builtin_amdgcn_s_getreg((3 << 11) | 20) & 0xFu; }
#define XB_SPIN(cond, bar) do { unsigned _sp = 0; while (cond) { __builtin_amdgcn_s_sleep(1); \
    if ((++_sp & 255u) == 0u) { if (xb_ld(&(bar)[XB_TMO])) break; if (_sp > XB_SPIN_CAP) { atomicAdd(&(bar)[XB_TMO], 1u); break; } } } } while (0)

struct XcdBarrier {
    unsigned* bar; unsigned x;
    volatile LAS unsigned* st;
};

__device__ __forceinline__ XcdBarrier xcd_barrier_post(unsigned* bar, volatile LAS unsigned* st) {
    XcdBarrier b; b.bar = bar; b.x = xb_xcc_id(); b.st = st;
    if (threadIdx.x == 0) (void)xb_add(&bar[XB_XCNT(b.x)], 1u);
    return b;
}
__device__ __forceinline__ void xcd_barrier_complete(unsigned* bar, unsigned x, unsigned& nloc, unsigned& nx) {
    const unsigned G = gridDim.x * gridDim.y * gridDim.z;
    unsigned sum, cnt, mine, sp = 0u;
    for (;;) {
        sum = 0u; cnt = 0u; mine = 0u;
#pragma unroll
        for (unsigned j = 0; j < 16; ++j) { const unsigned c = xb_ld(&bar[XB_XCNT(j)]); sum += c; cnt += (c > 0u) ? 1u : 0u; mine = (j == x) ? c : mine; }
        if (sum == G) break;
        __builtin_amdgcn_s_sleep(1);
        if ((++sp & 255u) == 0u) { if (xb_ld(&bar[XB_TMO])) break; if (sp > XB_SPIN_CAP) { atomicAdd(&bar[XB_TMO], 1u); break; } }
    }
    nloc = mine > 0u ? mine : 1u; nx = cnt > 0u ? cnt : 1u;
}

__device__ __forceinline__ void xcd_barrier(const XcdBarrier& b) {
    asm volatile("s_waitcnt vmcnt(0)" ::: "memory");
    __syncthreads();
    if (threadIdx.x == 0) {
        unsigned* bar = b.bar;
        __builtin_amdgcn_s_waitcnt(0);
        unsigned nloc = b.st[0], nx = b.st[1];
        if (nloc == 0u) { xcd_barrier_complete(bar, b.x, nloc, nx); b.st[0] = nloc; b.st[1] = nx; }
        const unsigned old = xb_add(&bar[XB_XSUB(b.x)], 1u);
        const unsigned gen = old / nloc;
        if (old + 1u == (gen + 1u) * nloc) {
            __builtin_amdgcn_fence(__ATOMIC_RELEASE, "agent");
            asm volatile("s_waitcnt vmcnt(0)" ::: "memory");
            const unsigned og = xb_add(&bar[XB_TOP], 1u);
            const unsigned tg = og / nx;
            if (og + 1u == (tg + 1u) * nx) xb_add(&bar[XB_TOPGEN], 1u);
            else XB_SPIN(xb_ld(&bar[XB_TOPGEN]) == tg, bar);
            __builtin_amdgcn_fence(__ATOMIC_ACQUIRE, "agent");
            xb_add(&bar[XB_XGEN(b.x)], 1u);
            asm volatile("s_waitcnt vmcnt(0)" ::: "memory");
        } else {
            XB_SPIN(xb_ld(&bar[XB_XGEN(b.x)]) == gen, bar);
            __builtin_amdgcn_fence(__ATOMIC_ACQUIRE, "agent");
            asm volatile("s_waitcnt vmcnt(0)" ::: "memory");
        }
    }
    __syncthreads();
}

template <int MAP> __device__ __forceinline__ int map_row(int n) {
    if (MAP == 1) return 256 * (n >> 7) + (n & 127);
    if (MAP == 2) return 256 * (n >> 7) + 128 + (n & 127);
    if (MAP == 3) { if (n < PC_KR) return n; const int j = n - PC_KR; return PC_KR + (j < 32 ? 2 * j : 2 * (j - 32) + 1); }
    if (MAP == 4) { const int h = n / 192, d = n % 192; if (d < 128) return n; const int j = d - 128; return h * 192 + 128 + (j < 32 ? 2 * j : 2 * (j - 32) + 1); }
    return n;
}
template <int MAP> __device__ __forceinline__ void p0_transpose_item(const float* W, int K, int N, bf16* WT, LAS float* scr, int item, int lane, const float* gain = nullptr, int ldw = 0) {
    const int nblk = N / 32, kb = item / nblk, nb = item % nblk, k0 = 64 * kb, n0 = 32 * nb;
    float wv[32];
#pragma unroll
    for (int i = 0; i < 32; ++i) { const int kk = 2 * i + (lane >> 5); wv[i] = __builtin_nontemporal_load(W + (size_t)(k0 + kk) * N + n0 + (lane & 31)); }
#pragma unroll
    for (int i = 0; i < 32; ++i) { const int kk = 2 * i + (lane >> 5); scr[kk * 33 + (lane & 31)] = wv[i]; }
    LDS_WAIT(); asm volatile("" ::: "memory");
    const int c = lane & 7;
    f32x4 g0 = (f32x4){1.f, 1.f, 1.f, 1.f}, g1 = g0;
    if (gain) { g0 = *(const GAS f32x4*)(gain + k0 + 8 * c); g1 = *(const GAS f32x4*)(gain + k0 + 8 * c + 4); }
#pragma unroll
    for (int j = 0; j < 4; ++j) { const int n = (lane >> 3) + 8 * j; const LAS float* s = scr + (8 * c) * 33 + n;
        v4u o; o.x = pk2(s[0 * 33] * g0.x, s[1 * 33] * g0.y); o.y = pk2(s[2 * 33] * g0.z, s[3 * 33] * g0.w); o.z = pk2(s[4 * 33] * g1.x, s[5 * 33] * g1.y); o.w = pk2(s[6 * 33] * g1.z, s[7 * 33] * g1.w);
        const int nr = map_row<MAP>(n0 + n);
        if (ldw >= 0) *(GAS v4u*)(WT + (size_t)nr * (ldw ? ldw : K) + k0 + 8 * c) = o;
        else *(GAS v4u*)(WT + (((size_t)(nr >> 8) * (K / 64) + (k0 >> 6)) * 256 + (nr & 255)) * 64 + 8 * c) = o; }
    LDS_WAIT(); asm volatile("" ::: "memory");
}
struct CvtDesc { const float* W; bf16* WT; const float* gain; int K, N, ldw, map, r; };
__device__ __forceinline__ int map_row_rt(int map, int n) {
    if (map == 1) return map_row<1>(n); if (map == 2) return map_row<2>(n); if (map == 3) return map_row<3>(n); if (map == 4) return map_row<4>(n); return n; }
#ifndef CVT_WIDE
#define CVT_WIDE 0
#endif
#if CVT_WIDE
__device__ __forceinline__ void cvt_load(const CvtDesc& d, float (&wv)[32], int lane) {
    const int nblk = d.N / 64, kb = d.r / nblk, nb = d.r % nblk; const float* src = d.W + (size_t)(32 * kb) * d.N + 64 * nb + lane;
#pragma unroll
    for (int i = 0; i < 32; ++i) wv[i] = __builtin_nontemporal_load(src + (size_t)i * d.N);
}
__device__ __forceinline__ void cvt_finish(const CvtDesc& d, const float (&wv)[32], LAS float* scr, int lane) {
    const int nblk = d.N / 64, kb = d.r / nblk, nb = d.r % nblk, k0 = 32 * kb, n0 = 64 * nb;
#pragma unroll
    for (int i = 0; i < 32; ++i) scr[i * 65 + lane] = wv[i];
    LDS_WAIT(); asm volatile("" ::: "memory");
    const int c = lane & 3;
    f32x4 g0 = (f32x4){1.f, 1.f, 1.f, 1.f}, g1 = g0;
    if (d.gain) { g0 = *(const GAS f32x4*)(d.gain + k0 + 8 * c); g1 = *(const GAS f32x4*)(d.gain + k0 + 8 * c + 4); }
#pragma unroll
    for (int j = 0; j < 4; ++j) { const int n = (lane >> 2) + 16 * j; const LAS float* s = scr + (8 * c) * 65 + n;
        v4u o; o.x = pk2(s[0 * 65] * g0.x, s[1 * 65] * g0.y); o.y = pk2(s[2 * 65] * g0.z, s[3 * 65] * g0.w); o.z = pk2(s[4 * 65] * g1.x, s[5 * 65] * g1.y); o.w = pk2(s[6 * 65] * g1.z, s[7 * 65] * g1.w);
        const int nr = map_row_rt(d.map, n0 + n);
        if (d.ldw >= 0) *(GAS v4u*)(d.WT + (size_t)nr * (d.ldw ? d.ldw : d.K) + k0 + 8 * c) = o;
        else *(GAS v4u*)(d.WT + (((size_t)(nr >> 8) * (d.K / 64) + (k0 >> 6)) * 256 + (nr & 255)) * 64 + (k0 & 63) + 8 * c) = o; }
    LDS_WAIT(); asm volatile("" ::: "memory");
}
#else
__device__ __forceinline__ void cvt_load(const CvtDesc& d, float (&wv)[32], int lane) {
    const int nblk = d.N / 32, kb = d.r / nblk, nb = d.r % nblk; const float* src = d.W + (size_t)(64 * kb + (lane >> 5)) * d.N + 32 * nb + (lane & 31);
#pragma unroll
    for (int i = 0; i < 32; ++i) wv[i] = __builtin_nontemporal_load(src + (size_t)(2 * i) * d.N);
}
__device__ __forceinline__ void cvt_finish(const CvtDesc& d, const float (&wv)[32], LAS float* scr, int lane) {
    const int nblk = d.N / 32, kb = d.r / nblk, nb = d.r % nblk, k0 = 64 * kb, n0 = 32 * nb;
#pragma unroll
    for (int i = 0; i < 32; ++i) { const int kk = 2 * i + (lane >> 5); scr[kk * 33 + (lane & 31)] = wv[i]; }
    LDS_WAIT(); asm volatile("" ::: "memory");
    const int c = lane & 7;
    f32x4 g0 = (f32x4){1.f, 1.f, 1.f, 1.f}, g1 = g0;
    if (d.gain) { g0 = *(const GAS f32x4*)(d.gain + k0 + 8 * c); g1 = *(const GAS f32x4*)(d.gain + k0 + 8 * c + 4); }
#pragma unroll
    for (int j = 0; j < 4; ++j) { const int n = (lane >> 3) + 8 * j; const LAS float* s = scr + (8 * c) * 33 + n;
        v4u o; o.x = pk2(s[0 * 33] * g0.x, s[1 * 33] * g0.y); o.y = pk2(s[2 * 33] * g0.z, s[3 * 33] * g0.w); o.z = pk2(s[4 * 33] * g1.x, s[5 * 33] * g1.y); o.w = pk2(s[6 * 33] * g1.z, s[7 * 33] * g1.w);
        const int nr = map_row_rt(d.map, n0 + n);
        if (probe_mode() & 256) asm volatile("" :: "v"(o)); else
        if (d.ldw >= 0) *(GAS v4u*)(d.WT + (size_t)nr * (d.ldw ? d.ldw : d.K) + k0 + 8 * c) = o;
        else *(GAS v4u*)(d.WT + (((size_t)(nr >> 8) * (d.K / 64) + (k0 >> 6)) * 256 + (nr & 255)) * 64 + 8 * c) = o; }
    LDS_WAIT(); asm volatile("" ::: "memory");
}
#endif
__device__ __forceinline__ void rms_row_to_bf16(const float* xrow, const float* g, bf16* orow, int lane) {
    const GAS f32x4* xr = (const GAS f32x4*)xrow + lane; const GAS f32x4* gr = (const GAS f32x4*)g + lane;
    f32x4 v[16]; float s = 0.f;
#pragma unroll
    for (int j = 0; j < 16; ++j) { v[j] = xr[64 * j]; s += (v[j].x * v[j].x + v[j].y * v[j].y) + (v[j].z * v[j].z + v[j].w * v[j].w); }
    const float rstd = 1.f / sqrtf(wave_sum(s) * (1.f / DM) + EPS);
    GAS v2u* o8 = (GAS v2u*)orow + lane;
#pragma unroll
    for (int j = 0; j < 16; ++j) { const f32x4 gg = gr[64 * j]; v2u w; w.x = pk2(v[j].x * rstd * gg.x, v[j].y * rstd * gg.y); w.y = pk2(v[j].z * rstd * gg.z, v[j].w * rstd * gg.w); o8[64 * j] = w; }
}
__device__ __forceinline__ void zero_row_bf16(bf16* orow, int nelem, int lane) {
    GAS v4u* o = (GAS v4u*)orow + lane;
    for (int j = 0; j < nelem / 512; ++j) o[64 * j] = (v4u){0u, 0u, 0u, 0u};
}
__device__ __forceinline__ void rms_row_inplace(float* xrow, const float* g, int lane) {
    GAS f32x4* xr = (GAS f32x4*)xrow + lane; const GAS f32x4* gr = (const GAS f32x4*)g + lane;
    f32x4 v[16]; float s = 0.f;
#pragma unroll
    for (int j = 0; j < 16; ++j) { v[j] = xr[64 * j]; s += (v[j].x * v[j].x + v[j].y * v[j].y) + (v[j].z * v[j].z + v[j].w * v[j].w); }
    const float rstd = 1.f / sqrtf(wave_sum(s) * (1.f / DM) + EPS);
#pragma unroll
    for (int j = 0; j < 16; ++j) { const f32x4 gg = gr[64 * j]; xr[64 * j] = v[j] * rstd * gg; }
}

struct Args { const float* in[27]; float* out; unsigned char* ws; int ph_lo, ph_hi, att_mask, pad; };
static_assert(sizeof(Args) == 27 * 8 + 8 + 8 + 16, "Args has no padding");
enum { I_X = 0, I_META, I_N1, I_W1G, I_W1U, I_W1D, I_NMIX, I_WIN, I_LQ1, I_LK1, I_LQ2, I_LK2, I_SUBLN, I_QNORM, I_WUQ, I_KVNORM, I_WUKV, I_WG, I_BG, I_WBD, I_WBM, I_WO, I_N2, I_W2G, I_W2U, I_W2D, I_NF };

__global__ void __launch_bounds__(NWAVES * 64, 2) fwd(Args  ) {
    extern __shared__ __attribute__((aligned(16))) unsigned char lds[];
    LAS unsigned char* const L = (LAS unsigned char*)lds;
    volatile LAS unsigned* const MISC = (volatile LAS unsigned*)(L + MISC_OFF);
    const int tid = threadIdx.x;
typedef const __attribute__((address_space(4))) Args* CArgsP;
#define KARGS() ({ CArgsP p_ = (CArgsP)__builtin_amdgcn_kernarg_segment_ptr(); asm volatile("" : "+s"(p_)); p_; })
    int lo, hi; { CArgsP A0 = KARGS(); lo = A0->ph_lo; hi = A0->ph_hi; }
    for (int u = tid; u < (LDS_BYTES - LDSCTL_OFF) / 4; u += NWAVES * 64) ((LAS unsigned*)(L + LDSCTL_OFF))[u] = 0u;
    __syncthreads();
    (void)xcd_barrier_post((unsigned*)(KARGS()->ws + WS_CTL) + CW_BAR + lo * XCD_BAR_WORDS, MISC + 8);
#define GRID_BAR() do { XcdBarrier b_; b_.bar = (unsigned*)(KARGS()->ws + WS_CTL) + CW_BAR + lo * XCD_BAR_WORDS; b_.x = xb_xcc_id(); b_.st = MISC + 8; xcd_barrier(b_); } while (0)
#ifndef PH_MASK
#define PH_MASK 0xFFFF
#endif
#define IN(k) ((((PH_MASK) >> (k)) & 1) && lo <= (k) && (k) < hi)
#define BOTH(k) (IN(k) && IN((k) + 1))
#define PHASE_PTRS() const int tidp_ = threadIdx.x, lane = tidp_ & 63, wave = __builtin_amdgcn_readfirstlane(tidp_ >> 6); (void)lane; (void)wave; \
    const int G = gridDim.x, bx = blockIdx.x, vcu = (G % 8 == 0) ? (bx % 8) * (G / 8) + bx / 8 : bx, gw = vcu * NWAVES + wave, NGW = G * NWAVES; (void)gw; (void)NGW; (void)vcu;     \
    CArgsP const A = KARGS(); unsigned char* const ws = A->ws; float* const out = A->out; (void)out; gu32* const ctl = (gu32*)(ws + WS_CTL); (void)ctl; \
    bf16* const XN = (bf16*)(ws + WS_XN); bf16* const HB = (bf16*)(ws + WS_H); bf16* const PB = (bf16*)(ws + WS_P); (void)XN; (void)HB; (void)PB; \
    bf16* const CQN = (bf16*)(ws + WS_CQN); bf16* const CKVN = (bf16*)(ws + WS_CKVN); bf16* const QM = (bf16*)(ws + WS_QM); bf16* const KV = (bf16*)(ws + WS_KV); (void)CQN; (void)CKVN; (void)QM; (void)KV; \
    bf16* const ORAW = (bf16*)(ws + WS_ORAW); bf16* const OM = (bf16*)(ws + WS_OM); bf16* const OD = (bf16*)(ws + WS_OD); (void)ORAW; (void)OM; (void)OD; \
    bf16* const GATES = (bf16*)(ws + WS_GATES); bf16* const T1 = (bf16*)(ws + WS_T1); bf16* const MERGED = (bf16*)(ws + WS_MERGED); (void)GATES; (void)T1; (void)MERGED; \
    float* const SLAB = (float*)(ws + WS_SLAB); float* const PART = (float*)(ws + WS_PART); float* const ROPE = (float*)(ws + WS_ROPE); (void)SLAB; (void)PART; (void)ROPE
    typedef pg8::bf16_t pbf;
#define GEMM_PHASE(EPI_T, Aptr, Btptr, Mr, Nr, Kr, LDA, LDB, EPI) GEMM_PHASE_S(EPI_T, Aptr, Btptr, Mr, Nr, Kr, LDA, LDB, EPI, 0, 8)
#define GEMM_PHASE_BLK(EPI_T, Aptr, Btptr, Mr, Nr, Kr, EPI, NSPLIT, WGM_) do { pg8::Gemm g_{(const pbf*)(Aptr), (const pbf*)(Btptr), (Mr), (Nr), (Kr), 64, 64, 1}; \
        pg8::StaticOrder S_; S_.init((Mr), (Nr), (Kr), G, bx, (NSPLIT), (WGM_)); pg8::gemm_phase<EPI_T, pg8::StaticOrder, PG8_ALIGNV, PG8_SP2V>(L + RING_OFF, g_, S_, EPI); } while (0)
#ifndef NCONV
#define NCONV 0
#endif
#ifndef PG8_ALIGNV
#define PG8_ALIGNV true
#endif
#ifndef PG8_SP2V
#define PG8_SP2V true
#endif
#ifndef WGM_DOWN
#define WGM_DOWN 2
#endif
#ifndef STAGGER_TICKS
#define STAGGER_TICKS 0
#endif
#define STAGGER() do { if (STAGGER_TICKS > 0) { const unsigned long long te_ = __builtin_amdgcn_s_memrealtime() + (unsigned long long)(((bx >> 7) & 1) * (STAGGER_TICKS)); while (__builtin_amdgcn_s_memrealtime() < te_) __builtin_amdgcn_s_sleep(16); } } while (0)
#define GEMM_PHASE_S(EPI_T, Aptr, Btptr, Mr, Nr, Kr, LDA, LDB, EPI, NSPLIT, WGM_) do { pg8::Gemm g_{(const pbf*)(Aptr), (const pbf*)(Btptr), (Mr), (Nr), (Kr), (LDA), (LDB), 0}; \
        pg8::StaticOrder S_; S_.init((Mr), (Nr), (Kr), G, bx, (NSPLIT), (WGM_)); pg8::gemm_phase<EPI_T, pg8::StaticOrder, PG8_ALIGNV, PG8_SP2V>(L + RING_OFF, g_, S_, EPI); } while (0)

    constexpr int IT_FG = (DM / 64) * (DFF / 32), IT_FD = (DFF / 64) * (DM / 32), IT_WIN = (DM / 64) * (INW / 32), IT_WG = (DM / 64) * (2 * DM / 32),
                  IT_UQ = (1024 / 64) * (3072 / 32), IT_UKV = (512 / 64) * (4096 / 32), IT_BR = (2048 / 64) * (DM / 32), IT_WO = (DM / 64) * (DM / 32);
    constexpr int NITEMS = 4 * IT_FG + 2 * IT_FD + IT_WIN + IT_WG + IT_UQ + IT_UKV + 2 * IT_BR + IT_WO, NEARLY = 2 * IT_FG;
    if (IN(0)) { PHASE_PTRS();
        LAS float* scr = (LAS float*)(L + RING_OFF + wave * 16384);
#define CVT_DECODE(d_, it_) do { int r = (it_); \
            if (r < IT_FG) { d_ = CvtDesc{A->in[I_W1G], (bf16*)(ws + WS_W1GU), nullptr, DM, DFF, 0, 1, r}; break; } r -= IT_FG; \
            if (r < IT_FG) { d_ = CvtDesc{A->in[I_W1U], (bf16*)(ws + WS_W1GU), nullptr, DM, DFF, 0, 2, r}; break; } r -= IT_FG; \
            if (r < IT_FD) { d_ = CvtDesc{A->in[I_W1D], (bf16*)(ws + WS_W1D), nullptr, DFF, DM, -1, 0, r}; break; } r -= IT_FD; \
            if (r < IT_WIN) { d_ = CvtDesc{A->in[I_WIN], (bf16*)(ws + WS_WIN), A->in[I_NMIX], DM, INW, 0, 3, r}; break; } r -= IT_WIN; \
            if (r < IT_WG) { d_ = CvtDesc{A->in[I_WG], (bf16*)(ws + WS_WG), A->in[I_NMIX], DM, 2 * DM, 0, 0, r}; break; } r -= IT_WG; \
            if (r < IT_UQ) { d_ = CvtDesc{A->in[I_WUQ], (bf16*)(ws + WS_WUQ), nullptr, 1024, 3072, 0, 4, r}; break; } r -= IT_UQ; \
            if (r < IT_UKV) { d_ = CvtDesc{A->in[I_WUKV], (bf16*)(ws + WS_WUKV), nullptr, 512, 4096, 0, 0, r}; break; } r -= IT_UKV; \
            if (r < IT_BR) { d_ = CvtDesc{A->in[I_WBD], (bf16*)(ws + WS_WBD), nullptr, 2048, DM, 0, 0, r}; break; } r -= IT_BR; \
            if (r < IT_BR) { d_ = CvtDesc{A->in[I_WBM], (bf16*)(ws + WS_WBM), nullptr, 2048, DM, 0, 0, r}; break; } r -= IT_BR; \
            if (r < IT_WO) { d_ = CvtDesc{A->in[I_WO], (bf16*)(ws + WS_WO), nullptr, DM, DM, 0, 0, r}; break; } r -= IT_WO; \
            if (r < IT_FG) { d_ = CvtDesc{A->in[I_W2G], (bf16*)(ws + WS_W2GU), A->in[I_N2], DM, DFF, 0, 1, r}; break; } r -= IT_FG; \
            if (r < IT_FG) { d_ = CvtDesc{A->in[I_W2U], (bf16*)(ws + WS_W2GU), A->in[I_N2], DM, DFF, 0, 2, r}; break; } r -= IT_FG; \
            d_ = CvtDesc{A->in[I_W2D], (bf16*)(ws + WS_W2D), nullptr, DFF, DM, -1, 0, r}; } while (0)
#define CVT_RUN(first_, last_, stride_) do { int it_ = (first_); if (it_ < (last_)) { CvtDesc dA, dB; float wA[32], wB[32]; CVT_DECODE(dA, it_); cvt_load(dA, wA, lane); \
            for (;;) { const int i1_ = it_ + (stride_); const bool h1_ = i1_ < (last_); if (h1_) { CVT_DECODE(dB, i1_); cvt_load(dB, wB, lane); } cvt_finish(dA, wA, scr, lane); if (!h1_) break; \
                       const int i2_ = i1_ + (stride_); const bool h2_ = i2_ < (last_); if (h2_) { CVT_DECODE(dA, i2_); cvt_load(dA, wA, lane); } cvt_finish(dB, wB, scr, lane); if (!h2_) break; it_ = i2_; } } } while (0)
        if (!(probe_mode() & 1024)) CVT_RUN(gw, (NCONV > 0 ? NEARLY : NITEMS), NGW);
        for (int m = gw; m < INWP - INW; m += NGW) zero_row_bf16((bf16*)(ws + WS_WIN) + (size_t)(INW + m) * DM, DM, lane);
        if (!(probe_mode() & 512)) {
            f32x4 gv[16];
#pragma unroll
            for (int j = 0; j < 16; ++j) gv[j] = ((const GAS f32x4*)A->in[I_N1] + lane)[64 * j];
            for (int m = gw; m < MR; m += 2 * NGW) { const int m2 = m + NGW; const bool has2 = m2 < MR;
                const GAS f32x4* x0 = (const GAS f32x4*)(A->in[I_X] + (size_t)m * DM) + lane; const GAS f32x4* x1 = (const GAS f32x4*)(A->in[I_X] + (size_t)(has2 ? m2 : m) * DM) + lane;
                f32x4 v0[16], v1[16]; float s0 = 0.f, s1 = 0.f;
#pragma unroll
                for (int j = 0; j < 16; ++j) v0[j] = __builtin_nontemporal_load(x0 + 64 * j);
#pragma unroll
                for (int j = 0; j < 16; ++j) v1[j] = __builtin_nontemporal_load(x1 + 64 * j);
#pragma unroll
                for (int j = 0; j < 16; ++j) { s0 += (v0[j].x * v0[j].x + v0[j].y * v0[j].y) + (v0[j].z * v0[j].z + v0[j].w * v0[j].w); s1 += (v1[j].x * v1[j].x + v1[j].y * v1[j].y) + (v1[j].z * v1[j].z + v1[j].w * v1[j].w); }
                const float r0 = 1.f / sqrtf(wave_sum(s0) * (1.f / DM) + EPS), r1 = 1.f / sqrtf(wave_sum(s1) * (1.f / DM) + EPS);
                GAS v2u* o0 = (GAS v2u*)(XN + (size_t)m * DM) + lane; GAS v2u* o1 = (GAS v2u*)(XN + (size_t)m2 * DM) + lane;
#pragma unroll
                for (int j = 0; j < 16; ++j) { v2u w; w.x = pk2(v0[j].x * r0 * gv[j].x, v0[j].y * r0 * gv[j].y); w.y = pk2(v0[j].z * r0 * gv[j].z, v0[j].w * r0 * gv[j].w); o0[64 * j] = w; }
                if (has2) {
#pragma unroll
                    for (int j = 0; j < 16; ++j) { v2u w; w.x = pk2(v1[j].x * r1 * gv[j].x, v1[j].y * r1 * gv[j].y); w.y = pk2(v1[j].z * r1 * gv[j].z, v1[j].w * r1 * gv[j].w); o1[64 * j] = w; } }
            }
            for (int m = MR + gw; m < MP; m += NGW) {
                if (m < MR + NMETA) rms_row_to_bf16(A->in[I_META] + (size_t)(m - MR) * DM, A->in[I_N1], XN + (size_t)m * DM, lane);
                else zero_row_bf16(XN + (size_t)m * DM, DM, lane);
            }
        }
        {
            static constexpr double INVF[32] = {1.0, 0.7498942093324559, 0.5623413251903491, 0.4216965034285822, 0.31622776601683794, 0.23713737056616552, 0.1778279410038923, 0.1333521432163324,
                0.1, 0.07498942093324558, 0.05623413251903491, 0.042169650342858224, 0.03162277660168379, 0.023713737056616554, 0.01778279410038923, 0.01333521432163324,
                0.01, 0.007498942093324558, 0.005623413251903491, 0.004216965034285823, 0.0031622776601683794, 0.0023713737056616554, 0.0017782794100389228, 0.001333521432163324,
                0.001, 0.0007498942093324559, 0.0005623413251903491, 0.00042169650342858224, 0.00031622776601683794, 0.00023713737056616554, 0.00017782794100389227, 0.0001333521432163324};
            for (int idx = (vcu * NWAVES + wave) * 64 + lane; idx < (SEQ + NMETA) * 32; idx += NGW * 64) {
                const int pos = idx >> 5, i = idx & 31; double rev = (double)pos * INVF[i] * 0.15915494309189535; rev -= __builtin_floor(rev);
                const float fr = (float)rev; ROPE[2 * idx] = __builtin_amdgcn_cosf(fr); ROPE[2 * idx + 1] = __builtin_amdgcn_sinf(fr);
            }
        }
        if (BOTH(0)) GRID_BAR();
    }

    if (IN(1)) { PHASE_PTRS();
        if (NCONV > 0 && G > 2 * NCONV && bx >= G - NCONV) {
            LAS float* scr = (LAS float*)(L + RING_OFF + wave * 16384);
            CVT_RUN(NEARLY + (bx - (G - NCONV)) * NWAVES + wave, NITEMS, NCONV * NWAVES);
        } else {
            const int Gg = (NCONV > 0 && G > 2 * NCONV) ? G - NCONV : G;
            pg8::EpiSwiglu E{(pbf*)HB, 0, nullptr}; pg8::Gemm g_{(const pbf*)XN, (const pbf*)(ws + WS_W1GU), MP, 2 * DFF, DM, DM, DM, 0};
            pg8::StaticOrder S_; S_.init(MP, 2 * DFF, DM, Gg, bx, 0, 8); pg8::gemm_phase<pg8::EpiSwiglu, pg8::StaticOrder, PG8_ALIGNV, PG8_SP2V>(L + RING_OFF, g_, S_, E);
        }
        if (BOTH(1)) GRID_BAR(); }
#undef CVT_RUN
#undef CVT_DECODE
    if (IN(2)) { PHASE_PTRS(); pg8::EpiResid E{A->in[I_X], out, SLAB, (pbf*)XN, PART, 0.5f}; STAGGER(); GEMM_PHASE_BLK(pg8::EpiResid, HB, ws + WS_W1D, MR, DM, DFF, E, 16, WGM_DOWN); if (BOTH(2)) GRID_BAR(); }
    if (IN(3)) { PHASE_PTRS(); float* const ssq = (float*)(ctl + CW_SSQ1);
        for (int m = gw; m < MR; m += NGW) { const float q = wave_sum(PART[(size_t)m * 64 + lane]); if (lane == 0) ssq[m] = q; }
        if (gw >= NGW - NMETA) { const int r = gw - (NGW - NMETA); const GAS f32x4* xr = (const GAS f32x4*)(A->in[I_META] + (size_t)r * DM) + lane; GAS v2u* o8 = (GAS v2u*)(XN + (size_t)(MR + r) * DM) + lane; float q = 0.f;
            for (int j = 0; j < 16; ++j) { f32x4 v = xr[64 * j];
                for (int sp = 0; sp < 16; ++sp) v = v + ((const GAS f32x4*)(SLAB + ((size_t)sp * NMETA + r) * DM) + lane)[64 * j];
                q += (v.x * v.x + v.y * v.y) + (v.z * v.z + v.w * v.w); v2u w; w.x = pk2(v.x, v.y); w.y = pk2(v.z, v.w); o8[64 * j] = w; }
            q = wave_sum(q); if (lane == 0) ssq[MR + r] = q; }
        if (BOTH(3)) GRID_BAR();
    }
    if (IN(4)) { PHASE_PTRS(); pg8::EpiB<pg8::MB_WIN> E{(pbf*)PB, INWP, nullptr, nullptr, nullptr, ROPE, (const float*)(ctl + CW_SSQ1)}; GEMM_PHASE(pg8::EpiB<pg8::MB_WIN>, XN, ws + WS_WIN, MP, INWP, DM, DM, DM, E); if (BOTH(4)) GRID_BAR(); }
    if (IN(5)) { PHASE_PTRS();
        for (int w = gw; w < MR / 8 + 256; w += NGW) {
        float qmx[4] = {0.f, 0.f, 0.f, 0.f}, kmx[4] = {0.f, 0.f, 0.f, 0.f};
        const bool meta = w >= MR / 8; const int nrows = meta ? 1 : 8;
        for (int it = 0; it < nrows; ++it) {
            const int m = meta ? MR + (w - MR / 8) : w * 8 + it;
            const bf16* prow = PB + (size_t)m * INWP;
            {   const v4u a = *(const GAS v4u*)(prow + PC_CQ + 8 * lane), b = *(const GAS v4u*)(prow + PC_CQ + 512 + 8 * lane);
                float x[16] = {bflo(a.x), bfhi(a.x), bflo(a.y), bfhi(a.y), bflo(a.z), bfhi(a.z), bflo(a.w), bfhi(a.w), bflo(b.x), bfhi(b.x), bflo(b.y), bfhi(b.y), bflo(b.z), bfhi(b.z), bflo(b.w), bfhi(b.w)};
                float s = 0.f;
#pragma unroll
                for (int j = 0; j < 16; ++j) s += x[j] * x[j];
                const float rstd = 1.f / sqrtf(wave_sum(s) * (1.f / 1024.f) + EPS);
                const float* g = A->in[I_QNORM];
#pragma unroll
                for (int hseg = 0; hseg < 2; ++hseg) { const f32x4 g0 = *(const GAS f32x4*)(g + hseg * 512 + 8 * lane), g1 = *(const GAS f32x4*)(g + hseg * 512 + 8 * lane + 4); const float* xx = x + 8 * hseg;
                    v4u o; o.x = pk2(xx[0] * rstd * g0.x, xx[1] * rstd * g0.y); o.y = pk2(xx[2] * rstd * g0.z, xx[3] * rstd * g0.w); o.z = pk2(xx[4] * rstd * g1.x, xx[5] * rstd * g1.y); o.w = pk2(xx[6] * rstd * g1.z, xx[7] * rstd * g1.w);
                    *(GAS v4u*)(CQN + (size_t)m * 1024 + hseg * 512 + 8 * lane) = o; } }
            {   const v4u a = *(const GAS v4u*)(prow + PC_CKV + 8 * lane);
                float x[8] = {bflo(a.x), bfhi(a.x), bflo(a.y), bfhi(a.y), bflo(a.z), bfhi(a.z), bflo(a.w), bfhi(a.w)};
                float s = 0.f;
#pragma unroll
                for (int j = 0; j < 8; ++j) s += x[j] * x[j];
                const float rstd = 1.f / sqrtf(wave_sum(s) * (1.f / 512.f) + EPS);
                const float* g = A->in[I_KVNORM];
                const f32x4 g0 = *(const GAS f32x4*)(g + 8 * lane), g1 = *(const GAS f32x4*)(g + 8 * lane + 4);
                v4u o; o.x = pk2(x[0] * rstd * g0.x, x[1] * rstd * g0.y); o.y = pk2(x[2] * rstd * g0.z, x[3] * rstd * g0.w); o.z = pk2(x[4] * rstd * g1.x, x[5] * rstd * g1.y); o.w = pk2(x[6] * rstd * g1.z, x[7] * rstd * g1.w);
                *(GAS v4u*)(CKVN + (size_t)m * 512 + 8 * lane) = o; }
            if (m < MR + NMETA) {
#pragma unroll
                for (int j = 0; j < 4; ++j) {
                    const v4u a = *(const GAS v4u*)(prow + PC_DQ + 512 * j + 8 * lane), b = *(const GAS v4u*)(prow + PC_DK + 512 * j + 8 * lane);
                    float sq = (bflo(a.x) * bflo(a.x) + bfhi(a.x) * bfhi(a.x)) + (bflo(a.y) * bflo(a.y) + bfhi(a.y) * bfhi(a.y)) + (bflo(a.z) * bflo(a.z) + bfhi(a.z) * bfhi(a.z)) + (bflo(a.w) * bflo(a.w) + bfhi(a.w) * bfhi(a.w));
                    float sk = (bflo(b.x) * bflo(b.x) + bfhi(b.x) * bfhi(b.x)) + (bflo(b.y) * bflo(b.y) + bfhi(b.y) * bfhi(b.y)) + (bflo(b.z) * bflo(b.z) + bfhi(b.z) * bfhi(b.z)) + (bflo(b.w) * bflo(b.w) + bfhi(b.w) * bfhi(b.w));
#pragma unroll
                    for (int o = 1; o < 16; o <<= 1) { sq += __shfl_xor(sq, o); sk += __shfl_xor(sk, o); }
                    if (!meta) { qmx[j] = fmaxf(qmx[j], sq); kmx[j] = fmaxf(kmx[j], sk); }
                    else if ((lane & 15) == 0) atomicMax((unsigned*)(ctl + CW_KMETA) + (lane >> 4) + 4 * j, __float_as_uint(sk));
                }
            }
        }
        if (!meta && (lane & 15) == 0) { const int r0 = w * 8, b = r0 >> 12, qb = (r0 & (SEQ - 1)) >> 8;
#pragma unroll
            for (int j = 0; j < 4; ++j) { const int g = (lane >> 4) + 4 * j;
                atomicMax((unsigned*)(ctl + CW_QMAX) + (b * 16 + qb) * 16 + g, __float_as_uint(qmx[j])); atomicMax((unsigned*)(ctl + CW_KMAX) + b * 16 + g, __float_as_uint(kmx[j])); } }
        }
        if (BOTH(5)) GRID_BAR();
    }
    if (IN(6)) { PHASE_PTRS();
        { pg8::EpiB<pg8::MB_QUP> E{(pbf*)QM, 3072, nullptr, nullptr, nullptr, ROPE, nullptr}; GEMM_PHASE(pg8::EpiB<pg8::MB_QUP>, CQN, ws + WS_WUQ, MR, 3072, 1024, 1024, 1024, E); }
        { pg8::EpiB<pg8::MB_PLAIN> E{(pbf*)KV, 4096, nullptr, nullptr, nullptr, nullptr, nullptr}; GEMM_PHASE(pg8::EpiB<pg8::MB_PLAIN>, CKVN, ws + WS_WUKV, MP, 4096, 512, 512, 512, E); }
        if (BOTH(6)) GRID_BAR();
    }
    if (IN(7)) { PHASE_PTRS();
        char* const al = (char*)lds + RING_OFF; int atid = threadIdx.x; asm volatile("" : "+v"(atid));
#ifndef ATT_NO_DIFF
#ifndef DIFF_B
#define DIFF_B 1
#endif
#if DIFF_B
        if (A->att_mask & 1) for (int Lu = vcu; Lu < 1024; Lu += G) {
            const int i = Lu >> 8, x = (Lu >> 5) & 7, j = Lu & 31, b = x >> 1, h = ((0x4370 >> (4 * i)) & 15) ^ (x & 1), c = j >> 4, qb = ((j & 15) + 4 * i) & 15;
#else
        if (A->att_mask & 1) for (int Lu = vcu; Lu < 2048; Lu += G) {
            const int i = Lu >> 8, x = (Lu >> 5) & 7, j = Lu & 31, b = x >> 1, h = ((0x4370 >> (4 * (i >> 1))) & 15) ^ (x & 1), c = i & 1, vh = j >> 4, qb = ((j & 15) + 2 * i) & 15;
#endif
            const size_t qrow = (size_t)b * SEQ + (size_t)qb * 256;
            const float sl2 = __builtin_amdgcn_exp2f(-(float)(h + 1)) * 1.4426950408889634f;
            const int g = 2 * h + c; const float qm = __uint_as_float(ctl[CW_QMAX + (b * 16 + qb) * 16 + g]), km = __uint_as_float(ctl[CW_KMAX + b * 16 + g]), kmt = __uint_as_float(ctl[CW_KMETA + g]);
            const float Wf = ((sqrtf(qm * km) + sqrtf(qm * kmt)) * 1.01f + 163.f) / sl2;
            int t_lo = 1, t_hi = 64;
            if (Wf < 8192.f) { const int W = (int)Wf + 1, klo = qb * 256 - W, khi = qb * 256 + 255 + W; t_lo = klo <= 0 ? 1 : (klo >> 6) + 1; t_hi = khi >= SEQ ? 64 : (khi >> 6) + 1;
                if (((t_hi - t_lo) & 1) == 0) { if (t_lo > 1) --t_lo; else ++t_hi; } }
#if DIFF_B
            att::attn_unit_b(PB + qrow * INWP + PC_DQ + h * 256 + c * 128, INWP, PB + PC_DK + h * 256 + c * 128, INWP, PB + PC_DV + h * 256, INWP,
                             ORAW + qrow * 4096 + c * 2048 + h * 256, 4096, b * SEQ, qb * 256, sl2, t_lo, t_hi, al, atid);
#else
            att::attn_unit<128, true, DIFF_SDEPTH>(PB + qrow * INWP + PC_DQ + h * 256 + c * 128, INWP, PB + PC_DK + h * 256 + c * 128, INWP, nullptr, 0, PB + PC_DV + h * 256 + vh * 128, INWP,
                                         ORAW + qrow * 4096 + c * 2048 + h * 256 + vh * 128, 4096, b * SEQ, qb * 256, sl2, t_lo, t_hi, al, atid);
#endif
        }
#endif
    }
    if (IN(7)) { PHASE_PTRS();
        char* const al = (char*)lds + RING_OFF; int atid = threadIdx.x; asm volatile("" : "+v"(atid));
#ifndef ATT_NO_MLA
        if (A->att_mask & 2) for (int Lu = vcu; Lu < 1024; Lu += G) {
            const int i = Lu >> 8, x = (Lu >> 5) & 7, j = Lu & 31, bh = 8 * x + 2 * i + (j >> 4), b = bh >> 4, h = bh & 15, qb = j & 15;
            const size_t qrow = (size_t)b * SEQ + (size_t)qb * 256;
#if MLA_B
            att::attn_unit_m(QM + qrow * 3072 + h * 192, 3072, KV + h * 256, 4096, PB + PC_KR, INWP, KV + h * 256 + 128, 4096, OM + qrow * 2048 + h * 128, 2048, b * SEQ, al, atid);
#else
            att::attn_unit<192, false, MLA_SDEPTH>(QM + qrow * 3072 + h * 192, 3072, KV + h * 256, 4096, PB + PC_KR, INWP, KV + h * 256 + 128, 4096,
                                                   OM + qrow * 2048 + h * 128, 2048, b * SEQ, qb * 256, 0.f, 1, 64, al, atid);
#endif
        }
#endif
        if (BOTH(7)) GRID_BAR();
    }
    if (IN(8)) { PHASE_PTRS();
        float lam;
        {   const float* q1 = A->in[I_LQ1]; const float* k1 = A->in[I_LK1]; const float* q2 = A->in[I_LQ2]; const float* k2 = A->in[I_LK2];
            const float s1 = wave_sum(q1[lane] * k1[lane] + q1[lane + 64] * k1[lane + 64]), s2 = wave_sum(q2[lane] * k2[lane] + q2[lane + 64] * k2[lane + 64]);
            lam = __builtin_amdgcn_exp2f(s1 * 1.4426950408889634f) - __builtin_amdgcn_exp2f(s2 * 1.4426950408889634f) + 0.2f; }
        const f32x4 sg = *(const GAS f32x4*)(A->in[I_SUBLN] + 4 * lane);
        for (int m = gw; m < MR; m += NGW) {
            const bf16* o1 = ORAW + (size_t)m * 4096; const bf16* o2 = o1 + 2048;
#pragma unroll 2
            for (int h = 0; h < 8; ++h) {
                const v2u a = *(const GAS v2u*)(o1 + h * 256 + 4 * lane), b = *(const GAS v2u*)(o2 + h * 256 + 4 * lane);
                const float f0 = bflo(a.x) - lam * bflo(b.x), f1 = bfhi(a.x) - lam * bfhi(b.x), f2 = bflo(a.y) - lam * bflo(b.y), f3 = bfhi(a.y) - lam * bfhi(b.y);
                const float rstd = 1.f / sqrtf(wave_sum((f0 * f0 + f1 * f1) + (f2 * f2 + f3 * f3)) * (1.f / 256.f) + EPS);
                v2u o; o.x = pk2(f0 * rstd * sg.x * 0.8f, f1 * rstd * sg.y * 0.8f); o.y = pk2(f2 * rstd * sg.z * 0.8f, f3 * rstd * sg.w * 0.8f);
                *(GAS v2u*)(OD + (size_t)m * 2048 + h * 256 + 4 * lane) = o;
            }
        }
        { pg8::EpiB<pg8::MB_GATE> E{(pbf*)GATES, 2 * DM, A->in[I_BG], nullptr, nullptr, nullptr, (const float*)(ctl + CW_SSQ1)}; GEMM_PHASE(pg8::EpiB<pg8::MB_GATE>, XN, ws + WS_WG, MR, 2 * DM, DM, DM, DM, E); }
        if (BOTH(8)) GRID_BAR();
    }
    if (IN(9)) { PHASE_PTRS(); pg8::EpiB<pg8::MB_BR1> E{(pbf*)T1, DM, nullptr, (const pbf*)GATES, nullptr, nullptr, nullptr}; GEMM_PHASE(pg8::EpiB<pg8::MB_BR1>, OD, ws + WS_WBD, MR, DM, 2048, 2048, 2048, E); }
    if (IN(10)) { PHASE_PTRS(); pg8::EpiB<pg8::MB_BR2> E{(pbf*)MERGED, DM, nullptr, (const pbf*)GATES, (const pbf*)T1, nullptr, nullptr}; GEMM_PHASE(pg8::EpiB<pg8::MB_BR2>, OM, ws + WS_WBM, MR, DM, 2048, 2048, 2048, E); if (BOTH(10)) GRID_BAR(); }
    if (IN(11)) { PHASE_PTRS(); pg8::EpiResid E{out, out, SLAB, (pbf*)XN, PART, 1.0f}; STAGGER(); GEMM_PHASE(pg8::EpiResid, MERGED, ws + WS_WO, MR, DM, DM, DM, DM, E); if (BOTH(11)) GRID_BAR(); }
    if (IN(12)) { PHASE_PTRS(); float* const ssq = (float*)(ctl + CW_SSQ2);
        for (int m = gw; m < MR; m += NGW) { const float q = wave_sum(PART[(size_t)m * 64 + lane]); if (lane == 0) ssq[m] = q; }
        if (BOTH(12)) GRID_BAR();
    }
    if (IN(13)) { PHASE_PTRS(); pg8::EpiSwiglu E{(pbf*)HB, 0, (const float*)(ctl + CW_SSQ2)}; GEMM_PHASE(pg8::EpiSwiglu, XN, ws + WS_W2GU, MR, 2 * DFF, DM, DM, DM, E); if (BOTH(13)) GRID_BAR(); }
    if (IN(14)) { PHASE_PTRS(); pg8::EpiResid E{out, out, SLAB, nullptr, PART, 0.5f}; STAGGER(); GEMM_PHASE_BLK(pg8::EpiResid, HB, ws + WS_W2D, MR, DM, DFF, E, 0, WGM_DOWN); if (BOTH(14)) GRID_BAR(); }
    if (IN(15)) { PHASE_PTRS();
        for (int m = gw; m < MR; m += NGW) { GAS f32x4* xr = (GAS f32x4*)(out + (size_t)m * DM) + lane; const GAS f32x4* gr = (const GAS f32x4*)A->in[I_NF] + lane;
            const float rstd = 1.0f / sqrtf(wave_sum(PART[(size_t)m * 64 + lane]) * (1.0f / DM) + EPS);
#pragma unroll
            for (int j = 0; j < 16; ++j) xr[64 * j] = xr[64 * j] * rstd * gr[64 * j]; }
    }
#undef IN
#undef BOTH
#undef GRID_BAR
#undef GEMM_PHASE
}

#define FWD_MAIN fwd
#define FWD_PROBE fwd
#define FWD_IS_PROBE(li) false
extern "C" void kernel_launch(void* const* d_in, const int* in_sizes, int n_in, void* d_out, int out_size, void* d_ws, size_t ws_size, hipStream_t stream) {
    static int grid = 0;
    if (grid == 0) {
        if (n_in != 27 || in_sizes[0] != MR * DM || out_size != MR * DM || ws_size < WS_END) {
            fprintf(stderr, "kernel_launch: built for 27 inputs, x/out of %d floats, >= %zu bytes of workspace; got n_in %d, in0 %d, out %d, ws %zu; nothing launched\n", MR * DM, (size_t)WS_END, n_in, n_in > 0 ? in_sizes[0] : -1, out_size, ws_size);
            grid = -1; return; }
        int dev = 0, cus = 0, per_cu = 0;
        if (hipGetDevice(&dev) != hipSuccess || hipDeviceGetAttribute(&cus, hipDeviceAttributeMultiprocessorCount, dev) != hipSuccess) { fprintf(stderr, "kernel_launch: device query failed\n"); grid = -1; return; }
        if (hipFuncSetAttribute((const void*)FWD_MAIN, hipFuncAttributeMaxDynamicSharedMemorySize, LDS_BYTES) != hipSuccess || hipFuncSetAttribute((const void*)FWD_PROBE, hipFuncAttributeMaxDynamicSharedMemorySize, LDS_BYTES) != hipSuccess) { fprintf(stderr, "kernel_launch: hipFuncSetAttribute failed\n"); grid = -1; return; }
        if (hipOccupancyMaxActiveBlocksPerMultiprocessor(&per_cu, (const void*)FWD_MAIN, NWAVES * 64, LDS_BYTES) != hipSuccess || per_cu < 1)
            fprintf(stderr, "kernel_launch: note: occupancy query reports %d workgroups per CU\n", per_cu);
        (void)hipGetLastError();
        grid = cus;
    }
    if (grid < 0) return;
    if (hipMemsetAsync((char*)d_ws + WS_CTL, 0, CTL_ZERO_BYTES, stream) != hipSuccess) { fprintf(stderr, "kernel_launch: memset failed\n"); return; }
    Args a{};
    for (int i = 0; i < 27; ++i) a.in[i] = (const float*)d_in[i];
    a.out = (float*)d_out; a.ws = (unsigned char*)d_ws; a.att_mask = 3; a.pad = 0;
#ifdef PROBE_DUP
    const int cuts[4] = {0, PROBE_DUP + 1, PROBE_DUP + 1, NPH}; const int nl = (PROBE_DUP + 1 < NPH) ? 3 : 2;
    for (int li = 0; li < nl; ++li) {
        a.ph_lo = li == 1 ? PROBE_DUP : cuts[li]; a.ph_hi = cuts[li + 1];
#ifdef PROBE_ATT_MASK
        a.att_mask = li == 1 ? PROBE_ATT_MASK : 3;
#endif
#else
    for (int li = 0; li < N_LAUNCHES; ++li) {
        a.ph_lo = (N_LAUNCHES == 1) ? 0 : li * NPH / N_LAUNCHES; a.ph_hi = (N_LAUNCHES == 1) ? NPH : (li + 1) * NPH / N_LAUNCHES;
#endif
        { void* kargs_[] = {(void*)&a}; (void)hipLaunchKernel(FWD_IS_PROBE(li) ? (const void*)FWD_PROBE : (const void*)FWD_MAIN, dim3(grid), dim3(NWAVES * 64), kargs_, LDS_BYTES, stream); }
        const hipError_t le = hipPeekAtLastError();
        if (le != hipSuccess) { fprintf(stderr, "kernel_launch: launch %d failed: %s\n", li, hipGetErrorName(le)); break; }
    }
}
```
